# Optimizing an MI355X kernel written in HIP

```python
import jax, jax.numpy as jnp
from jax import lax
import numpy as np

D_MODEL = 1024
BATCH = 16
SEQ = 2048
DEPTH = 2

ATT_GROUPS = ((128, 1), (512, 4), (2048, 16))
HEADS_PER_GROUP = 4
N_ATT_HEADS = HEADS_PER_GROUP * len(ATT_GROUPS)
ATT_HEAD_DIM = 64
ATT_WIDTH = N_ATT_HEADS * ATT_HEAD_DIM
ATT_OUT_WIDTH = HEADS_PER_GROUP * ATT_HEAD_DIM
BLOCK = 128
ALIBI_MAX = 8.0
NEG_INF = -1e30
RET_HEADS = 8
RET_KEY_DIM = 64
RET_VAL_DIM = 128
RET_QK_WIDTH = RET_HEADS * RET_KEY_DIM
RET_V_WIDTH = RET_HEADS * RET_VAL_DIM
RET_CHUNK = 128
ROPE_BASE = 10000.0
D_FF = 2816
N_EXPERTS = 8
TOP_K = 2
EPS = 1e-6
IN_SIZES = (ATT_WIDTH, ATT_WIDTH, ATT_WIDTH, RET_QK_WIDTH, RET_QK_WIDTH, RET_V_WIDTH, RET_V_WIDTH, D_MODEL, D_MODEL)
IN_COLS = sum(IN_SIZES)
IN_SPLIT_POINTS = tuple(int(v) for v in np.cumsum(IN_SIZES)[:-1])

kernel_name = 'hybrid_dilated_retention_moe_block'


def rms_norm(x, gain):
    xf = x.astype(jnp.float32)
    y = xf * lax.rsqrt(jnp.mean(xf * xf, axis=-1, keepdims=True) + EPS)
    return (y * gain.astype(jnp.float32)).astype(x.dtype)


def alibi_slopes():
    h = jnp.arange(1, N_ATT_HEADS + 1, dtype=jnp.float32)
    return jnp.exp2(-ALIBI_MAX * h / N_ATT_HEADS)


def retention_gammas():
    return jnp.log1p(-jnp.exp2(-5.0 - jnp.arange(RET_HEADS, dtype=jnp.float32)))


def rotary(t, positions):
    half = t.shape[-1] // 2
    inv_freq = 1.0 / (ROPE_BASE ** (jnp.arange(half, dtype=jnp.float32) / half))
    ang = positions.astype(jnp.float32)[:, None] * inv_freq[None]
    cos = jnp.cos(ang)[None, :, None, :]
    sin = jnp.sin(ang)[None, :, None, :]
    t1, t2 = t[..., :half], t[..., half:]
    return jnp.concatenate([t1 * cos - t2 * sin, t1 * sin + t2 * cos], axis=-1)


def dilated_attention(q, k, v, window, dilation, slopes):
    B, S, H, Dh = q.shape
    n_w = window // dilation
    n = S // dilation
    nb = -(-n // BLOCK)
    pad = nb * BLOCK - n

    def to_strided(t):
        t = t.reshape(B, n, dilation, H, Dh)
        t = jnp.pad(t, ((0, 0), (0, pad), (0, 0), (0, 0), (0, 0)))
        return t.reshape(B, nb, BLOCK, dilation, H, Dh)

    def with_prev(t):
        prev = jnp.pad(t, ((0, 0), (1, 0), (0, 0), (0, 0), (0, 0), (0, 0)))[:, :-1]
        return jnp.concatenate([prev, t], axis=2)

    qs = to_strided(q)
    kb = with_prev(to_strided(k))
    vb = with_prev(to_strided(v))
    scores = jnp.einsum('bnqrhd,bnkrhd->bnrhqk', qs, kb) * (Dh ** -0.5)
    qi = jnp.arange(BLOCK)[:, None] + BLOCK
    kj = jnp.arange(2 * BLOCK)[None, :]
    dist = qi - kj
    blk = jnp.arange(nb)
    valid = ((dist >= 0) & (dist <= n_w))[None] & ((blk[:, None, None] > 0) | (kj[None] >= BLOCK))
    alibi = -slopes[:, None, None] * (dilation * dist).astype(jnp.float32)[None]
    scores = jnp.where(valid[None, :, None, None], scores + alibi, NEG_INF)
    m = jnp.max(scores, axis=-1, keepdims=True)
    p = jnp.exp(scores - m)
    den = jnp.sum(p, axis=-1, keepdims=True)
    out = jnp.einsum('bnrhqk,bnkrhd->bnqrhd', p / den, vb)
    lse = (m + jnp.log(den))[..., 0]
    out = out.reshape(B, nb * BLOCK, dilation, H, Dh)[:, :n].reshape(B, S, H, Dh)
    lse = jnp.transpose(lse, (0, 1, 4, 2, 3)).reshape(B, nb * BLOCK, dilation, H)[:, :n].reshape(B, S, H)
    return out, lse


def retention(q, k, v, log_gamma):
    B, S, H, Dk = q.shape
    Dv = v.shape[-1]
    C = RET_CHUNK
    nc = S // C
    k = k * (Dk ** -0.5)
    qc = q.reshape(B, nc, C, H, Dk)
    kc = k.reshape(B, nc, C, H, Dk)
    vc = v.reshape(B, nc, C, H, Dv)
    idx = jnp.arange(C, dtype=jnp.float32)
    rel = idx[:, None] - idx[None, :]
    decay = jnp.where(rel[None] >= 0, jnp.exp(jnp.maximum(rel, 0.0)[None] * log_gamma[:, None, None]), 0.0)
    intra = jnp.einsum('bcihd,bcjhd->bchij', qc, kc) * decay[None, None]
    intra_out = jnp.einsum('bchij,bcjhv->bcihv', intra, vc)
    zeta = jnp.exp((C - 1 - idx)[None] * log_gamma[:, None])
    xi = jnp.exp((idx + 1)[None] * log_gamma[:, None])
    chunk_kv = jnp.einsum('bcjhd,hj,bcjhv->bchdv', kc, zeta, vc)
    g_chunk = jnp.exp(C * log_gamma)[:, None, None]

    def step(state, kv):
        return state * g_chunk + kv, state

    _, r_prev = lax.scan(step, jnp.zeros((B, H, Dk, Dv), jnp.float32), jnp.moveaxis(chunk_kv, 1, 0))
    r_prev = jnp.moveaxis(r_prev, 0, 1)
    inter = jnp.einsum('bcihd,hi,bchdv->bcihv', qc, xi, r_prev)
    return (intra_out + inter).reshape(B, S, H, Dv)


def token_mixer(h, w_in, w_att_proj, w_ret_proj, w_mix_out):
    B, S, _ = h.shape
    proj = h @ w_in
    q_a, k_a, v_a, q_r, k_r, v_r, g_r, gate_a, gate_r = jnp.split(proj, IN_SPLIT_POINTS, axis=-1)
    heads = lambda t: t.astype(jnp.float32).reshape(B, S, N_ATT_HEADS, ATT_HEAD_DIM)
    q_a, k_a, v_a = heads(q_a), heads(k_a), heads(v_a)
    slopes = alibi_slopes()
    outs, lses = [], []
    for g, (window, dilation) in enumerate(ATT_GROUPS):
        sl = slice(g * HEADS_PER_GROUP, (g + 1) * HEADS_PER_GROUP)
        o, l = dilated_attention(q_a[:, :, sl], k_a[:, :, sl], v_a[:, :, sl], window, dilation, slopes[sl])
        outs.append(o)
        lses.append(l)
    weights = jax.nn.softmax(jnp.stack(lses), axis=0)
    att = jnp.sum(weights[..., None] * jnp.stack(outs), axis=0).reshape(B, S, ATT_OUT_WIDTH).astype(h.dtype)
    pos = jnp.arange(S)
    q_r = rotary(q_r.astype(jnp.float32).reshape(B, S, RET_HEADS, RET_KEY_DIM), pos)
    k_r = rotary(k_r.astype(jnp.float32).reshape(B, S, RET_HEADS, RET_KEY_DIM), pos)
    v_r = v_r.astype(jnp.float32).reshape(B, S, RET_HEADS, RET_VAL_DIM)
    ret = retention(q_r, k_r, v_r, retention_gammas())
    ret = ret * lax.rsqrt(jnp.mean(ret * ret, axis=-1, keepdims=True) + EPS)
    ret = (jax.nn.silu(g_r.astype(jnp.float32)) * ret.reshape(B, S, RET_V_WIDTH)).astype(h.dtype)
    merged = jax.nn.sigmoid(gate_a) * (att @ w_att_proj) + jax.nn.sigmoid(gate_r) * (ret @ w_ret_proj)
    return merged @ w_mix_out


def swiglu(h, w_gate, w_up, w_down):
    return (jax.nn.silu(h @ w_gate) * (h @ w_up)) @ w_down


def moe_swiglu(h, w_router, b_router, w_exp_gate, w_exp_up, w_exp_down):
    logits = (h @ w_router).astype(jnp.float32) + b_router.astype(jnp.float32)
    top_vals, top_idx = lax.top_k(logits, TOP_K)
    top_w = jax.nn.softmax(top_vals, axis=-1)
    combine = jnp.sum(jax.nn.one_hot(top_idx, N_EXPERTS, dtype=jnp.float32) * top_w[..., None], axis=-2)
    out = jnp.zeros_like(h)
    for e in range(N_EXPERTS):
        y = swiglu(h, w_exp_gate[e], w_exp_up[e], w_exp_down[e])
        out = out + combine[..., e:e + 1].astype(h.dtype) * y
    return out


def setup_inputs(seed: int = 0) -> dict:
    key = jax.random.key(seed)
    ks = jax.random.split(key, 24)
    n_dense = (DEPTH + 1) // 2
    n_moe = DEPTH // 2
    f32 = jnp.float32

    def w(k, shape, fan_in):
        return jax.random.normal(k, shape, f32) * (fan_in ** -0.5)

    def gain(k, shape):
        return 1.0 + 0.05 * jax.random.normal(k, shape, f32)

    def bias(k, shape, scale):
        return scale * jax.random.normal(k, shape, f32)

    D = D_MODEL
    return {
        'x': jax.random.normal(ks[0], (BATCH, SEQ, D), f32),
        'c': jax.random.normal(ks[1], (BATCH, D), f32),
        'w_ada': w(ks[2], (DEPTH, D, 6 * D), D),
        'b_ada': bias(ks[3], (DEPTH, 6 * D), 0.02),
        'norm_pre_mix': gain(ks[4], (DEPTH, D)),
        'w_in': w(ks[5], (DEPTH, D, IN_COLS), D),
        'w_att_proj': w(ks[6], (DEPTH, ATT_OUT_WIDTH, D), ATT_OUT_WIDTH),
        'w_ret_proj': w(ks[7], (DEPTH, RET_V_WIDTH, D), RET_V_WIDTH),
        'w_mix_out': w(ks[8], (DEPTH, D, D), D),
        'norm_post_mix': gain(ks[9], (DEPTH, D)),
        'norm_pre_ffn': gain(ks[10], (DEPTH, D)),
        'w_ffn_gate': w(ks[11], (n_dense, D, D_FF), D),
        'w_ffn_up': w(ks[12], (n_dense, D, D_FF), D),
        'w_ffn_down': w(ks[13], (n_dense, D_FF, D), D_FF),
        'w_router': w(ks[14], (n_moe, D, N_EXPERTS), D),
        'b_router': bias(ks[15], (n_moe, N_EXPERTS), 0.01),
        'w_exp_gate': w(ks[16], (n_moe, N_EXPERTS, D, D_FF), D),
        'w_exp_up': w(ks[17], (n_moe, N_EXPERTS, D, D_FF), D),
        'w_exp_down': w(ks[18], (n_moe, N_EXPERTS, D_FF, D), D_FF),
        'norm_post_ffn': gain(ks[19], (DEPTH, D)),
    }


def reference(x, c, w_ada, b_ada, norm_pre_mix, w_in, w_att_proj, w_ret_proj, w_mix_out, norm_post_mix,
              norm_pre_ffn, w_ffn_gate, w_ffn_up, w_ffn_down, w_router, b_router, w_exp_gate, w_exp_up,
              w_exp_down, norm_post_ffn):
    c_act = jax.nn.silu(c)
    for layer in range(DEPTH):
        mod = c_act @ w_ada[layer] + b_ada[layer]
        sh1, sc1, g1, sh2, sc2, g2 = jnp.split(mod[:, None, :], 6, axis=-1)
        h = rms_norm(x, norm_pre_mix[layer]) * (1.0 + sc1) + sh1
        y = token_mixer(h, w_in[layer], w_att_proj[layer], w_ret_proj[layer], w_mix_out[layer])
        x = x + g1 * rms_norm(y, norm_post_mix[layer])
        h = rms_norm(x, norm_pre_ffn[layer]) * (1.0 + sc2) + sh2
        j = layer // 2
        if layer % 2 == 0:
            y = swiglu(h, w_ffn_gate[j], w_ffn_up[j], w_ffn_down[j])
        else:
            y = moe_swiglu(h, w_router[j], b_router[j], w_exp_gate[j], w_exp_up[j], w_exp_down[j])
        x = x + g2 * rms_norm(y, norm_post_ffn[layer])
    return x
```

```cpp
#include <hip/hip_runtime.h>
#include <cstdio>
#include <cstdint>

#define REP_B 1
#define REP_C1 1
#define REP_BAR 1
#define REP_H0 1
#define REP_PRO 1
#define REP_MIX 1
#define REP_FFN0 1
#define REP_SH 1
#define REP_SC 1
#define REP_CVT 1
#define REP_A 1
#define REP_C1A 1
#define REP_C1K 1
#define REP_D 1
#define REP_C2 1
#define REP_E 1
#define REP_G 1
#define REP_I 1
#define REP_J 1
#ifndef MK_MULTI
#define MK_MULTI 0
#endif

__device__ __forceinline__ int lane_id() { int r; asm volatile("v_mbcnt_lo_u32_b32 %0, -1, 0\n\tv_mbcnt_hi_u32_b32 %0, -1, %0" : "=v"(r)); return r; }
namespace pg8 {
#define PG8_LAS __attribute__((address_space(3)))
#define PG8_GAS __attribute__((address_space(1)))
typedef unsigned short bf16_t;
typedef short bf16x8 __attribute__((ext_vector_type(8)));
typedef float f32x4 __attribute__((ext_vector_type(4)));
typedef unsigned u32x4 __attribute__((ext_vector_type(4)));
typedef int v8i32 __attribute__((ext_vector_type(8)));
typedef int v4i32 __attribute__((ext_vector_type(4)));
constexpr int BM = 256, BK = 64, HALF = 128, HTB = HALF * BK * 2, STAGE_BYTES = 8 * HTB, NXCD = 8, WGM = 8;

__host__ __device__ __forceinline__ int lds_byte(int r, int c) { const int st = (r >> 4) * 2 + (c >> 5), rr = r & 15, cc = c & 31, ob = rr * 64 + cc * 2; return st * 1024 + (ob ^ (((ob >> 9) & 1) << 5)); }
__host__ __device__ __forceinline__ void stage_rc(int b, int& R, int& C) { const int st = b / 1024, sb = b % 1024, swz = sb ^ (((sb >> 9) & 1) << 5); R = (st >> 1) * 16 + swz / 64; C = (st & 1) * 32 + (swz % 64) / 2; }
__host__ __device__ __forceinline__ int perm32(int rho) { const int n = rho >> 4, i = rho & 15; return 8 * (i >> 2) + 4 * n + (i & 3); }

struct Unit { int pm, pn; unsigned boff; int e; };
struct Gemm { const bf16_t* A; const bf16_t* Bt; int M, N, K; };

struct StaticOrder {
    int nM, nN, nwg, G, c;
    __host__ __device__ void init(int M, int N, int G_, int c_) { nM = M / BM; nN = N / BM; nwg = nM * nN; G = G_; c = c_; }
    __host__ __device__ bool next(int i, Unit& u) const {
        const int L = i * G + c; if (L >= nwg) return false;
        int wgid = L; { const int q = nwg / NXCD, r = nwg % NXCD, xcd = wgid % NXCD, off = wgid / NXCD; wgid = (xcd < r ? xcd * (q + 1) : r * (q + 1) + (xcd - r) * q) + off; }
        const int nig = WGM * nN, gid = wgid / nig, fm = gid * WGM, gsz = (nM - fm) < WGM ? (nM - fm) : WGM;
        u.pm = fm + ((wgid % nig) % gsz); u.pn = (wgid % nig) / gsz; u.boff = 0; u.e = 0; return true;
    }
};
struct FfnOrder {
    StaticOrder so; const PG8_LAS int* tend; unsigned estride;
    __device__ bool next(int i, Unit& u) const {
        if (!so.next(i, u)) return false;
        const int ta = u.pm; int e = 0;
#pragma unroll
        for (int k = 0; k < 7; ++k) e += (ta >= tend[k]) ? 1 : 0;
        u.boff = (unsigned)e * estride; u.e = e; return true;
    }
};

__device__ __forceinline__ unsigned cvt_pk_bf16(float lo, float hi) { unsigned r; asm volatile("v_cvt_pk_bf16_f32 %0, %1, %2" : "=v"(r) : "v"(lo), "v"(hi)); return r; }
__device__ __forceinline__ float bflo(unsigned w) { return __builtin_bit_cast(float, w << 16); }
__device__ __forceinline__ float bfhi(unsigned w) { return __builtin_bit_cast(float, w & 0xffff0000u); }
__device__ __forceinline__ float sigm(float x) { return __builtin_amdgcn_rcpf(1.0f + __expf(-x)); }

struct EpiBf16 {
    static constexpr bool PERM = true; static constexpr int NVM = 16;
    bf16_t* O; int ldc;
    __device__ __forceinline__ void operator()(const f32x4 (&acc)[2][2][4][2], const Unit& u, int wr, int wc, int fr, int fq) const {
        const int row0 = u.pm * BM + wr * 64 + fr; const int col0 = u.pn * BM + wc * 32 + 8 * fq;
#pragma unroll
        for (int ai = 0; ai < 2; ++ai)
#pragma unroll
            for (int m = 0; m < 4; ++m) { bf16_t* rowp = O + (size_t)(row0 + ai * HALF + m * 16) * ldc + col0;
#pragma unroll
                for (int bj = 0; bj < 2; ++bj) { const f32x4 v0 = acc[ai][bj][m][0], v1 = acc[ai][bj][m][1];
                    u32x4 w; w.x = cvt_pk_bf16(v0[0], v0[1]); w.y = cvt_pk_bf16(v0[2], v0[3]); w.z = cvt_pk_bf16(v1[0], v1[1]); w.w = cvt_pk_bf16(v1[2], v1[3]);
                    *(PG8_GAS u32x4*)(rowp + bj * HALF) = w; } }
    }
};
constexpr int SC_OFF = 131072 + 320 + 1024;
__device__ __forceinline__ void stage_row_scales(PG8_LAS unsigned char* lds, const float* rs0, int wid) {
    int ln; asm volatile("v_mbcnt_lo_u32_b32 %0, -1, 0\n\tv_mbcnt_hi_u32_b32 %0, -1, %0" : "=v"(ln));
    const float* p = rs0 + (wid >> 2) * 64 + ln; PG8_LAS unsigned char* d = lds + SC_OFF + wid * 512;
    asm volatile("" ::: "memory");
    __builtin_amdgcn_global_load_lds((const unsigned*)p, (PG8_LAS unsigned*)d, 4, 0, 0);
    __builtin_amdgcn_global_load_lds((const unsigned*)(p + HALF), (PG8_LAS unsigned*)(d + 256), 4, 0, 0);
    asm volatile("" ::: "memory");
}
__device__ __forceinline__ void load_row_scales(PG8_LAS unsigned char* lds, int wid, int fr, float ws, float (&sc)[2][4]) {
    asm volatile("" ::: "memory");
    const PG8_LAS float* sl = (const PG8_LAS float*)(lds + SC_OFF + wid * 512) + fr;
#pragma unroll
    for (int ai = 0; ai < 2; ++ai)
#pragma unroll
        for (int m = 0; m < 4; ++m) sc[ai][m] = sl[ai * 64 + m * 16] * ws;
}
struct EpiI8 {
    static constexpr bool PERM = true, HAS_STAGE = true; static constexpr int NVM = 18;
    bf16_t* O; int ldc; const float* rs; float ws; unsigned char* G8; int ntb;
    static constexpr int GC8 = 2048;
    __device__ __forceinline__ void stage(PG8_LAS unsigned char* lds, const Unit& u, int wid) const { stage_row_scales(lds, rs + u.pm * BM, wid); }
    __device__ __forceinline__ void operator()(const f32x4 (&acc)[2][2][4][2], const Unit& u, int wr, int wc, int fr, int fq, PG8_LAS unsigned char* lds, int wid) const {
        const int row0 = u.pm * BM + wr * 64 + fr;
        float scv[2][4]; load_row_scales(lds, wid, fr, ws, scv);
        if (u.pn < ntb) {
            const int col0 = u.pn * BM + wc * 32 + 8 * fq;
#pragma unroll
            for (int ai = 0; ai < 2; ++ai)
#pragma unroll
                for (int m = 0; m < 4; ++m) { const int row = row0 + ai * HALF + m * 16; const float sc = scv[ai][m]; bf16_t* rowp = O + (size_t)row * ldc + col0;
#pragma unroll
                    for (int bj = 0; bj < 2; ++bj) { const v4i32 a0 = __builtin_bit_cast(v4i32, acc[ai][bj][m][0]), a1 = __builtin_bit_cast(v4i32, acc[ai][bj][m][1]);
                        u32x4 w; w.x = cvt_pk_bf16((float)a0[0] * sc, (float)a0[1] * sc); w.y = cvt_pk_bf16((float)a0[2] * sc, (float)a0[3] * sc); w.z = cvt_pk_bf16((float)a1[0] * sc, (float)a1[1] * sc); w.w = cvt_pk_bf16((float)a1[2] * sc, (float)a1[3] * sc);
                        *(PG8_GAS u32x4*)(rowp + bj * HALF) = w; } }
        } else {
            const int col0 = (u.pn - ntb) * BM + wc * 32 + 8 * fq;
            typedef int i32x2 __attribute__((ext_vector_type(2)));
#pragma unroll
            for (int ai = 0; ai < 2; ++ai)
#pragma unroll
                for (int m = 0; m < 4; ++m) { const int row = row0 + ai * HALF + m * 16; const float sc = scv[ai][m]; unsigned char* rowp = G8 + (size_t)row * GC8 + col0;
#pragma unroll
                    for (int bj = 0; bj < 2; ++bj) { const v4i32 a0 = __builtin_bit_cast(v4i32, acc[ai][bj][m][0]), a1 = __builtin_bit_cast(v4i32, acc[ai][bj][m][1]);
                        int w0 = 0, w1 = 0;
                        w0 = __builtin_amdgcn_cvt_pk_fp8_f32((float)a0[0] * sc, (float)a0[1] * sc, w0, false); w0 = __builtin_amdgcn_cvt_pk_fp8_f32((float)a0[2] * sc, (float)a0[3] * sc, w0, true);
                        w1 = __builtin_amdgcn_cvt_pk_fp8_f32((float)a1[0] * sc, (float)a1[1] * sc, w1, false); w1 = __builtin_amdgcn_cvt_pk_fp8_f32((float)a1[2] * sc, (float)a1[3] * sc, w1, true);
                        *(PG8_GAS i32x2*)(rowp + bj * HALF) = (i32x2){w0, w1}; } }
        }
    }
};
template <int ADD> struct EpiGate {
    static constexpr bool PERM = true; static constexpr int NVM = 16;
    const unsigned char* Gt; int ldg; bf16_t* O; int ldc;
    typedef int i32x2 __attribute__((ext_vector_type(2))); typedef float f32x2v __attribute__((ext_vector_type(2)));
    __device__ __forceinline__ void one(const f32x4 v0, const f32x4 v1, const i32x2 g, const u32x4 t, bf16_t* p) const {
        const f32x2v g01 = __builtin_amdgcn_cvt_pk_f32_fp8(g.x, false), g23 = __builtin_amdgcn_cvt_pk_f32_fp8(g.x, true), g45 = __builtin_amdgcn_cvt_pk_f32_fp8(g.y, false), g67 = __builtin_amdgcn_cvt_pk_f32_fp8(g.y, true);
        float o[8];
        o[0] = sigm(g01.x) * v0[0]; o[1] = sigm(g01.y) * v0[1]; o[2] = sigm(g23.x) * v0[2]; o[3] = sigm(g23.y) * v0[3];
        o[4] = sigm(g45.x) * v1[0]; o[5] = sigm(g45.y) * v1[1]; o[6] = sigm(g67.x) * v1[2]; o[7] = sigm(g67.y) * v1[3];
        if (ADD) { o[0] += bflo(t.x); o[1] += bfhi(t.x); o[2] += bflo(t.y); o[3] += bfhi(t.y); o[4] += bflo(t.z); o[5] += bfhi(t.z); o[6] += bflo(t.w); o[7] += bfhi(t.w); }
        u32x4 w; w.x = cvt_pk_bf16(o[0], o[1]); w.y = cvt_pk_bf16(o[2], o[3]); w.z = cvt_pk_bf16(o[4], o[5]); w.w = cvt_pk_bf16(o[6], o[7]);
        *(PG8_GAS u32x4*)p = w;
    }
    __device__ __forceinline__ void operator()(const f32x4 (&acc)[2][2][4][2], const Unit& u, int wr, int wc, int fr, int fq) const {
        const int row0 = u.pm * BM + wr * 64 + fr; const int col0 = u.pn * BM + wc * 32 + 8 * fq;
        i32x2 gt[2][4][2]; u32x4 t0[4][2], t1[4][2];
#pragma unroll
        for (int ai = 0; ai < 2; ++ai)
#pragma unroll
            for (int m = 0; m < 4; ++m)
#pragma unroll
                for (int bj = 0; bj < 2; ++bj) { const size_t row = (size_t)(row0 + ai * HALF + m * 16);
                    gt[ai][m][bj] = *(const PG8_GAS i32x2*)(Gt + row * ldg + col0 + bj * HALF);
                    if (ai == 0) { t0[m][bj] = (u32x4){0u, 0u, 0u, 0u}; if (ADD) t0[m][bj] = *(const PG8_GAS u32x4*)(O + row * ldc + col0 + bj * HALF); } }
#pragma unroll
        for (int m = 0; m < 4; ++m) {
#pragma unroll
            for (int bj = 0; bj < 2; ++bj) { const size_t row = (size_t)(row0 + m * 16); one(acc[0][bj][m][0], acc[0][bj][m][1], gt[0][m][bj], t0[m][bj], O + row * ldc + col0 + bj * HALF); }
#pragma unroll
            for (int bj = 0; bj < 2; ++bj) { const size_t row = (size_t)(row0 + HALF + m * 16); t1[m][bj] = (u32x4){0u, 0u, 0u, 0u}; if (ADD) t1[m][bj] = *(const PG8_GAS u32x4*)(O + row * ldc + col0 + bj * HALF); }
            __builtin_amdgcn_sched_barrier(0);
        }
#pragma unroll
        for (int m = 0; m < 4; ++m)
#pragma unroll
            for (int bj = 0; bj < 2; ++bj) { const size_t row = (size_t)(row0 + HALF + m * 16); one(acc[1][bj][m][0], acc[1][bj][m][1], gt[1][m][bj], t1[m][bj], O + row * ldc + col0 + bj * HALF); }
    }
};
struct EpiSwiglu {
    static constexpr bool PERM = true; static constexpr int NVM = 8;
    unsigned char* O; int ldc;
    __device__ __forceinline__ void operator()(const f32x4 (&acc)[2][2][4][2], const Unit& u, int wr, int wc, int fr, int fq) const {
        const int row0 = u.pm * BM + wr * 64 + fr; const int col0 = u.pn * HALF + wc * 32 + 8 * fq;
#pragma unroll
        for (int ai = 0; ai < 2; ++ai)
#pragma unroll
            for (int m = 0; m < 4; ++m) { unsigned char* rowp = O + (size_t)(row0 + ai * HALF + m * 16) * ldc + col0;
                float o[8];
#pragma unroll
                for (int n = 0; n < 2; ++n)
#pragma unroll
                    for (int k = 0; k < 4; ++k) { const float g = acc[ai][0][m][n][k], up = acc[ai][1][m][n][k]; o[n * 4 + k] = g * sigm(g) * up; }
                int w0 = 0, w1 = 0;
                w0 = __builtin_amdgcn_cvt_pk_fp8_f32(o[0], o[1], w0, false); w0 = __builtin_amdgcn_cvt_pk_fp8_f32(o[2], o[3], w0, true);
                w1 = __builtin_amdgcn_cvt_pk_fp8_f32(o[4], o[5], w1, false); w1 = __builtin_amdgcn_cvt_pk_fp8_f32(o[6], o[7], w1, true);
                typedef int i32x2 __attribute__((ext_vector_type(2)));
                *(PG8_GAS i32x2*)rowp = (i32x2){w0, w1}; }
    }
};

__device__ __forceinline__ v8i32 cat8(bf16x8 a, bf16x8 b) { return __builtin_shufflevector(__builtin_bit_cast(v4i32, a), __builtin_bit_cast(v4i32, b), 0, 1, 2, 3, 4, 5, 6, 7); }
constexpr int W8_SHIFT = 8;
constexpr int W8_SCALE = (127 - W8_SHIFT / 2) * 0x01010101, ONE_SCALE = W8_SCALE;
template <class E, class = void> struct EpiStage {
    static __device__ __forceinline__ void stage(const E&, PG8_LAS unsigned char*, const Unit&, int) {}
    template <class A> static __device__ __forceinline__ void run(const E& e, const A& acc, const Unit& u, int wr, int wc, int fr, int fq, PG8_LAS unsigned char*, int) { e(acc, u, wr, wc, fr, fq); } };
template <class E> struct EpiStage<E, decltype((void)E::HAS_STAGE)> {
    static __device__ __forceinline__ void stage(const E& e, PG8_LAS unsigned char* lds, const Unit& u, int wid) { e.stage(lds, u, wid); }
    template <class A> static __device__ __forceinline__ void run(const E& e, const A& acc, const Unit& u, int wr, int wc, int fr, int fq, PG8_LAS unsigned char* lds, int wid) { e(acc, u, wr, wc, fr, fq, lds, wid); } };
struct EpiSwigluI8 {
    static constexpr bool PERM = true, HAS_STAGE = true; static constexpr int NVM = 10;
    unsigned char* O; int ldc; const float* rs; const PG8_LAS float* wscL;
    __device__ __forceinline__ void stage(PG8_LAS unsigned char* lds, const Unit& u, int wid) const { stage_row_scales(lds, rs + u.pm * BM, wid); }
    __device__ __forceinline__ void operator()(const f32x4 (&acc)[2][2][4][2], const Unit& u, int wr, int wc, int fr, int fq, PG8_LAS unsigned char* lds, int wid) const {
        const int row0 = u.pm * BM + wr * 64 + fr; const int col0 = u.pn * HALF + wc * 32 + 8 * fq;
        float scv[2][4]; load_row_scales(lds, wid, fr, wscL[u.e], scv);
#pragma unroll
        for (int ai = 0; ai < 2; ++ai)
#pragma unroll
            for (int m = 0; m < 4; ++m) { const int row = row0 + ai * HALF + m * 16; const float sc = scv[ai][m]; unsigned char* rowp = O + (size_t)row * ldc + col0;
                typedef float f32x2v __attribute__((ext_vector_type(2))); typedef int i32x2 __attribute__((ext_vector_type(2)));
                const f32x2v sc2 = (f32x2v){sc, sc}, nl2 = (f32x2v){-1.44269504f, -1.44269504f}, one2 = (f32x2v){1.0f, 1.0f};
                f32x2v o[4];
#pragma unroll
                for (int n = 0; n < 2; ++n) { const v4i32 gi = __builtin_bit_cast(v4i32, acc[ai][0][m][n]), ui = __builtin_bit_cast(v4i32, acc[ai][1][m][n]);
#pragma unroll
                    for (int k = 0; k < 2; ++k) { const f32x2v g = (f32x2v){(float)gi[2 * k], (float)gi[2 * k + 1]} * sc2, up = (f32x2v){(float)ui[2 * k], (float)ui[2 * k + 1]} * sc2;
                        const f32x2v t = g * nl2; const f32x2v d = (f32x2v){__builtin_amdgcn_exp2f(t.x), __builtin_amdgcn_exp2f(t.y)} + one2;
                        o[n * 2 + k] = (g * (f32x2v){__builtin_amdgcn_rcpf(d.x), __builtin_amdgcn_rcpf(d.y)}) * up; } }
                int w0 = 0, w1 = 0;
                w0 = __builtin_amdgcn_cvt_pk_fp8_f32(o[0].x, o[0].y, w0, false); w0 = __builtin_amdgcn_cvt_pk_fp8_f32(o[1].x, o[1].y, w0, true);
                w1 = __builtin_amdgcn_cvt_pk_fp8_f32(o[2].x, o[2].y, w1, false); w1 = __builtin_amdgcn_cvt_pk_fp8_f32(o[3].x, o[3].y, w1, true);
                *(PG8_GAS i32x2*)rowp = (i32x2){w0, w1}; }
    }
};
template <class Epi, class Sched, bool ALIGN_EPI = false, bool SP2 = false, int MODE = 0>
__device__ __forceinline__ void gemm_phase(PG8_LAS unsigned char* lds, const int wv, const Gemm g, const Sched& S, const Epi& E) {
    int tid_ = wv * 64 + lane_id(); asm volatile("" : "+v"(tid_));
    const int tid = tid_, wid = __builtin_amdgcn_readfirstlane(tid >> 6), lane = tid & 63, wr = wid >> 2, wc = wid & 3, fr = lane & 15, fq = lane >> 4;
    constexpr bool FP8 = (MODE == 1), I8 = (MODE == 2);
    int K_ = g.K; asm volatile("" : "+s"(K_)); const int K = K_, nt = K / BK;
    unsigned voffA, voffB;
    { int R, C; stage_rc(tid * 16, R, C); const int Rb = Epi::PERM ? ((R & ~31) + perm32(R & 31)) : R;
        voffA = (unsigned)(R * K + C) * 2u; voffB = (unsigned)(Rb * K + C) * 2u; }
    const unsigned pstep = 64u * (unsigned)K * 2u;
    const unsigned kstep = (unsigned)(BK * 2);
    const unsigned hstep = (unsigned)HALF * (unsigned)K * 2u;
    const unsigned tstep = 2u * hstep;
    const unsigned ldsw = (unsigned)wid * 1024u;
    const char* const Ab = (const char*)g.A; const char* const Bb = (const char*)g.Bt;
    const int aoff = lds_byte(wr * 64 + fr, fq * 8), boff = lds_byte(wc * 32 + fr, fq * 8);
#define PG8_SA(b, h) (((b) * 2 + (h)) * HTB)
#define PG8_SB(b, h) ((4 + (b) * 2 + (h)) * HTB)
#define PG8_STAGE(bufoff, gbase, uoff, voff) do { _Pragma("unroll") for (int _i = 0; _i < 2; ++_i) \
        __builtin_amdgcn_global_load_lds((const unsigned*)((gbase) + (size_t)(unsigned)(((uoff) + _i * pstep) + (voff))), (PG8_LAS unsigned*)(lds + (bufoff) + ldsw + _i * 8192), 16, 0, 0); } while (0)
#define PG8_LDA(dst, b, h) do { _Pragma("unroll") for (int m = 0; m < 4; ++m) { if constexpr (FP8) { dst##8[m] = __builtin_shufflevector(*(const PG8_LAS v4i32*)(lds + PG8_SA(b, h) + aoff + m * 2048), *(const PG8_LAS v4i32*)(lds + PG8_SA(b, h) + aoff + m * 2048 + 1024), 0, 1, 2, 3, 4, 5, 6, 7); } else { \
        _Pragma("unroll") for (int k = 0; k < 2; ++k) dst[m][k] = *(const PG8_LAS bf16x8*)(lds + PG8_SA(b, h) + aoff + m * 2048 + k * 1024); } } } while (0)
#define PG8_LDB(dst, b, h) do { _Pragma("unroll") for (int n = 0; n < 2; ++n) { if constexpr (FP8) { dst##8[n] = __builtin_shufflevector(*(const PG8_LAS v4i32*)(lds + PG8_SB(b, h) + boff + n * 2048), *(const PG8_LAS v4i32*)(lds + PG8_SB(b, h) + boff + n * 2048 + 1024), 0, 1, 2, 3, 4, 5, 6, 7); } else { \
        _Pragma("unroll") for (int k = 0; k < 2; ++k) dst[n][k] = *(const PG8_LAS bf16x8*)(lds + PG8_SB(b, h) + boff + n * 2048 + k * 1024); } } } while (0)
#define PG8_MMA(ai, bj, At, Bt) do { __builtin_amdgcn_s_setprio(1); if constexpr (FP8) { _Pragma("unroll") for (int m = 0; m < 4; ++m) _Pragma("unroll") for (int n = 0; n < 2; ++n) \
        asm volatile("v_mfma_scale_f32_16x16x128_f8f6f4 %0, %1, %2, %0, %3, %3 op_sel_hi:[0,0,0]" : "+v"(acc[ai][bj][m][n]) : "v"(Bt##8[n]), "v"(At##8[m]), "v"(scl8)); } else { \
        _Pragma("unroll") for (int m = 0; m < 4; ++m) _Pragma("unroll") for (int n = 0; n < 2; ++n) _Pragma("unroll") for (int k = 0; k < 2; ++k) { if constexpr (I8) \
        acc[ai][bj][m][n] = __builtin_bit_cast(f32x4, __builtin_amdgcn_mfma_i32_16x16x64_i8(__builtin_bit_cast(v4i32, Bt[n][k]), __builtin_bit_cast(v4i32, At[m][k]), __builtin_bit_cast(v4i32, acc[ai][bj][m][n]), 0, 0, 0)); else \
        acc[ai][bj][m][n] = __builtin_amdgcn_mfma_f32_16x16x32_bf16(Bt[n][k], At[m][k], acc[ai][bj][m][n], 0, 0, 0); } } __builtin_amdgcn_s_setprio(0); } while (0)
#define PG8_WAIT_V(n) asm volatile("s_waitcnt vmcnt(" #n ")" ::: "memory")
#define PG8_WAIT_L(n) asm volatile("s_waitcnt lgkmcnt(" #n ")" ::: "memory")
#define PG8_WAIT_VR(rlx) asm volatile("s_cmp_lg_u32 %0, 0\n\ts_cbranch_scc1 1f\n\ts_waitcnt vmcnt(8)\n1:\n\ts_waitcnt vmcnt(%1)" :: "s"(rlx), "n"(8 + Epi::NVM) : "scc", "memory")
#define PG8_BAR __builtin_amdgcn_s_barrier()
#define PG8_SCHED __builtin_amdgcn_sched_barrier(0)
    Unit cur, nxt; int ui = 0;
    if (!S.next(0, cur)) return;
    EpiStage<Epi>::stage(E, lds, cur, wid);
    f32x4 acc[2][2][4][2];
#pragma unroll
    for (int a = 0; a < 2; ++a)
#pragma unroll
        for (int b = 0; b < 2; ++b)
#pragma unroll
            for (int m = 0; m < 4; ++m)
#pragma unroll
                for (int n = 0; n < 2; ++n) acc[a][b][m][n] = (f32x4){0.f, 0.f, 0.f, 0.f};
    int scl8 = W8_SCALE; asm volatile("" : "+v"(scl8));
    bf16x8 At[4][2], B0[2][2], B1[2][2]; v8i32 At8[4], B08[2], B18[2];
    unsigned cA = (unsigned)cur.pm * tstep, cB = (unsigned)cur.pn * tstep + cur.boff;
    if constexpr (SP2) {
        PG8_STAGE(PG8_SB(0, 0), Bb, cB, voffB); PG8_STAGE(PG8_SB(0, 1), Bb, cB + hstep, voffB); PG8_STAGE(PG8_SA(0, 0), Ab, cA, voffA); PG8_STAGE(PG8_SA(0, 1), Ab, cA + hstep, voffA);
        if (wr == 1) PG8_BAR;
        PG8_WAIT_V(2); PG8_BAR;
        PG8_STAGE(PG8_SB(1, 0), Bb, cB + kstep, voffB); PG8_STAGE(PG8_SA(1, 0), Ab, cA + kstep, voffA); PG8_STAGE(PG8_SB(1, 1), Bb, cB + hstep + kstep, voffB);
        PG8_WAIT_V(6); PG8_BAR;
    } else {
        PG8_STAGE(PG8_SB(0, 0), Bb, cB, voffB); PG8_STAGE(PG8_SA(0, 0), Ab, cA, voffA); PG8_STAGE(PG8_SB(0, 1), Bb, cB + hstep, voffB); PG8_STAGE(PG8_SA(0, 1), Ab, cA + hstep, voffA);
        if (wr == 1) PG8_BAR;
        PG8_WAIT_V(4); PG8_BAR;
        PG8_STAGE(PG8_SB(1, 0), Bb, cB + kstep, voffB); PG8_STAGE(PG8_SA(1, 0), Ab, cA + kstep, voffA); PG8_STAGE(PG8_SB(1, 1), Bb, cB + hstep + kstep, voffB);
        PG8_WAIT_V(6); PG8_BAR;
    }
    for (;;) {
        const bool has_next = S.next(ui + 1, nxt);
        const unsigned nA = has_next ? (unsigned)nxt.pm * tstep : cA, nB = has_next ? (unsigned)nxt.pn * tstep + nxt.boff : cB;
        int t = 0;
        do {
            const bool last = (t == nt - 2);
            const unsigned a1 = cA + (unsigned)(t + 1) * kstep;
            const unsigned a2 = last ? nA : cA + (unsigned)(t + 2) * kstep, b2 = last ? nB : cB + (unsigned)(t + 2) * kstep;
            const unsigned a3 = a2 + kstep, b3 = b2 + kstep;
            if constexpr (SP2) {
            const int rlx = __builtin_amdgcn_readfirstlane(((t == 0) && (ui > 0)) ? 1 : 0);
            PG8_LDB(B0, 0, 0); PG8_LDB(B1, 0, 1); PG8_SCHED; PG8_LDA(At, 0, 0); PG8_STAGE(PG8_SA(1, 1), Ab, a1 + hstep, voffA);
            PG8_WAIT_VR(rlx); PG8_WAIT_L(0); PG8_BAR; PG8_MMA(0, 0, At, B0); PG8_MMA(0, 1, At, B1); PG8_BAR; PG8_SCHED;
            PG8_LDA(At, 0, 1); PG8_STAGE(PG8_SB(0, 0), Bb, b2, voffB); PG8_STAGE(PG8_SB(0, 1), Bb, b2 + hstep, voffB); PG8_STAGE(PG8_SA(0, 0), Ab, a2, voffA);
            PG8_WAIT_VR(rlx); PG8_WAIT_L(0); PG8_BAR; PG8_MMA(1, 0, At, B0); PG8_MMA(1, 1, At, B1); PG8_BAR; PG8_SCHED;
            PG8_LDB(B0, 1, 0); PG8_LDB(B1, 1, 1); PG8_SCHED; PG8_LDA(At, 1, 0); PG8_STAGE(PG8_SA(0, 1), Ab, a2 + hstep, voffA);
            PG8_WAIT_V(8); PG8_WAIT_L(0); PG8_BAR; PG8_MMA(0, 0, At, B0); PG8_MMA(0, 1, At, B1); PG8_BAR; PG8_SCHED;
            PG8_LDA(At, 1, 1); PG8_STAGE(PG8_SB(1, 0), Bb, b3, voffB); PG8_STAGE(PG8_SB(1, 1), Bb, b3 + hstep, voffB); PG8_STAGE(PG8_SA(1, 0), Ab, a3, voffA);
            PG8_WAIT_V(8); PG8_WAIT_L(0); PG8_BAR; PG8_MMA(1, 0, At, B0); PG8_MMA(1, 1, At, B1); PG8_BAR; PG8_SCHED;
            } else {
            PG8_LDB(B0, 0, 0); PG8_SCHED; PG8_LDA(At, 0, 0); PG8_STAGE(PG8_SA(1, 1), Ab, a1 + hstep, voffA);
            PG8_WAIT_L(8); PG8_BAR; PG8_WAIT_L(0); PG8_MMA(0, 0, At, B0); PG8_BAR; PG8_SCHED;
            PG8_LDB(B1, 0, 1); PG8_STAGE(PG8_SB(0, 0), Bb, b2, voffB);
            PG8_BAR; PG8_WAIT_L(0); PG8_MMA(0, 1, At, B1); PG8_BAR;
            PG8_LDA(At, 0, 1); PG8_STAGE(PG8_SA(0, 0), Ab, a2, voffA);
            PG8_BAR; PG8_WAIT_L(0); PG8_MMA(1, 0, At, B0); PG8_BAR; PG8_SCHED;
            PG8_STAGE(PG8_SB(0, 1), Bb, b2 + hstep, voffB);
            PG8_WAIT_V(6); PG8_BAR; PG8_MMA(1, 1, At, B1); PG8_BAR;
            PG8_LDB(B0, 1, 0); PG8_SCHED; PG8_LDA(At, 1, 0); PG8_STAGE(PG8_SA(0, 1), Ab, a2 + hstep, voffA);
            PG8_WAIT_L(8); PG8_BAR; PG8_WAIT_L(0); PG8_MMA(0, 0, At, B0); PG8_BAR; PG8_SCHED;
            PG8_LDB(B1, 1, 1); PG8_STAGE(PG8_SB(1, 0), Bb, b3, voffB);
            PG8_BAR; PG8_WAIT_L(0); PG8_MMA(0, 1, At, B1); PG8_BAR;
            PG8_LDA(At, 1, 1); PG8_STAGE(PG8_SA(1, 0), Ab, a3, voffA);
            PG8_BAR; PG8_WAIT_L(0); PG8_MMA(1, 0, At, B0); PG8_BAR; PG8_SCHED;
            PG8_STAGE(PG8_SB(1, 1), Bb, b3 + hstep, voffB);
            PG8_WAIT_V(6); PG8_BAR; PG8_MMA(1, 1, At, B1); PG8_BAR;
            }
            t += 2;
        } while (t < nt);
        if constexpr (FP8) asm volatile("s_nop 15\n\ts_nop 15" ::: "memory");
        if constexpr (ALIGN_EPI) { if (wr == 0) PG8_BAR; }
        { int l2 = lane; asm volatile("" : "+v"(l2)); EpiStage<Epi>::run(E, acc, cur, wr, wc, l2 & 15, l2 >> 4, lds, wid); }
        if (!has_next) break;
#pragma unroll
        for (int a = 0; a < 2; ++a)
#pragma unroll
            for (int b = 0; b < 2; ++b)
#pragma unroll
                for (int m = 0; m < 4; ++m)
#pragma unroll
                    for (int n = 0; n < 2; ++n) acc[a][b][m][n] = (f32x4){0.f, 0.f, 0.f, 0.f};
        cur = nxt; cA = nA; cB = nB; ++ui; EpiStage<Epi>::stage(E, lds, cur, wid);
        if constexpr (ALIGN_EPI) { if (wr == 1) PG8_BAR; }
    }
    PG8_WAIT_V(0);
    if constexpr (!ALIGN_EPI) { if (wr == 0) PG8_BAR; }
    PG8_BAR;
#undef PG8_SA
#undef PG8_SB
#undef PG8_STAGE
#undef PG8_LDA
#undef PG8_LDB
#undef PG8_MMA
#undef PG8_WAIT_V
#undef PG8_WAIT_L
#undef PG8_WAIT_VR
#undef PG8_BAR
#undef PG8_SCHED
}
}

constexpr int BATCH = 16, SEQ = 2048, DM = 1024, T = BATCH * SEQ, DEPTH = 2;
constexpr int NCOL = 7424, FF = 2816, NEXP = 8;
constexpr int OFF_QA = 0, OFF_KA = 768, OFF_VA = 1536, OFF_QR = 2304, OFF_KR = 2816, OFF_VR = 3328, OFF_GR = 4352, OFF_GA = 5376, OFF_GT = 6400;
constexpr int PCOL = 5376, GCOL = 2048;
constexpr int CB = 8, TC = CB * SEQ, NCH = BATCH / CB;
constexpr float EPS = 1e-6f;
constexpr int NWAVES = 8;

constexpr size_t MiB = 1u << 20;
constexpr size_t WS_CTL = 0, CTL_ZERO_BYTES = 1 * MiB;
constexpr size_t WS_MOD = 1 * MiB;
constexpr size_t WS_ROPE = 2 * MiB;
constexpr size_t WS_ROUTEA = 3 * MiB;
constexpr size_t WS_ROUTEB = 4 * MiB;
constexpr size_t WS_ROUTEP = 4 * MiB + 512 * 1024;
constexpr size_t WS_WSCF = 5 * MiB + 160 * 1024;
constexpr size_t WS_RSS = 5 * MiB + 512 * 1024;
constexpr size_t WS_WSC = 5 * MiB + 128 * 1024;
constexpr size_t WS_RS = 5 * MiB + 256 * 1024;
constexpr size_t WS_BBASE = 5 * MiB;
constexpr size_t WS_WM = 6 * MiB;
constexpr size_t WM_WIN = 0, WM_WA = (size_t)NCOL * DM, WM_WR = WM_WA + (size_t)DM * 256 * 2, WM_WMIX = WM_WR + (size_t)DM * DM * 2, WM_END = WM_WMIX + (size_t)DM * DM * 2;
static_assert(WM_END <= 12 * MiB, "mixer weights");
constexpr size_t WS_WF = 18 * MiB;
constexpr size_t WF_GU = (size_t)2 * FF * DM, WF_D = (size_t)DM * FF, WF_E = WF_GU + WF_D;
static_assert(NEXP * WF_E <= 66 * MiB, "ffn weights");
constexpr size_t WS_H = 84 * MiB;
constexpr size_t WS_BIG = 116 * MiB;
constexpr size_t WS_XB = WS_BIG;
constexpr size_t WS_Y = WS_BIG + 64 * MiB;
constexpr size_t WS_RET = WS_Y;
constexpr size_t WS_PROJ = WS_BIG + 128 * MiB;
constexpr size_t WS_MRG = WS_PROJ;
constexpr size_t WS_G8 = WS_BIG + 296 * MiB;
constexpr size_t WS_OG = WS_BIG + 360 * MiB;
constexpr size_t OGR_B = 5 * MiB / 2;
constexpr size_t RPT_OFF = 3 * MiB / 2;
constexpr size_t WS_LSE = WS_BIG + 400 * MiB;
constexpr size_t WS_ATT = WS_BIG + 401 * MiB;
constexpr size_t WS_YS = WS_BIG + 64 * MiB;
constexpr size_t WS_SORT = WS_BIG + 64 * MiB;
constexpr size_t WS_U = WS_BIG + 196 * MiB;
constexpr size_t WS_END = WS_BIG + 417 * MiB;
static_assert((size_t)TC * PCOL * 2 <= 168 * MiB && (size_t)T * GCOL <= 64 * MiB && (size_t)264 * 256 * 1024 * 2 <= 132 * MiB && (size_t)264 * 256 * FF <= 182 * MiB && (size_t)3 * TC * 256 * 2 <= 24 * MiB && (size_t)CB * 8 * 16 * 8192 * 2 <= 16 * MiB && (size_t)T * DM * 2 <= 168 * MiB && (size_t)T * 256 * 2 <= 16 * MiB, "big map");

constexpr int CW_TMO = 0;
constexpr int CW_FMAX = 96;
constexpr int CW_WMAX = 80;
constexpr int CW_ECNT = 64;
constexpr int CW_RANK = 1024;
constexpr int CW_LBAR = 2048;
constexpr int CW_BAR = 4096;

constexpr int RING_BYTES = 131072;
constexpr int LDSCTL_OFF = RING_BYTES, MISC_OFF = LDSCTL_OFF + 320;
constexpr int LDS_BYTES = 147456;

#define GAS __attribute__((address_space(1)))
#define LAS __attribute__((address_space(3)))
typedef unsigned short bf16;
typedef unsigned v4u __attribute__((ext_vector_type(4)));
typedef unsigned v2u __attribute__((ext_vector_type(2)));
typedef int v4i __attribute__((ext_vector_type(4)));
typedef int v2i __attribute__((ext_vector_type(2)));
typedef float f32x4 __attribute__((ext_vector_type(4)));
typedef float f32x2 __attribute__((ext_vector_type(2)));
typedef short bf16x8 __attribute__((ext_vector_type(8)));
typedef short bf16x4 __attribute__((ext_vector_type(4)));
typedef GAS unsigned gu32;
#define RLX_AGENT __ATOMIC_RELAXED, __HIP_MEMORY_SCOPE_AGENT
#define LDS_WAIT() asm volatile("s_waitcnt lgkmcnt(0)" ::: "memory")
__device__ __forceinline__ unsigned f2bf(float f) { unsigned u = __builtin_bit_cast(unsigned, f); return (u + 0x7fffu + ((u >> 16) & 1u)) >> 16; }
__device__ __forceinline__ unsigned pk2(float lo, float hi) { return f2bf(lo) | (f2bf(hi) << 16); }
__device__ __forceinline__ float bflo(unsigned w) { return __builtin_bit_cast(float, w << 16); }
__device__ __forceinline__ float bfhi(unsigned w) { return __builtin_bit_cast(float, w & 0xffff0000u); }
__device__ __forceinline__ float bf2f(bf16 b) { return __builtin_bit_cast(float, (unsigned)b << 16); }

#define XB_TMO      128
#define XB_XCNT(j)  (256  + 64 * (j))
#define XB_XSUB(j)  (1280 + 64 * (j))
#define XB_XGEN(j)  (2304 + 64 * (j))
#define XB_TOP      3328
#define XB_TOPGEN   3392
#define XCD_BAR_WORDS 3456
#define XB_SPIN_CAP (1u << 22)

__device__ __forceinline__ unsigned xb_ld(unsigned* p)              { return __hip_atomic_load(p, __ATOMIC_RELAXED, __HIP_MEMORY_SCOPE_AGENT); }
__device__ __forceinline__ unsigned xb_add(unsigned* p, unsigned v) { return __hip_atomic_fetch_add(p, v, __ATOMIC_RELAXED, __HIP_MEMORY_SCOPE_AGENT); }
__device__ __forceinline__ unsigned xb_xcc_id() { return (unsigned)__builtin_amdgcn_s_getreg((3 << 11) | 20) & 0xFu; }
#define XB_SPIN(cond, bar) do { unsigned _sp = 0; while (cond) { __builtin_amdgcn_s_sleep(1); \
    if ((++_sp & 255u) == 0u) { if (xb_ld(&(bar)[XB_TMO])) break; if (_sp > XB_SPIN_CAP) { atomicAdd(&(bar)[XB_TMO], 1u); break; } } } } while (0)

struct XcdBarrier { unsigned* bar; unsigned x; volatile LAS unsigned* st; int wv; };

__device__ __forceinline__ XcdBarrier xcd_barrier_post(unsigned* bar, volatile LAS unsigned* st, int wv) {
    XcdBarrier b; b.bar = bar; b.x = xb_xcc_id(); b.st = st; b.wv = wv;
    if (wv == 0 && lane_id() == 0) (void)xb_add(&bar[XB_XCNT(b.x)], 1u);
    return b;
}
__device__ __forceinline__ void xcd_barrier_complete(unsigned* bar, unsigned x, unsigned& nloc, unsigned& nx) {
    const unsigned G = gridDim.x * gridDim.y * gridDim.z;
    unsigned sum, cnt, mine, sp = 0u;
    for (;;) {
        sum = 0u; cnt = 0u; mine = 0u;
#pragma unroll
        for (unsigned j = 0; j < 16; ++j) { const unsigned c = xb_ld(&bar[XB_XCNT(j)]); sum += c; cnt += (c > 0u) ? 1u : 0u; mine = (j == x) ? c : mine; }
        if (sum == G) break;
        __builtin_amdgcn_s_sleep(1);
        if ((++sp & 255u) == 0u) { if (xb_ld(&bar[XB_TMO])) break; if (sp > XB_SPIN_CAP) { atomicAdd(&bar[XB_TMO], 1u); break; } }
    }
    nloc = mine > 0u ? mine : 1u; nx = cnt > 0u ? cnt : 1u;
}
__device__ __forceinline__ void xcd_barrier(const XcdBarrier& b) {
    asm volatile("s_waitcnt vmcnt(0)" ::: "memory");
    __syncthreads();
    if (b.wv == 0 && lane_id() == 0) {
        unsigned* bar = b.bar;
        __builtin_amdgcn_s_waitcnt(0);
        unsigned nloc = b.st[0], nx = b.st[1];
        if (nloc == 0u) { xcd_barrier_complete(bar, b.x, nloc, nx); b.st[0] = nloc; b.st[1] = nx; }
        const unsigned old = xb_add(&bar[XB_XSUB(b.x)], 1u);
        const unsigned gen = old / nloc;
        if (old + 1u == (gen + 1u) * nloc) {
            __builtin_amdgcn_fence(__ATOMIC_RELEASE, "agent");
            asm volatile("s_waitcnt vmcnt(0)" ::: "memory");
            const unsigned og = xb_add(&bar[XB_TOP], 1u);
            const unsigned tg = og / nx;
            if (og + 1u == (tg + 1u) * nx) xb_add(&bar[XB_TOPGEN], 1u);
            else XB_SPIN(xb_ld(&bar[XB_TOPGEN]) == tg, bar);
            __builtin_amdgcn_fence(__ATOMIC_ACQUIRE, "agent");
            xb_add(&bar[XB_XGEN(b.x)], 1u);
            asm volatile("s_waitcnt vmcnt(0)" ::: "memory");
        } else {
            XB_SPIN(xb_ld(&bar[XB_XGEN(b.x)]) == gen, bar);
            __builtin_amdgcn_fence(__ATOMIC_ACQUIRE, "agent");
            asm volatile("s_waitcnt vmcnt(0)" ::: "memory");
        }
    }
    __syncthreads();
}

__device__ __forceinline__ void xl_barrier(gu32* ctl, unsigned* bar, int xi, int NR, int& gen, int wv) {
    asm volatile("s_waitcnt vmcnt(0)" ::: "memory");
    __syncthreads();
    if (wv == 0 && lane_id() == 0) {
        unsigned* c = (unsigned*)(ctl + CW_LBAR + 64 * xi);
        (void)xb_add(c, 1u);
        const unsigned target = (unsigned)NR * (unsigned)(gen + 1);
        XB_SPIN(xb_ld(c) < target, bar);
        __builtin_amdgcn_fence(__ATOMIC_ACQUIRE, "agent");
        asm volatile("s_waitcnt vmcnt(0)" ::: "memory");
    }
    __syncthreads();
    ++gen;
}

#define DPP_REDUCE(v, OP, IDENT) do { \
        v = OP(v, __builtin_bit_cast(float, __builtin_amdgcn_update_dpp(__builtin_bit_cast(int, v), __builtin_bit_cast(int, v), 0xB1, 0xF, 0xF, false)));    \
        v = OP(v, __builtin_bit_cast(float, __builtin_amdgcn_update_dpp(__builtin_bit_cast(int, v), __builtin_bit_cast(int, v), 0x4E, 0xF, 0xF, false)));    \
        v = OP(v, __builtin_bit_cast(float, __builtin_amdgcn_update_dpp(__builtin_bit_cast(int, v), __builtin_bit_cast(int, v), 0x141, 0xF, 0xF, false)));   \
        v = OP(v, __builtin_bit_cast(float, __builtin_amdgcn_update_dpp(__builtin_bit_cast(int, v), __builtin_bit_cast(int, v), 0x140, 0xF, 0xF, false)));   \
        v = OP(v, __builtin_bit_cast(float, __builtin_amdgcn_update_dpp(__builtin_bit_cast(int, (float)(IDENT)), __builtin_bit_cast(int, v), 0x142, 0xA, 0xF, false)));   \
        v = OP(v, __builtin_bit_cast(float, __builtin_amdgcn_update_dpp(__builtin_bit_cast(int, (float)(IDENT)), __builtin_bit_cast(int, v), 0x143, 0xC, 0xF, false)));   \
    } while (0)
__device__ __forceinline__ float dpp_add(float a, float b) { return a + b; }
__device__ __forceinline__ float wave_sum(float v) {
    DPP_REDUCE(v, dpp_add, 0.0f);
    return __builtin_bit_cast(float, __builtin_amdgcn_readlane(__builtin_bit_cast(int, v), 63));
}
__device__ __forceinline__ float wave_max_nonneg(float v) {
    DPP_REDUCE(v, fmaxf, 0.0f);
    return __builtin_bit_cast(float, __builtin_amdgcn_readlane(__builtin_bit_cast(int, v), 63));
}
__device__ __forceinline__ float sq4(f32x4 v) { return (v.x * v.x + v.y * v.y) + (v.z * v.z + v.w * v.w); }
__device__ __forceinline__ float log2_gamma(int h) { return log2f(1.0f - exp2f(-5.0f - (float)h)); }

__device__ __forceinline__ void cvt_item(const float* W, int N, int k0, int n0, bf16* WT, int K, int drow0, LAS float* scr, int lane) {
    float wv[32];
#pragma unroll
    for (int i = 0; i < 32; ++i) { const int kk = 2 * i + (lane >> 5); wv[i] = W[(size_t)(k0 + kk) * N + n0 + (lane & 31)]; }
#pragma unroll
    for (int i = 0; i < 32; ++i) { const int kk = 2 * i + (lane >> 5); scr[kk * 33 + (lane & 31)] = wv[i]; }
    LDS_WAIT(); asm volatile("" ::: "memory");
    const int c = lane & 7;
#pragma unroll
    for (int j = 0; j < 4; ++j) { const int n = (lane >> 3) + 8 * j; const LAS float* s = scr + (8 * c) * 33 + n;
        v4u o; o.x = pk2(s[0 * 33], s[1 * 33]); o.y = pk2(s[2 * 33], s[3 * 33]); o.z = pk2(s[4 * 33], s[5 * 33]); o.w = pk2(s[6 * 33], s[7 * 33]);
        *(GAS v4u*)(WT + (size_t)(drow0 + n) * K + k0 + 8 * c) = o; }
    LDS_WAIT(); asm volatile("" ::: "memory");
}

__device__ __forceinline__ void cvt_item8(const float* W, int N, int k0, int n0, unsigned char* WT, int K, int drow0, LAS float* scr, int lane) {
    float wv[32];
#pragma unroll
    for (int i = 0; i < 32; ++i) { const int kk = 2 * i + (lane >> 5); wv[i] = W[(size_t)(k0 + kk) * N + n0 + (lane & 31)]; }
#pragma unroll
    for (int i = 0; i < 32; ++i) { const int kk = 2 * i + (lane >> 5); scr[kk * 33 + (lane & 31)] = wv[i]; }
    LDS_WAIT(); asm volatile("" ::: "memory");
    const int c = lane & 3; const float sc = (float)(1 << pg8::W8_SHIFT);
#pragma unroll
    for (int j = 0; j < 2; ++j) { const int n = (lane >> 2) + 16 * j; const LAS float* sp = scr + (16 * c) * 33 + n;
        int w[4];
#pragma unroll
        for (int q = 0; q < 4; ++q) { int t = 0; t = __builtin_amdgcn_cvt_pk_fp8_f32(sp[(4 * q + 0) * 33] * sc, sp[(4 * q + 1) * 33] * sc, t, false); t = __builtin_amdgcn_cvt_pk_fp8_f32(sp[(4 * q + 2) * 33] * sc, sp[(4 * q + 3) * 33] * sc, t, true); w[q] = t; }
        *(GAS v4i*)(WT + (size_t)(drow0 + n) * K + k0 + 16 * c) = (v4i){w[0], w[1], w[2], w[3]}; }
    LDS_WAIT(); asm volatile("" ::: "memory");
}

__device__ __forceinline__ void cvt_item_i8(const float* W, int N, int k0, int n0, signed char* WT, int K, int drow0, float q, LAS float* scr, int lane) {
    float wv[32];
#pragma unroll
    for (int i = 0; i < 32; ++i) { const int kk = 2 * i + (lane >> 5); wv[i] = W[(size_t)(k0 + kk) * N + n0 + (lane & 31)]; }
#pragma unroll
    for (int i = 0; i < 32; ++i) { const int kk = 2 * i + (lane >> 5); scr[kk * 33 + (lane & 31)] = wv[i]; }
    LDS_WAIT(); asm volatile("" ::: "memory");
    const int c = lane & 3;
#pragma unroll
    for (int j = 0; j < 2; ++j) { const int n = (lane >> 2) + 16 * j; const LAS float* sp = scr + (16 * c) * 33 + n;
        int w[4];
#pragma unroll
        for (int t = 0; t < 4; ++t) { const int a = __float2int_rn(__builtin_amdgcn_fmed3f(sp[(4 * t + 0) * 33] * q, -127.f, 127.f)), b = __float2int_rn(__builtin_amdgcn_fmed3f(sp[(4 * t + 1) * 33] * q, -127.f, 127.f)), cc = __float2int_rn(__builtin_amdgcn_fmed3f(sp[(4 * t + 2) * 33] * q, -127.f, 127.f)), d = __float2int_rn(__builtin_amdgcn_fmed3f(sp[(4 * t + 3) * 33] * q, -127.f, 127.f));
            w[t] = (int)((unsigned)(a & 255) | ((unsigned)(b & 255) << 8) | ((unsigned)(cc & 255) << 16) | ((unsigned)(d & 255) << 24)); }
        *(GAS v4i*)(WT + (size_t)(drow0 + n) * K + k0 + 16 * c) = (v4i){w[0], w[1], w[2], w[3]}; }
    LDS_WAIT(); asm volatile("" ::: "memory");
}

struct Args { const float* in[20]; float* out; unsigned char* ws; int lo, hi; };
struct Frame {
    LAS unsigned char* lds;
    gu32* ctl;
    int G, wv;
    int xi, rank;
    int crow;
    __device__ __forceinline__ int NR_() const { return G >> 3; }
    __device__ __forceinline__ int vb_() const { return rank * 8 + xi; }
    __device__ __forceinline__ int vid_() const { return xi * (G >> 3) + rank; }
    float* out; unsigned char* ws;
};
__device__ __forceinline__ void fresh_ids(Frame& F) { int a = __builtin_amdgcn_readfirstlane(F.xi), b = __builtin_amdgcn_readfirstlane(F.rank); asm volatile("" : "+s"(a), "+s"(b)); F.xi = a; F.rank = b; }
enum { I_X = 0, I_C, I_WADA, I_BADA, I_NPM, I_WIN, I_WATT, I_WRET, I_WMIX, I_NPOM, I_NPF, I_WFG, I_WFU, I_WFD, I_WROUT, I_BROUT, I_WEG, I_WEU, I_WED, I_NPOF };

__device__ __forceinline__ void convert_mixer_weights(Frame& F, const Args& A_, int l) {
    int tid_ = F.wv * 64 + lane_id(); asm volatile("" : "+v"(tid_)); const int tid = tid_, lane = tid & 63, wave = __builtin_amdgcn_readfirstlane(tid >> 6), gw = blockIdx.x * NWAVES + wave, NGW = F.G * NWAVES;
    LAS float* scr = (LAS float*)(F.lds + wave * 16384);
    bf16* wm = (bf16*)(F.ws + WS_WM);
    constexpr int I_A = (256 / 64) * (DM / 32), I_R = (DM / 64) * (DM / 32), NIT = I_A + 2 * I_R;
    for (int it = gw; it < NIT; it += NGW) {
        int r = it;
        if (r < I_A) { const int nb = DM / 32, kb = r / nb, n0 = (r % nb) * 32; cvt_item(A_.in[I_WATT] + (size_t)l * 256 * DM, DM, kb * 64, n0, (bf16*)((char*)wm + WM_WA), 256, n0, scr, lane); continue; } r -= I_A;
        if (r < I_R) { const int nb = DM / 32, kb = r / nb, n0 = (r % nb) * 32; cvt_item(A_.in[I_WRET] + (size_t)l * DM * DM, DM, kb * 64, n0, (bf16*)((char*)wm + WM_WR), DM, n0, scr, lane); continue; } r -= I_R;
        { const int nb = DM / 32, kb = r / nb, n0 = (r % nb) * 32; cvt_item(A_.in[I_WMIX] + (size_t)l * DM * DM, DM, kb * 64, n0, (bf16*)((char*)wm + WM_WMIX), DM, n0, scr, lane); }
    }
}
__device__ __forceinline__ float max4(f32x4 v) { return fmaxf(fmaxf(fabsf(v.x), fabsf(v.y)), fmaxf(fabsf(v.z), fabsf(v.w))); }
__device__ __forceinline__ void absmax_phase(Frame& F, const Args& A_) {
    int tid_ = F.wv * 64 + lane_id(); asm volatile("" : "+v"(tid_)); const int tid = tid_, lane = tid & 63; const int b = blockIdx.x;
    if (F.G >= 256) {
        { constexpr int N4 = DM * NCOL / 4, SL = (N4 + 127) / 128; const int l = b & 1, sl = (b >> 1) & 127;
          if (b < 256) { const f32x4* W = (const f32x4*)(A_.in[I_WIN] + (size_t)l * DM * NCOL); const int end = (sl + 1) * SL < N4 ? (sl + 1) * SL : N4; float mx = 0.f;
            for (int i = sl * SL + tid; i < end; i += 8 * 512) { f32x4 v[8];
#pragma unroll
                for (int u = 0; u < 8; ++u) { const int ii = i + u * 512; v[u] = W[ii < end ? ii : i]; }
#pragma unroll
                for (int u = 0; u < 8; ++u) mx = fmaxf(mx, max4(v[u])); }
            mx = wave_max_nonneg(mx);
            if (lane == 0) __hip_atomic_fetch_max((unsigned*)(F.ctl + CW_WMAX + l), __builtin_bit_cast(unsigned, mx), RLX_AGENT); } }
        { constexpr int NH = 128 * FF / 4, N4 = 2 * NH, NS = 28, SL = (N4 + NS - 1) / NS; const int t = b % 9, sl = b / 9;
          if (sl < NS) { const f32x4* Wg = (const f32x4*)(t == 0 ? A_.in[I_WFG] : A_.in[I_WEG] + (size_t)(t - 1) * DM * FF); const f32x4* Wu = (const f32x4*)(t == 0 ? A_.in[I_WFU] : A_.in[I_WEU] + (size_t)(t - 1) * DM * FF);
            const int end = (sl + 1) * SL < N4 ? (sl + 1) * SL : N4; float mx = 0.f;
            for (int i = sl * SL + tid; i < end; i += 4 * 512) { f32x4 v[4];
#pragma unroll
                for (int u = 0; u < 4; ++u) { int ii = i + u * 512; if (ii >= end) ii = i; v[u] = ii < NH ? Wg[ii] : Wu[ii - NH]; }
#pragma unroll
                for (int u = 0; u < 4; ++u) mx = fmaxf(mx, max4(v[u])); }
            mx = wave_max_nonneg(mx);
            if (lane == 0) __hip_atomic_fetch_max((unsigned*)(F.ctl + CW_FMAX + t), __builtin_bit_cast(unsigned, mx), RLX_AGENT); } }
    } else {
        for (int l = 0; l < DEPTH; ++l) { constexpr int N4 = DM * NCOL / 4; const f32x4* W = (const f32x4*)(A_.in[I_WIN] + (size_t)l * DM * NCOL); float mx = 0.f;
            for (int i = b * 512 + tid; i < N4; i += F.G * 512) mx = fmaxf(mx, max4(W[i]));
            mx = wave_max_nonneg(mx);
            if (lane == 0) __hip_atomic_fetch_max((unsigned*)(F.ctl + CW_WMAX + l), __builtin_bit_cast(unsigned, mx), RLX_AGENT); }
        for (int t = 0; t < 9; ++t) { constexpr int NH = 128 * FF / 4; const f32x4* Wg = (const f32x4*)(t == 0 ? A_.in[I_WFG] : A_.in[I_WEG] + (size_t)(t - 1) * DM * FF); const f32x4* Wu = (const f32x4*)(t == 0 ? A_.in[I_WFU] : A_.in[I_WEU] + (size_t)(t - 1) * DM * FF); float mx = 0.f;
            for (int i = b * 512 + tid; i < NH; i += F.G * 512) mx = fmaxf(mx, fmaxf(max4(Wg[i]), max4(Wu[i])));
            mx = wave_max_nonneg(mx);
            if (lane == 0) __hip_atomic_fetch_max((unsigned*)(F.ctl + CW_FMAX + t), __builtin_bit_cast(unsigned, mx), RLX_AGENT); }
    }
}
__device__ __forceinline__ void convert_win(Frame& F, const Args& A_, int l) {
    int tid_ = F.wv * 64 + lane_id(); asm volatile("" : "+v"(tid_)); const int tid = tid_, lane = tid & 63, wave = __builtin_amdgcn_readfirstlane(tid >> 6), gw = blockIdx.x * NWAVES + wave, NGW = F.G * NWAVES;
    LAS float* scr = (LAS float*)(F.lds + wave * 16384);
    const float mx = fmaxf(__builtin_bit_cast(float, __hip_atomic_load((unsigned*)(F.ctl + CW_WMAX + l), RLX_AGENT)), 1e-30f);
    const float q = 127.0f / mx;
    if (blockIdx.x == 0 && tid == 0) ((float*)(F.ws + WS_WSC))[l] = mx * (1.0f / 127.0f);
    constexpr int I_IN = (DM / 64) * (NCOL / 32);
    for (int it = gw; it < I_IN; it += NGW) { const int nb = NCOL / 32, kb = it / nb, n0 = (it % nb) * 32;
        cvt_item_i8(A_.in[I_WIN] + (size_t)l * DM * NCOL, NCOL, kb * 64, n0, (signed char*)(F.ws + WS_WM + WM_WIN), DM, n0, q, scr, lane); }
}
__device__ __forceinline__ void convert_ffn_weights(Frame& F, const float* wg, const float* wu, const float* wd, int tmax0, int it_lo, int it_hi, int gwi, int ngw) {
    int tid_ = F.wv * 64 + lane_id(); asm volatile("" : "+v"(tid_)); const int tid = tid_, lane = tid & 63, wave = __builtin_amdgcn_readfirstlane(tid >> 6);
    LAS float* scr = (LAS float*)(F.lds + wave * 16384);
    constexpr int I_G = (DM / 64) * (FF / 32), I_D = (FF / 64) * (DM / 32), PER = 2 * I_G + I_D;
    for (int it = it_lo + gwi; it < it_hi; it += ngw) {
        const int e = it / PER; int r = it % PER;
        unsigned char* wgu_t = F.ws + WS_WF + (size_t)e * WF_E; unsigned char* wd_t = wgu_t + WF_GU;
        if (r < 2 * I_G) { const int up = r >= I_G; if (up) r -= I_G; const int nb = FF / 32, kb = r / nb, n0 = (r % nb) * 32;
            const float mx = 1.25f * fmaxf(__builtin_bit_cast(float, __hip_atomic_load((unsigned*)(F.ctl + CW_FMAX + tmax0 + e), RLX_AGENT)), 1e-30f);
            if (r == 0 && !up && lane == 0) ((float*)(F.ws + WS_WSCF))[e] = mx * (1.0f / 127.0f);
            cvt_item_i8((up ? wu : wg) + (size_t)e * DM * FF, FF, kb * 64, n0, (signed char*)wgu_t, DM, (n0 >> 7) * 256 + (n0 & 127) + (up ? 128 : 0), 127.0f / mx, scr, lane); continue; }
        r -= 2 * I_G;
        { const int nb = DM / 32, kb = r / nb, n0 = (r % nb) * 32; cvt_item8(wd + (size_t)e * FF * DM, DM, kb * 64, n0, wd_t, FF, n0, scr, lane); }
    }
}
constexpr int FFN_ITEMS = 2 * (DM / 64) * (FF / 32) + (FF / 64) * (DM / 32);

__device__ __forceinline__ void adaln_phase(Frame& F, const Args& A_) {
    int tid_ = F.wv * 64 + lane_id(); asm volatile("" : "+v"(tid_)); const int tid = tid_, lane = tid & 63, wave = __builtin_amdgcn_readfirstlane(tid >> 6), gw = blockIdx.x * NWAVES + wave, NGW = F.G * NWAVES; (void)lane; (void)gw; (void)NGW; (void)tid;
    LAS float* cact = (LAS float*)F.lds;
    LAS float* part = (LAS float*)(F.lds + 65536);
    const float* c = A_.in[I_C];
    for (int i = tid; i < BATCH * DM; i += 512) { const float v = c[i]; cact[i] = v / (1.0f + __expf(-v)); }
    __syncthreads();
    float* mod = (float*)(F.ws + WS_MOD);
    for (int item = blockIdx.x; item < DEPTH * 96; item += F.G) {
        const int l = item / 96, n0 = (item % 96) * 64, n = n0 + lane;
        const float* W = A_.in[I_WADA] + (size_t)l * DM * 6 * DM;
        float acc[16];
#pragma unroll
        for (int b = 0; b < 16; ++b) acc[b] = 0.f;
        const int kb = wave * 128;
        for (int k = kb; k < kb + 128; k += 16) {
            float wv[16];
#pragma unroll
            for (int i = 0; i < 16; ++i) wv[i] = W[(size_t)(k + i) * 6144 + n];
#pragma unroll
            for (int q = 0; q < 4; ++q)
#pragma unroll
                for (int b = 0; b < 16; ++b) { const f32x4 cv = *(const LAS f32x4*)(cact + b * DM + k + 4 * q); acc[b] += (cv.x * wv[4 * q] + cv.y * wv[4 * q + 1]) + (cv.z * wv[4 * q + 2] + cv.w * wv[4 * q + 3]); }
        }
#pragma unroll
        for (int b = 0; b < 16; ++b) part[(wave * 16 + b) * 64 + lane] = acc[b];
        __syncthreads();
        for (int o = tid; o < 1024; o += 512) { const int b = o >> 6, nn = o & 63; float s = 0.f;
#pragma unroll
            for (int w = 0; w < 8; ++w) s += part[(w * 16 + b) * 64 + nn];
            mod[((size_t)l * 16 + b) * 6144 + n0 + nn] = s + A_.in[I_BADA][(size_t)l * 6144 + n0 + nn]; }
        __syncthreads();
    }
}
__device__ __forceinline__ void rope_phase(Frame& F) {
    int tid_ = F.wv * 64 + lane_id(); asm volatile("" : "+v"(tid_)); const int tid = tid_, lane = tid & 63, wave = __builtin_amdgcn_readfirstlane(tid >> 6), gw = blockIdx.x * NWAVES + wave, NGW = F.G * NWAVES; (void)lane; (void)gw; (void)NGW; (void)tid;
    float* rope = (float*)(F.ws + WS_ROPE);
    for (int i = blockIdx.x * 512 + tid; i < SEQ * 32; i += F.G * 512) {
        const int pos = i >> 5, k = i & 31;
        const float inv = 1.0f / powf(10000.0f, (float)k / 32.0f);
        const float ang = (float)pos * inv;
        float s, c; sincosf(ang, &s, &c);
        rope[pos * 64 + k] = c; rope[pos * 64 + 32 + k] = s;
    }
}

__device__ __forceinline__ void norm_mod_store(const f32x4 (&v)[4], const float* gain, const float* sc, const float* sh, signed char* orow, float* rsp, int lane) {
    float ss = 0.f;
#pragma unroll
    for (int j = 0; j < 4; ++j) ss += sq4(v[j]);
    const float r = rsqrtf(wave_sum(ss) * (1.0f / DM) + EPS);
    f32x4 o[4]; float mx = 0.f;
#pragma unroll
    for (int j = 0; j < 4; ++j) { const int k = 4 * lane + 256 * j;
        const f32x4 g = *(const f32x4*)(gain + k), s1 = *(const f32x4*)(sc + k), s0 = *(const f32x4*)(sh + k);
        o[j] = (v[j] * r) * g * (s1 + 1.0f) + s0;
        mx = fmaxf(mx, fmaxf(fmaxf(fabsf(o[j].x), fabsf(o[j].y)), fmaxf(fabsf(o[j].z), fabsf(o[j].w)))); }
    mx = wave_max_nonneg(mx);
    mx = fmaxf(mx, 1e-20f);
    const float q = 127.0f / mx;
#pragma unroll
    for (int j = 0; j < 4; ++j) { const int k = 4 * lane + 256 * j;
        const int a = __float2int_rn(o[j].x * q), b = __float2int_rn(o[j].y * q), c = __float2int_rn(o[j].z * q), d = __float2int_rn(o[j].w * q);
        *(unsigned*)(orow + k) = (unsigned)(a & 255) | ((unsigned)(b & 255) << 8) | ((unsigned)(c & 255) << 16) | ((unsigned)(d & 255) << 24); }
    if (lane == 0) *rsp = mx * (1.0f / 127.0f);
}
__device__ __forceinline__ void norm_mod_store_reg(const f32x4 (&v)[4], const f32x4 (&vn)[4], const f32x4 (&vs)[4], signed char* orow, float* rsp, int lane) {
    float ss = 0.f;
#pragma unroll
    for (int j = 0; j < 4; ++j) ss += sq4(v[j]);
    const float r = rsqrtf(wave_sum(ss) * (1.0f / DM) + EPS);
    f32x4 o[4]; float mx = 0.f;
#pragma unroll
    for (int j = 0; j < 4; ++j) { o[j] = (v[j] * r) * vn[j] + vs[j];
        mx = fmaxf(mx, fmaxf(fmaxf(fabsf(o[j].x), fabsf(o[j].y)), fmaxf(fabsf(o[j].z), fabsf(o[j].w)))); }
    mx = wave_max_nonneg(mx);
    mx = fmaxf(mx, 1e-20f);
    const float q = 127.0f / mx;
#pragma unroll
    for (int j = 0; j < 4; ++j) { const int k = 4 * lane + 256 * j;
        const int a = __float2int_rn(o[j].x * q), b = __float2int_rn(o[j].y * q), c = __float2int_rn(o[j].z * q), d = __float2int_rn(o[j].w * q);
        *(unsigned*)(orow + k) = (unsigned)(a & 255) | ((unsigned)(b & 255) << 8) | ((unsigned)(c & 255) << 16) | ((unsigned)(d & 255) << 24); }
    if (lane == 0) *rsp = mx * (1.0f / 127.0f);
}
__device__ __forceinline__ void load_row_bf16(const bf16* row, f32x4 (&v)[4], int lane) {
#pragma unroll
    for (int j = 0; j < 4; ++j) { const v2u w = *(const v2u*)(row + 4 * lane + 256 * j); v[j] = (f32x4){bflo(w.x), bfhi(w.x), bflo(w.y), bfhi(w.y)}; }
}

constexpr int RW = 2;
__device__ __forceinline__ void phase_a(Frame& F, const Args& A_) {
    int tid_ = F.wv * 64 + lane_id(); asm volatile("" : "+v"(tid_)); const int tid = tid_, lane = tid & 63, wave = __builtin_amdgcn_readfirstlane(tid >> 6), gw = blockIdx.x * NWAVES + wave, NGW = F.G * NWAVES;
    const float* mod = (const float*)(F.ws + WS_MOD); signed char* hb = (signed char*)(F.ws + WS_H);
    const int WPB = NGW / BATCH, blw = gw / WPB, wi = gw % WPB, mbase = blw * SEQ, mend = mbase + SEQ;
    if (blw >= BATCH) return;
    const float* mb = mod + (size_t)blw * 6144;
    f32x4 vn[4], vs[4];
#pragma unroll
    for (int j = 0; j < 4; ++j) { const int k = 4 * lane + 256 * j; vn[j] = *(const f32x4*)(A_.in[I_NPM] + k) * (*(const f32x4*)(mb + 1024 + k) + 1.0f); vs[j] = *(const f32x4*)(mb + k); }
    f32x4 nx[RW][4];
#define PA_ISSUE(mm0) do { _Pragma("unroll") for (int r = 0; r < RW; ++r) { const int m = (mm0) + r * WPB < mend ? (mm0) + r * WPB : (mm0); \
        _Pragma("unroll") for (int j = 0; j < 4; ++j) nx[r][j] = *(const f32x4*)(A_.in[I_X] + (size_t)m * DM + 4 * lane + 256 * j); } } while (0)
    if (mbase + wi < mend) PA_ISSUE(mbase + wi);
    for (int m0 = mbase + wi; m0 < mend; m0 += RW * WPB) {
        f32x4 v[RW][4];
#pragma unroll
        for (int r = 0; r < RW; ++r)
#pragma unroll
            for (int j = 0; j < 4; ++j) v[r][j] = nx[r][j];
        if (m0 + RW * WPB < mend) PA_ISSUE(m0 + RW * WPB);
#pragma unroll
        for (int r = 0; r < RW; ++r) { const int m = m0 + r * WPB; if (m < mend) norm_mod_store_reg(v[r], vn, vs, hb + (size_t)m * DM, (float*)(F.ws + WS_RS) + m, lane); }
    }
#undef PA_ISSUE
}

template <bool L0, bool MOE>
__device__ __forceinline__ void phase_h_t(Frame& F, const Args& A_, int l, int ch, int bi, int nb, bool first) {
    constexpr bool moe = MOE;
    int tid_ = F.wv * 64 + lane_id(); asm volatile("" : "+v"(tid_)); const int tid = tid_, lane = tid & 63, wave = __builtin_amdgcn_readfirstlane(tid >> 6), gw = bi * NWAVES + wave, NGW = nb * NWAVES;
    const float* mod = (const float*)(F.ws + WS_MOD) + (size_t)l * 16 * 6144; unsigned char* h8 = F.ws + WS_H;
    const bf16* Y = (const bf16*)(F.ws + WS_Y);
    const float* xin = A_.in[I_X]; bf16* xb = (bf16*)(F.ws + WS_XB);
    LAS float* wr = (LAS float*)F.lds;
    LAS int* cntL = (LAS int*)(F.lds + MISC_OFF + 64);
    if (moe) {
        if (first) for (int i = tid; i < DM * NEXP; i += 512) wr[i] = A_.in[I_WROUT][i];
        if (tid < 8) cntL[tid] = 0;
        __syncthreads();
    }
    const float* gpost = A_.in[I_NPOM] + (size_t)l * DM; const float* gffn = A_.in[I_NPF] + (size_t)l * DM;
    const int WPB = NGW / CB, blw = gw / WPB, wi = gw % WPB, mbase = ch * TC + blw * SEQ, mend = mbase + SEQ;
    const float* mb = mod + (size_t)(ch * CB + blw) * 6144;
    f32x4 vg1[4], vgf[4];
#pragma unroll
    for (int j = 0; j < 4; ++j) { const int k = 4 * lane + 256 * j; vg1[j] = *(const f32x4*)(mb + 2048 + k) * *(const f32x4*)(gpost + k); vgf[j] = *(const f32x4*)(gffn + k) * (*(const f32x4*)(mb + 4096 + k) + 1.0f); }
    v2u ry[RW][4], rx[RW][4]; f32x4 rxf[RW][4];
#define PH_ISSUE(mm0) do { _Pragma("unroll") for (int r = 0; r < RW; ++r) { const int m = (mm0) + r * WPB < mend ? (mm0) + r * WPB : (mm0); \
        _Pragma("unroll") for (int j = 0; j < 4; ++j) { ry[r][j] = *(const v2u*)(Y + (size_t)m * DM + 4 * lane + 256 * j); \
            if (L0) rxf[r][j] = *(const f32x4*)(xin + (size_t)m * DM + 4 * lane + 256 * j); else rx[r][j] = *(const v2u*)(xb + (size_t)m * DM + 4 * lane + 256 * j); } } } while (0)
    constexpr bool PF = !MOE;
    if (PF && mbase + wi < mend) PH_ISSUE(mbase + wi);
    for (int m0 = mbase + wi; m0 < mend; m0 += RW * WPB) {
        const int NGWr = WPB;
        f32x4 y[RW][4], x[RW][4], h[RW][4]; float ss[RW], ss2[RW];
        f32x4 vsh[4];
#pragma unroll
        for (int j = 0; j < 4; ++j) vsh[j] = *(const f32x4*)(mb + 3072 + 4 * lane + 256 * j);
        if (!PF) PH_ISSUE(m0);
#pragma unroll
        for (int r = 0; r < RW; ++r)
#pragma unroll
            for (int j = 0; j < 4; ++j) { const v2u w = ry[r][j]; y[r][j] = (f32x4){bflo(w.x), bfhi(w.x), bflo(w.y), bfhi(w.y)};
                if (L0) x[r][j] = rxf[r][j]; else { const v2u u = rx[r][j]; x[r][j] = (f32x4){bflo(u.x), bfhi(u.x), bflo(u.y), bfhi(u.y)}; } }
        if (PF && m0 + RW * WPB < mend) PH_ISSUE(m0 + RW * WPB);
#pragma unroll
        for (int r = 0; r < RW; ++r) { ss[r] = 0.f;
#pragma unroll
            for (int j = 0; j < 4; ++j) ss[r] += sq4(y[r][j]); }
#pragma unroll
        for (int r = 0; r < RW; ++r) ss[r] = wave_sum(ss[r]);
#pragma unroll
        for (int r = 0; r < RW; ++r) { const int m = m0 + r * NGWr < mend ? m0 + r * NGWr : m0;
            const float rr = rsqrtf(ss[r] * (1.0f / DM) + EPS); ss2[r] = 0.f;
#pragma unroll
            for (int j = 0; j < 4; ++j) { const int k = 4 * lane + 256 * j;
                x[r][j] = x[r][j] + vg1[j] * (y[r][j] * rr);
                if (m0 + r * NGWr < mend) *(v2u*)(xb + (size_t)m * DM + k) = (v2u){pk2(x[r][j].x, x[r][j].y), pk2(x[r][j].z, x[r][j].w)};
                ss2[r] += sq4(x[r][j]); } }
#pragma unroll
        for (int r = 0; r < RW; ++r) ss2[r] = wave_sum(ss2[r]);
#pragma unroll
        for (int r = 0; r < RW; ++r) { const int m = m0 + r * NGWr < mend ? m0 + r * NGWr : m0;
            const float r2 = rsqrtf(ss2[r] * (1.0f / DM) + EPS); float mx = 0.f;
#pragma unroll
            for (int j = 0; j < 4; ++j) {
                h[r][j] = (x[r][j] * r2) * vgf[j] + vsh[j];
                mx = fmaxf(mx, fmaxf(fmaxf(fabsf(h[r][j].x), fabsf(h[r][j].y)), fmaxf(fabsf(h[r][j].z), fabsf(h[r][j].w)))); }
            mx = wave_max_nonneg(mx);
            mx = fmaxf(mx, 1e-20f); const float q = 127.0f / mx;
            if (m0 + r * NGWr < mend) {
#pragma unroll
                for (int j = 0; j < 4; ++j) { const int k = 4 * lane + 256 * j;
                    const int a = __float2int_rn(h[r][j].x * q), b = __float2int_rn(h[r][j].y * q), c = __float2int_rn(h[r][j].z * q), d = __float2int_rn(h[r][j].w * q);
                    *(unsigned*)(h8 + (size_t)m * DM + k) = (unsigned)(a & 255) | ((unsigned)(b & 255) << 8) | ((unsigned)(c & 255) << 16) | ((unsigned)(d & 255) << 24); }
                if (lane == 0) ((float*)(F.ws + WS_RS))[m] = mx * (1.0f / 127.0f); } }
        if (moe) {
            float lg[RW][8];
#pragma unroll
            for (int r = 0; r < RW; ++r) {
#pragma unroll
                for (int e = 0; e < 8; ++e) lg[r][e] = 0.f;
#pragma unroll
                for (int j = 0; j < 4; ++j)
#pragma unroll
                    for (int i = 0; i < 4; ++i) { const int k = 4 * lane + 256 * j + i; const f32x4 wa = *(const LAS f32x4*)(wr + k * 8), wb = *(const LAS f32x4*)(wr + k * 8 + 4); const float hv = h[r][j][i];
                        lg[r][0] += hv * wa.x; lg[r][1] += hv * wa.y; lg[r][2] += hv * wa.z; lg[r][3] += hv * wa.w; lg[r][4] += hv * wb.x; lg[r][5] += hv * wb.y; lg[r][6] += hv * wb.z; lg[r][7] += hv * wb.w; } }
#pragma unroll
            for (int e = 0; e < 8; ++e)
#pragma unroll
                for (int r = 0; r < RW; ++r) lg[r][e] = wave_sum(lg[r][e]) + A_.in[I_BROUT][e];
#pragma unroll
            for (int r = 0; r < RW; ++r) { const int m = m0 + r * NGWr;
                int e1 = 0; float v1 = lg[r][0];
#pragma unroll
                for (int e = 1; e < 8; ++e) if (lg[r][e] > v1) { v1 = lg[r][e]; e1 = e; }
                int e2 = -1; float v2 = -3.0e38f;
#pragma unroll
                for (int e = 0; e < 8; ++e) if (e != e1 && lg[r][e] > v2) { v2 = lg[r][e]; e2 = e; }
                const float p1 = 1.0f / (1.0f + __expf(v2 - v1)), p2 = 1.0f - p1;
                if (lane == 0 && m < mend) {
                    const int lr1 = __hip_atomic_fetch_add(cntL + e1, 1, __ATOMIC_RELAXED, __HIP_MEMORY_SCOPE_WORKGROUP);
                    const int lr2 = __hip_atomic_fetch_add(cntL + e2, 1, __ATOMIC_RELAXED, __HIP_MEMORY_SCOPE_WORKGROUP);
                    *(v4i*)(F.ws + WS_ROUTEA + (size_t)m * 16) = (v4i){e1, lr1, e2, lr2};
                    *(f32x2*)(F.ws + WS_ROUTEP + (size_t)m * 8) = (f32x2){p1, p2};
                } }
        }
    }
#undef PH_ISSUE
    if (moe) {
        __syncthreads();
        if (tid < 8) { const int c = cntL[tid]; const unsigned base = __hip_atomic_fetch_add((unsigned*)(F.ctl + CW_ECNT + tid), (unsigned)c, RLX_AGENT);
            ((int*)(F.ws + WS_BBASE))[(ch * 256 + bi) * 8 + tid] = (int)base; }
    }
}
__device__ __forceinline__ void phase_h(Frame& F, const Args& A_, int l, bool moe, int ch, int bi, int nb, bool first) {
    static_assert(DEPTH == 2, "layer 0 is the dense one and reads the f32 input, layer 1 the MoE one: only those two variants are instantiated");
    (void)moe;
    if (l == 0) phase_h_t<true, false>(F, A_, l, ch, bi, nb, first); else phase_h_t<false, true>(F, A_, l, ch, bi, nb, first);
}
__device__ __forceinline__ void phase_h2(Frame& F, int nb_first, int nb_last) {
    int tid_ = F.wv * 64 + lane_id(); asm volatile("" : "+v"(tid_)); const int tid = tid_, lane = tid & 63, wave = __builtin_amdgcn_readfirstlane(tid >> 6), gw = blockIdx.x * NWAVES + wave, NGW = F.G * NWAVES;
    LAS int* offL = (LAS int*)(F.lds + MISC_OFF + 96);
    LAS int* bbL = (LAS int*)F.lds;
    for (int i = tid; i < NCH * 256 * 8; i += 512) bbL[i] = ((const int*)(F.ws + WS_BBASE))[i];
    if (tid == 0) { int off = 0;
        for (int e = 0; e < 8; ++e) { const int c = (int)__hip_atomic_load((unsigned*)(F.ctl + CW_ECNT + e), RLX_AGENT); offL[e] = off; off += ((c + 255) >> 8) << 8; } }
    __syncthreads();
    const unsigned char* hb = F.ws + WS_H; unsigned char* sorted = F.ws + WS_SORT;
    constexpr int R4 = 4;
    for (int m0 = gw; m0 < T; m0 += R4 * NGW) {
        v4i a[R4]; v4u rowv[R4]; float rsv[R4];
#pragma unroll
        for (int q = 0; q < R4; ++q) { const int m = m0 + q * NGW < T ? m0 + q * NGW : m0;
            a[q] = *(const v4i*)(F.ws + WS_ROUTEA + (size_t)m * 16); rowv[q] = *(const v4u*)(hb + (size_t)m * DM + 16 * lane); rsv[q] = ((const float*)(F.ws + WS_RS))[m]; }
#pragma unroll
        for (int q = 0; q < R4; ++q) { const int m = m0 + q * NGW; if (m < T) {
            const int ch = m / TC, r = m % TC, nb = (ch == NCH - 1) ? nb_last : nb_first, WPB = nb * NWAVES / CB, bi = ((r / SEQ) * WPB + (r % SEQ) % WPB) / NWAVES;
            const int pos1 = offL[a[q].x] + bbL[(ch * 256 + bi) * 8 + a[q].x] + a[q].y, pos2 = offL[a[q].z] + bbL[(ch * 256 + bi) * 8 + a[q].z] + a[q].w;
            *(v4u*)(sorted + (size_t)pos1 * DM + 16 * lane) = rowv[q];
            *(v4u*)(sorted + (size_t)pos2 * DM + 16 * lane) = rowv[q];
            if (lane == 0) { *(v2i*)(F.ws + WS_ROUTEB + (size_t)m * 8) = (v2i){pos1, pos2}; ((float*)(F.ws + WS_RSS))[pos1] = rsv[q]; ((float*)(F.ws + WS_RSS))[pos2] = rsv[q]; } } }
    }
    __syncthreads();
}
__device__ __forceinline__ void phase_k(Frame& F, const Args& A_, int l, bool moe, int kb) {
    int tid_ = F.wv * 64 + lane_id(); asm volatile("" : "+v"(tid_)); const int tid = tid_, lane = tid & 63, wave = __builtin_amdgcn_readfirstlane(tid >> 6), gw = kb * NWAVES + wave, NGW = F.G * NWAVES;
    const float* mod = (const float*)(F.ws + WS_MOD) + (size_t)l * 16 * 6144; signed char* hb = (signed char*)(F.ws + WS_H);
    const bf16* ys = (const bf16*)(F.ws + WS_YS);
    const float* gpost = A_.in[I_NPOF] + (size_t)l * DM;
    const int WPB = NGW / BATCH, blw = gw / WPB, wi = gw % WPB, mbase = blw * SEQ, mend = mbase + SEQ;
    if (blw >= BATCH) return;
    const float* mb = mod + (size_t)blw * 6144; const float* mb2 = mb + 16 * 6144;
    f32x4 vg2[4], vn[4], vs[4];
#pragma unroll
    for (int j = 0; j < 4; ++j) { const int k = 4 * lane + 256 * j; vg2[j] = *(const f32x4*)(mb + 5120 + k) * *(const f32x4*)(gpost + k);
        if (l + 1 < DEPTH) { vn[j] = *(const f32x4*)(A_.in[I_NPM] + (size_t)(l + 1) * DM + k) * (*(const f32x4*)(mb2 + 1024 + k) + 1.0f); vs[j] = *(const f32x4*)(mb2 + k); } else { vn[j] = vg2[j]; vs[j] = vg2[j]; } }
    v2u rya[RW][4], ryb[RW][4], rxx[RW][4]; v2i npos[RW]; f32x2 np[RW], cp[RW];
#pragma unroll
    for (int r = 0; r < RW; ++r) { npos[r] = (v2i){0, 0}; np[r] = (f32x2){0.f, 0.f}; cp[r] = np[r]; }
#define PK_POS(mm0) do { _Pragma("unroll") for (int r = 0; r < RW; ++r) { const int m = (mm0) + r * WPB < mend ? (mm0) + r * WPB : mbase + wi; \
        npos[r] = *(const v2i*)(F.ws + WS_ROUTEB + (size_t)m * 8); np[r] = *(const f32x2*)(F.ws + WS_ROUTEP + (size_t)m * 8); } } while (0)
#define PK_ROWS(mm0) do { _Pragma("unroll") for (int r = 0; r < RW; ++r) { const int m = (mm0) + r * WPB < mend ? (mm0) + r * WPB : (mm0); \
        _Pragma("unroll") for (int j = 0; j < 4; ++j) { \
            if (moe) { rya[r][j] = *(const v2u*)(ys + (size_t)npos[r].x * DM + 4 * lane + 256 * j); ryb[r][j] = *(const v2u*)(ys + (size_t)npos[r].y * DM + 4 * lane + 256 * j); } \
            else rya[r][j] = *(const v2u*)(ys + (size_t)m * DM + 4 * lane + 256 * j); \
            rxx[r][j] = *(const v2u*)((const bf16*)(F.ws + WS_XB) + (size_t)m * DM + 4 * lane + 256 * j); } cp[r] = np[r]; } } while (0)
    if (mbase + wi < mend) { if (moe) PK_POS(mbase + wi); PK_ROWS(mbase + wi); if (moe) PK_POS(mbase + wi + RW * WPB); }
    for (int m0 = mbase + wi; m0 < mend; m0 += RW * WPB) {
        f32x4 y[RW][4], x[RW][4]; float ss[RW];
#pragma unroll
        for (int r = 0; r < RW; ++r) { const f32x2 p = cp[r];
#pragma unroll
            for (int j = 0; j < 4; ++j) { const v2u a = rya[r][j], u = rxx[r][j];
                if (moe) { const v2u b = ryb[r][j]; y[r][j] = (f32x4){bflo(a.x) * p.x + bflo(b.x) * p.y, bfhi(a.x) * p.x + bfhi(b.x) * p.y, bflo(a.y) * p.x + bflo(b.y) * p.y, bfhi(a.y) * p.x + bfhi(b.y) * p.y}; }
                else y[r][j] = (f32x4){bflo(a.x), bfhi(a.x), bflo(a.y), bfhi(a.y)};
                x[r][j] = (f32x4){bflo(u.x), bfhi(u.x), bflo(u.y), bfhi(u.y)}; } }
        if (m0 + RW * WPB < mend) { PK_ROWS(m0 + RW * WPB); if (moe) PK_POS(m0 + 2 * RW * WPB); }
#pragma unroll
        for (int r = 0; r < RW; ++r) { ss[r] = 0.f;
#pragma unroll
            for (int j = 0; j < 4; ++j) ss[r] += sq4(y[r][j]); }
#pragma unroll
        for (int r = 0; r < RW; ++r) ss[r] = wave_sum(ss[r]);
#pragma unroll
        for (int r = 0; r < RW; ++r) { const int m = m0 + r * WPB; if (m < mend) {
            const float rr = rsqrtf(ss[r] * (1.0f / DM) + EPS);
#pragma unroll
            for (int j = 0; j < 4; ++j) { const int k = 4 * lane + 256 * j;
                x[r][j] = x[r][j] + vg2[j] * (y[r][j] * rr);
                if (l + 1 < DEPTH) *(v2u*)((bf16*)(F.ws + WS_XB) + (size_t)m * DM + k) = (v2u){pk2(x[r][j].x, x[r][j].y), pk2(x[r][j].z, x[r][j].w)};
                else *(f32x4*)(F.out + (size_t)m * DM + k) = x[r][j]; }
            if (l + 1 < DEPTH) norm_mod_store_reg(x[r], vn, vs, hb + (size_t)m * DM, (float*)(F.ws + WS_RS) + m, lane); } }
    }
#undef PK_POS
#undef PK_ROWS
}

typedef short v4s16 __attribute__((ext_vector_type(4)));
__device__ __forceinline__ v2u tr4(const LAS bf16* tile, int stride, int r0, int c0, int fr) {
    const LAS bf16* p = tile + (r0 + (fr >> 2)) * stride + c0 + 4 * (fr & 3);
    return __builtin_bit_cast(v2u, __builtin_amdgcn_ds_read_tr16_b64_v4i16((LAS v4s16*)p));
}
#define LDS_BARRIER() asm volatile("s_waitcnt lgkmcnt(0)\n\ts_barrier" ::: "memory")
struct AttnPre { v4u q[2], k[4], v[4]; };
struct AttnId { int bl, g, h4, dsh, r, nbk, head; };
__device__ __forceinline__ AttnId attn_decode(int uid) {
    AttnId a; a.bl = uid / 192; int rem = uid % 192; a.g = rem >> 6; rem &= 63; a.h4 = rem >> 4; const int blk = rem & 15;
    a.dsh = 2 * a.g; const int d = 1 << a.dsh; a.r = blk & (d - 1); a.nbk = blk >> a.dsh; a.head = a.g * 4 + a.h4; return a;
}
__device__ __forceinline__ void attn_load(Frame& F, int uid, int tid, AttnPre& P) {
    const AttnId a = attn_decode(uid);
    const bf16* proj = (const bf16*)(F.ws + WS_PROJ);
#pragma unroll
    for (int k = 0; k < 2; ++k) { const int it = tid + 512 * k, i = it >> 3, c = it & 7; const size_t row = (size_t)a.bl * SEQ + (((size_t)a.nbk * 128 + i) << a.dsh) + a.r;
        P.q[k] = *(const v4u*)(proj + row * PCOL + OFF_QA + a.head * 64 + c * 8); }
#pragma unroll
    for (int k = 0; k < 4; ++k) { const int it = tid + 512 * k, kj = it >> 3, c = it & 7; const int si = (a.nbk - 1) * 128 + kj;
        P.k[k] = (v4u){0u, 0u, 0u, 0u}; P.v[k] = (v4u){0u, 0u, 0u, 0u};
        if (si >= 0) { const size_t row = (size_t)a.bl * SEQ + ((size_t)si << a.dsh) + a.r; P.k[k] = *(const v4u*)(proj + row * PCOL + OFF_KA + a.head * 64 + c * 8); P.v[k] = *(const v4u*)(proj + row * PCOL + OFF_VA + a.head * 64 + c * 8); } }
}
__device__ __forceinline__ void attn_stage(Frame& F, int tid, const AttnPre& P, bool np) {
    LAS bf16* Qs = (LAS bf16*)F.lds; LAS bf16* Ks = Qs + 128 * 72; LAS bf16* Vs = Ks + 256 * 72;
#pragma unroll
    for (int k = 0; k < 2; ++k) { const int it = tid + 512 * k, i = it >> 3, c = it & 7; *(LAS v4u*)(Qs + i * 72 + c * 8) = P.q[k]; }
#pragma unroll
    for (int k = 0; k < 4; ++k) { const int it = tid + 512 * k, kj = it >> 3, c = it & 7; if (!(np && k < 2)) *(LAS v4u*)(Ks + kj * 72 + c * 8) = P.k[k]; *(LAS v4u*)(Vs + kj * 72 + c * 8) = P.v[k]; }
}
__device__ __forceinline__ void attn_compute(Frame& F, int uid, int tid) {
    const int lane = tid & 63, w = __builtin_amdgcn_readfirstlane(tid >> 6), fr = lane & 15, qq = lane >> 4;
    const AttnId a = attn_decode(uid);
    const float slope_d = exp2f(-8.0f * (float)(a.head + 1) / 12.0f) * (float)(1 << a.dsh);
    const LAS bf16* Qs = (const LAS bf16*)F.lds; const LAS bf16* Ks = Qs + 128 * 72; const LAS bf16* Vs = Ks + 256 * 72;
    bf16x8 qf[2];
#pragma unroll
    for (int ks = 0; ks < 2; ++ks) qf[ks] = *(const LAS bf16x8*)(Qs + (16 * w + fr) * 72 + 32 * ks + 8 * qq);
    const int t0 = (a.nbk == 0) ? 8 - w : 0;
    f32x4 sc[9];
#pragma unroll
    for (int tt = 0; tt < 9; ++tt) { f32x4 acc = (f32x4){0.f, 0.f, 0.f, 0.f};
        if (tt >= t0) {
#pragma unroll
            for (int ks = 0; ks < 2; ++ks) { const bf16x8 av = *(const LAS bf16x8*)(Ks + (16 * (w + tt) + fr) * 72 + 32 * ks + 8 * qq); acc = __builtin_amdgcn_mfma_f32_16x16x32_bf16(av, qf[ks], acc, 0, 0, 0); } }
        sc[tt] = acc; }
    const int iq = 16 * w + fr; float mx = -3.0e38f;
#pragma unroll
    for (int tt = 0; tt < 9; ++tt) if (tt >= t0) {
#pragma unroll
        for (int i = 0; i < 4; ++i) { const int kj = 16 * (w + tt) + 4 * qq + i; const int dist = 128 + iq - kj; const bool valid = (dist >= 0) && (dist <= 128) && (a.nbk > 0 || kj >= 128);
            const float sv = valid ? (sc[tt][i] * 0.125f - slope_d * (float)dist) : -1.0e30f; sc[tt][i] = sv; mx = fmaxf(mx, sv); } }
    mx = fmaxf(mx, __shfl_xor(mx, 16)); mx = fmaxf(mx, __shfl_xor(mx, 32));
    float sum = 0.f;
#pragma unroll
    for (int tt = 0; tt < 9; ++tt) {
        if (tt >= t0) {
#pragma unroll
            for (int i = 0; i < 4; ++i) { const float p = __expf(sc[tt][i] - mx); sc[tt][i] = p; sum += p; }
        } else sc[tt] = (f32x4){0.f, 0.f, 0.f, 0.f}; }
    sum += __shfl_xor(sum, 16); sum += __shfl_xor(sum, 32);
    const float inv = 1.0f / sum;
    f32x4 oacc[4];
#pragma unroll
    for (int dt = 0; dt < 4; ++dt) oacc[dt] = (f32x4){0.f, 0.f, 0.f, 0.f};
#pragma unroll
    for (int s = 0; s < 5; ++s) if (2 * s + 1 >= t0) {
        v4u pw; pw.x = pk2(sc[2 * s][0] * inv, sc[2 * s][1] * inv); pw.y = pk2(sc[2 * s][2] * inv, sc[2 * s][3] * inv);
        if (s < 4) { pw.z = pk2(sc[2 * s + 1][0] * inv, sc[2 * s + 1][1] * inv); pw.w = pk2(sc[2 * s + 1][2] * inv, sc[2 * s + 1][3] * inv); } else { pw.z = 0u; pw.w = 0u; }
        const bf16x8 pf = __builtin_bit_cast(bf16x8, pw);
        const int key0 = 16 * (w + 2 * s) + 4 * qq; int key1 = key0 + 16; if (key1 > 252) key1 = 252;
#pragma unroll
        for (int dt = 0; dt < 4; ++dt) { const v2u lo = tr4(Vs, 72, key0, 16 * dt, fr), hi = tr4(Vs, 72, key1, 16 * dt, fr);
            const bf16x8 av = __builtin_bit_cast(bf16x8, (v4u){lo.x, lo.y, hi.x, hi.y}); oacc[dt] = __builtin_amdgcn_mfma_f32_16x16x32_bf16(av, pf, oacc[dt], 0, 0, 0); }
    }
    const size_t lrow = (((size_t)a.nbk * 128 + iq) << a.dsh) + a.r, row = (size_t)a.bl * SEQ + lrow;
    bf16* og = (bf16*)(F.ws + WS_OG) + (size_t)a.bl * OGR_B + ((size_t)a.g * SEQ + lrow) * 256 + a.h4 * 64;
#pragma unroll
    for (int dt = 0; dt < 4; ++dt) { v2u o; o.x = pk2(oacc[dt][0], oacc[dt][1]); o.y = pk2(oacc[dt][2], oacc[dt][3]); *(v2u*)(og + 16 * dt + 4 * qq) = o; }
    if (qq == 0) ((float*)(F.ws + WS_LSE))[((size_t)a.g * TC + row) * 4 + a.h4] = mx + __logf(sum);
}

__device__ __forceinline__ void rot8(const bf16* p, const float* rope, int pos, int d0, float scl, float (&o1)[8], float (&o2)[8]) {
    const v4u a = *(const v4u*)(p + d0), b = *(const v4u*)(p + d0 + 32);
    const float t1[8] = {bflo(a.x), bfhi(a.x), bflo(a.y), bfhi(a.y), bflo(a.z), bfhi(a.z), bflo(a.w), bfhi(a.w)};
    const float t2[8] = {bflo(b.x), bfhi(b.x), bflo(b.y), bfhi(b.y), bflo(b.z), bfhi(b.z), bflo(b.w), bfhi(b.w)};
    const f32x4 c0 = *(const f32x4*)(rope + pos * 64 + d0), c1 = *(const f32x4*)(rope + pos * 64 + d0 + 4), s0 = *(const f32x4*)(rope + pos * 64 + 32 + d0), s1 = *(const f32x4*)(rope + pos * 64 + 32 + d0 + 4);
    const float cs[8] = {c0.x, c0.y, c0.z, c0.w, c1.x, c1.y, c1.z, c1.w}, sn[8] = {s0.x, s0.y, s0.z, s0.w, s1.x, s1.y, s1.z, s1.w};
#pragma unroll
    for (int j = 0; j < 8; ++j) { o1[j] = (t1[j] * cs[j] - t2[j] * sn[j]) * scl; o2[j] = (t1[j] * sn[j] + t2[j] * cs[j]) * scl; }
}

struct KvPre { v4u k1, k2, v[4]; f32x4 c0, c1, s0, s1; };
__device__ __forceinline__ void kvseq_load(Frame& F, int bl, int h, int c, int tid, KvPre& P) {
    const bf16* proj = (const bf16*)(F.ws + WS_PROJ); const float* rope = (const float*)(F.ws + WS_ROPE);
    { const int j = tid >> 2, d0 = (tid & 3) * 8; const size_t row = (size_t)bl * SEQ + c * 128 + j; const int pos = c * 128 + j;
      const bf16* kp = proj + row * PCOL + OFF_KR + h * 64;
      P.k1 = *(const v4u*)(kp + d0); P.k2 = *(const v4u*)(kp + d0 + 32);
      P.c0 = *(const f32x4*)(rope + pos * 64 + d0); P.c1 = *(const f32x4*)(rope + pos * 64 + d0 + 4); P.s0 = *(const f32x4*)(rope + pos * 64 + 32 + d0); P.s1 = *(const f32x4*)(rope + pos * 64 + 32 + d0 + 4); }
#pragma unroll
    for (int k = 0; k < 4; ++k) { const int it = tid + 512 * k, j = it >> 4, cc = it & 15; const size_t row = (size_t)bl * SEQ + c * 128 + j;
        P.v[k] = *(const v4u*)(proj + row * PCOL + OFF_VR + h * 128 + cc * 8); }
}
__device__ __forceinline__ void rot8r(const v4u a, const v4u b, const f32x4 c0, const f32x4 c1, const f32x4 s0, const f32x4 s1, float scl, v4u& o1, v4u& o2) {
    const float t1[8] = {bflo(a.x), bfhi(a.x), bflo(a.y), bfhi(a.y), bflo(a.z), bfhi(a.z), bflo(a.w), bfhi(a.w)};
    const float t2[8] = {bflo(b.x), bfhi(b.x), bflo(b.y), bfhi(b.y), bflo(b.z), bfhi(b.z), bflo(b.w), bfhi(b.w)};
    const float cs[8] = {c0.x, c0.y, c0.z, c0.w, c1.x, c1.y, c1.z, c1.w}, sn[8] = {s0.x, s0.y, s0.z, s0.w, s1.x, s1.y, s1.z, s1.w};
    float r1[8], r2[8];
#pragma unroll
    for (int j = 0; j < 8; ++j) { r1[j] = (t1[j] * cs[j] - t2[j] * sn[j]) * scl; r2[j] = (t1[j] * sn[j] + t2[j] * cs[j]) * scl; }
    o1 = (v4u){pk2(r1[0], r1[1]), pk2(r1[2], r1[3]), pk2(r1[4], r1[5]), pk2(r1[6], r1[7])};
    o2 = (v4u){pk2(r2[0], r2[1]), pk2(r2[2], r2[3]), pk2(r2[4], r2[5]), pk2(r2[6], r2[7])};
}
__device__ __forceinline__ void kvseq_unit(Frame& F, int bh) {
    int tid_ = F.wv * 64 + lane_id(); asm volatile("" : "+v"(tid_)); const int tid = tid_, lane = tid & 63, w = __builtin_amdgcn_readfirstlane(tid >> 6), fr = lane & 15, qq = lane >> 4;
    const int bl = bh >> 3, h = bh & 7;
    const float l2g = log2_gamma(h), gam = exp2f(l2g), g127 = exp2f(127.0f * l2g), g128 = exp2f(128.0f * l2g);
    constexpr int KVB = 128 * 72 + 128 * 136;
    f32x4 st[4];
#pragma unroll
    for (int mt = 0; mt < 4; ++mt) st[mt] = (f32x4){0.f, 0.f, 0.f, 0.f};
    KvPre P0, P1; kvseq_load(F, bl, h, 0, tid, P0); kvseq_load(F, bl, h, 1, tid, P1);
    const float kscl = 0.125f * exp2f(-(float)(tid >> 2) * l2g);
    bf16* rpt = (bf16*)(F.ws + WS_OG) + (size_t)bl * OGR_B + RPT_OFF + (size_t)(h * 16) * 8192 + (size_t)(16 * w + fr) * 64 + 4 * qq;
#define KVSEQ_STEP(P, c, bufi) do { LAS bf16* Ks = (LAS bf16*)F.lds + (bufi) * KVB; LAS bf16* Vs = Ks + 128 * 72; \
        { const int j = tid >> 2, d0 = (tid & 3) * 8; v4u o1, o2; rot8r(P.k1, P.k2, P.c0, P.c1, P.s0, P.s1, kscl, o1, o2); \
          *(LAS v4u*)(Ks + j * 72 + d0) = o1; *(LAS v4u*)(Ks + j * 72 + d0 + 32) = o2; } \
        _Pragma("unroll") for (int k = 0; k < 4; ++k) { const int it = tid + 512 * k, j = it >> 4, cc = it & 15; *(LAS v4u*)(Vs + j * 136 + cc * 8) = P.v[k]; } \
        _Pragma("unroll") for (int mt = 0; mt < 4; ++mt) *(v2u*)(rpt + (size_t)(c) * 8192 + 16 * mt) = (v2u){pk2(gam * st[mt][0], gam * st[mt][1]), pk2(gam * st[mt][2], gam * st[mt][3])}; \
        LDS_BARRIER(); \
        if ((c) + 2 < 16) kvseq_load(F, bl, h, (c) + 2, tid, P); \
        f32x4 acc[4]; \
        _Pragma("unroll") for (int mt = 0; mt < 4; ++mt) acc[mt] = (f32x4){0.f, 0.f, 0.f, 0.f}; \
        _Pragma("unroll") for (int ks = 0; ks < 4; ++ks) { \
            const v2u blo = tr4(Vs, 136, 32 * ks + 4 * qq, 16 * w, fr), bhi = tr4(Vs, 136, 32 * ks + 16 + 4 * qq, 16 * w, fr); \
            const bf16x8 bv = __builtin_bit_cast(bf16x8, (v4u){blo.x, blo.y, bhi.x, bhi.y}); \
            _Pragma("unroll") for (int mt = 0; mt < 4; ++mt) { \
                const v2u alo = tr4(Ks, 72, 32 * ks + 4 * qq, 16 * mt, fr), ahi = tr4(Ks, 72, 32 * ks + 16 + 4 * qq, 16 * mt, fr); \
                acc[mt] = __builtin_amdgcn_mfma_f32_16x16x32_bf16(__builtin_bit_cast(bf16x8, (v4u){alo.x, alo.y, ahi.x, ahi.y}), bv, acc[mt], 0, 0, 0); } } \
        _Pragma("unroll") for (int mt = 0; mt < 4; ++mt) st[mt] = st[mt] * g128 + acc[mt] * g127; } while (0)
    for (int c = 0; c < 16; c += 2) { KVSEQ_STEP(P0, c, 0); KVSEQ_STEP(P1, c + 1, 1); }
    LDS_BARRIER();
#undef KVSEQ_STEP
}
__device__ __forceinline__ void merge_items(Frame& F) {
    int tid_ = F.wv * 64 + lane_id(); asm volatile("" : "+v"(tid_)); const int tid = tid_;
    const bf16* og = (const bf16*)(F.ws + WS_OG) + (size_t)F.xi * OGR_B; const float* lse = (const float*)(F.ws + WS_LSE); bf16* att = (bf16*)(F.ws + WS_ATT) + (size_t)F.crow * 256;
    const int istr = F.NR_() * 512;
    for (int item0 = F.rank * 512 + tid; item0 < SEQ * 32; item0 += 4 * istr) {
        float l0[4], l1[4], l2[4]; v4u a[4], b[4], c[4];
#pragma unroll
        for (int q = 0; q < 4; ++q) { const int item = item0 + q * istr < SEQ * 32 ? item0 + q * istr : item0; const int row = F.xi * SEQ + (item >> 5), ch = item & 31, h4 = ch >> 3;
            l0[q] = lse[((size_t)0 * TC + row) * 4 + h4]; l1[q] = lse[((size_t)1 * TC + row) * 4 + h4]; l2[q] = lse[((size_t)2 * TC + row) * 4 + h4];
            const size_t lr = (size_t)(item >> 5) * 256 + ch * 8;
            a[q] = *(const v4u*)(og + lr); b[q] = *(const v4u*)(og + (size_t)SEQ * 256 + lr); c[q] = *(const v4u*)(og + (size_t)2 * SEQ * 256 + lr); }
#pragma unroll
        for (int q = 0; q < 4; ++q) { const int item = item0 + q * istr; if (item < SEQ * 32) { const int row = F.xi * SEQ + (item >> 5), ch = item & 31;
            const float mx = fmaxf(l0[q], fmaxf(l1[q], l2[q])); float w0 = __expf(l0[q] - mx), w1 = __expf(l1[q] - mx), w2 = __expf(l2[q] - mx); const float inv = 1.0f / (w0 + w1 + w2); w0 *= inv; w1 *= inv; w2 *= inv;
            v4u o;
            o.x = pk2(w0 * bflo(a[q].x) + w1 * bflo(b[q].x) + w2 * bflo(c[q].x), w0 * bfhi(a[q].x) + w1 * bfhi(b[q].x) + w2 * bfhi(c[q].x));
            o.y = pk2(w0 * bflo(a[q].y) + w1 * bflo(b[q].y) + w2 * bflo(c[q].y), w0 * bfhi(a[q].y) + w1 * bfhi(b[q].y) + w2 * bfhi(c[q].y));
            o.z = pk2(w0 * bflo(a[q].z) + w1 * bflo(b[q].z) + w2 * bflo(c[q].z), w0 * bfhi(a[q].z) + w1 * bfhi(b[q].z) + w2 * bfhi(c[q].z));
            o.w = pk2(w0 * bflo(a[q].w) + w1 * bflo(b[q].w) + w2 * bflo(c[q].w), w0 * bfhi(a[q].w) + w1 * bfhi(b[q].w) + w2 * bfhi(c[q].w));
            *(v4u*)(att + (size_t)row * 256 + ch * 8) = o; } }
    }
}
struct RetPre { v4u q1, q2, k1, k2, v[4], r[2]; f32x4 c0, c1, s0, s1; };
__device__ __forceinline__ void ret_load(Frame& F, int kid, int tid, RetPre& P) {
    const int bh = kid >> 4, c = kid & 15, bl = bh >> 3, h = bh & 7;
    const bf16* proj = (const bf16*)(F.ws + WS_PROJ); const float* rope = (const float*)(F.ws + WS_ROPE);
    { const int j = tid >> 2, d0 = (tid & 3) * 8; const size_t row = (size_t)bl * SEQ + c * 128 + j; const int pos = c * 128 + j;
      const bf16* qp = proj + row * PCOL + OFF_QR + h * 64; const bf16* kp = proj + row * PCOL + OFF_KR + h * 64;
      P.q1 = *(const v4u*)(qp + d0); P.q2 = *(const v4u*)(qp + d0 + 32); P.k1 = *(const v4u*)(kp + d0); P.k2 = *(const v4u*)(kp + d0 + 32);
      P.c0 = *(const f32x4*)(rope + pos * 64 + d0); P.c1 = *(const f32x4*)(rope + pos * 64 + d0 + 4); P.s0 = *(const f32x4*)(rope + pos * 64 + 32 + d0); P.s1 = *(const f32x4*)(rope + pos * 64 + 32 + d0 + 4); }
#pragma unroll
    for (int k = 0; k < 4; ++k) { const int it = tid + 512 * k, j = it >> 4, cc = it & 15; const size_t row = (size_t)bl * SEQ + c * 128 + j;
        P.v[k] = *(const v4u*)(proj + row * PCOL + OFF_VR + h * 128 + cc * 8); }
    { const bf16* rp = (const bf16*)(F.ws + WS_OG) + (size_t)bl * OGR_B + RPT_OFF + (size_t)(kid & 127) * 8192;
#pragma unroll
      for (int k = 0; k < 2; ++k) { const int it = tid + 512 * k, dv = it >> 3, cc = it & 7; P.r[k] = *(const v4u*)(rp + dv * 64 + cc * 8); } }
}
__device__ __forceinline__ void ret_stage(Frame& F, int kid, int tid, const RetPre& P) {
    const int h = (kid >> 4) & 7; const float l2g = log2_gamma(h);
    LAS bf16* Qs = (LAS bf16*)F.lds; LAS bf16* Ks = Qs + 128 * 72; LAS bf16* Rs = Ks + 128 * 72; LAS bf16* Vs = Rs + 128 * 72;
    { const int j = tid >> 2, d0 = (tid & 3) * 8; v4u o1, o2;
      rot8r(P.q1, P.q2, P.c0, P.c1, P.s0, P.s1, exp2f((float)j * l2g), o1, o2);
      *(LAS v4u*)(Qs + j * 72 + d0) = o1; *(LAS v4u*)(Qs + j * 72 + d0 + 32) = o2;
      rot8r(P.k1, P.k2, P.c0, P.c1, P.s0, P.s1, 0.125f * exp2f(-(float)j * l2g), o1, o2);
      *(LAS v4u*)(Ks + j * 72 + d0) = o1; *(LAS v4u*)(Ks + j * 72 + d0 + 32) = o2; }
#pragma unroll
    for (int k = 0; k < 4; ++k) { const int it = tid + 512 * k, j = it >> 4, cc = it & 15; *(LAS v4u*)(Vs + j * 136 + cc * 8) = P.v[k]; }
#pragma unroll
    for (int k = 0; k < 2; ++k) { const int it = tid + 512 * k, dv = it >> 3, cc = it & 7; *(LAS v4u*)(Rs + dv * 72 + cc * 8) = P.r[k]; }
}
constexpr int RET_GS_OFF = (128 * 72 * 3 + 128 * 136) * 2;
__device__ __forceinline__ void ret_gate_dma(Frame& F, int kid, int tid) {
    const int lane = tid & 63, w = __builtin_amdgcn_readfirstlane(tid >> 6);
    const int bh = kid >> 4, c = kid & 15, bl = bh >> 3, h = bh & 7;
    const bf16* gp = (const bf16*)(F.ws + WS_PROJ) + ((size_t)bl * SEQ + c * 128 + 16 * w) * PCOL + OFF_GR + h * 128;
    asm volatile("" ::: "memory");
#pragma unroll
    for (int k = 0; k < 4; ++k) { const int p = k * 64 + lane, r = p >> 4, cc = (p & 15) ^ r;
        __builtin_amdgcn_global_load_lds((const unsigned*)(gp + (size_t)r * PCOL + cc * 8), (LAS unsigned*)(F.lds + RET_GS_OFF + w * 4096 + k * 1024), 16, 0, 0); }
    asm volatile("" ::: "memory");
}
constexpr int RET_NLOADS = 14;
__device__ __forceinline__ void ret_compute(Frame& F, int kid, int tid, bool younger) {
    const int lane = tid & 63, w = __builtin_amdgcn_readfirstlane(tid >> 6), fr = lane & 15, qq = lane >> 4;
    const int bh = kid >> 4, c = kid & 15, bl = bh >> 3, h = bh & 7;
    const bf16* proj = (const bf16*)(F.ws + WS_PROJ);
    const LAS bf16* Qs = (const LAS bf16*)F.lds;
    const LAS bf16* Ks = Qs + 128 * 72;
    const LAS bf16* Rs = Ks + 128 * 72;
    const LAS bf16* Vs = Rs + 128 * 72;
    bf16x8 qf[2];
#pragma unroll
    for (int ks = 0; ks < 2; ++ks) qf[ks] = *(const LAS bf16x8*)(Qs + (16 * w + fr) * 72 + 32 * ks + 8 * qq);
    f32x4 oacc[8];
#pragma unroll
    for (int dt = 0; dt < 8; ++dt) oacc[dt] = (f32x4){0.f, 0.f, 0.f, 0.f};
    const int iq = 16 * w + fr;
#pragma unroll
    for (int s = 0; s < 4; ++s) {
        if (2 * s <= w) {
            f32x4 sa = (f32x4){0.f, 0.f, 0.f, 0.f}, sb = (f32x4){0.f, 0.f, 0.f, 0.f};
#pragma unroll
            for (int ks = 0; ks < 2; ++ks) { const bf16x8 av = *(const LAS bf16x8*)(Ks + (32 * s + fr) * 72 + 32 * ks + 8 * qq); sa = __builtin_amdgcn_mfma_f32_16x16x32_bf16(av, qf[ks], sa, 0, 0, 0); }
            if (2 * s + 1 <= w) {
#pragma unroll
                for (int ks = 0; ks < 2; ++ks) { const bf16x8 av = *(const LAS bf16x8*)(Ks + (32 * s + 16 + fr) * 72 + 32 * ks + 8 * qq); sb = __builtin_amdgcn_mfma_f32_16x16x32_bf16(av, qf[ks], sb, 0, 0, 0); }
            }
#pragma unroll
            for (int i = 0; i < 4; ++i) { const int ka = 32 * s + 4 * qq + i; if (ka > iq) sa[i] = 0.f; if (ka + 16 > iq) sb[i] = 0.f; }
            const bf16x8 pf = __builtin_bit_cast(bf16x8, (v4u){pk2(sa[0], sa[1]), pk2(sa[2], sa[3]), pk2(sb[0], sb[1]), pk2(sb[2], sb[3])});
#pragma unroll
            for (int dt = 0; dt < 8; ++dt) { const v2u lo = tr4(Vs, 136, 32 * s + 4 * qq, 16 * dt, fr), hi = tr4(Vs, 136, 32 * s + 16 + 4 * qq, 16 * dt, fr);
                const bf16x8 av = __builtin_bit_cast(bf16x8, (v4u){lo.x, lo.y, hi.x, hi.y}); oacc[dt] = __builtin_amdgcn_mfma_f32_16x16x32_bf16(av, pf, oacc[dt], 0, 0, 0); }
        }
    }
#pragma unroll
    for (int dt = 0; dt < 8; ++dt)
#pragma unroll
        for (int ks = 0; ks < 2; ++ks) { const bf16x8 av = *(const LAS bf16x8*)(Rs + (16 * dt + fr) * 72 + 32 * ks + 8 * qq); oacc[dt] = __builtin_amdgcn_mfma_f32_16x16x32_bf16(av, qf[ks], oacc[dt], 0, 0, 0); }
    float ss = 0.f;
#pragma unroll
    for (int dt = 0; dt < 8; ++dt) ss += sq4(oacc[dt]);
    ss += __shfl_xor(ss, 16); ss += __shfl_xor(ss, 32);
    const float rn = rsqrtf(ss * (1.0f / 128.0f) + EPS);
    const size_t row = (size_t)bl * SEQ + c * 128 + iq;
    bf16* rp = (bf16*)(F.ws + WS_RET) + (row + (size_t)F.crow) * DM + h * 128;
    if (younger) asm volatile("s_waitcnt vmcnt(%0)" :: "n"(RET_NLOADS) : "memory"); else asm volatile("s_waitcnt vmcnt(0)" ::: "memory");
    const LAS unsigned char* gs = F.lds + RET_GS_OFF + w * 4096 + fr * 256 + (qq & 1) * 8;
#pragma unroll
    for (int dt = 0; dt < 8; ++dt) { const v2u gw2 = *(const LAS v2u*)(gs + (((2 * dt + (qq >> 1)) ^ fr) << 4));
        const float g0 = bflo(gw2.x), g1 = bfhi(gw2.x), g2 = bflo(gw2.y), g3 = bfhi(gw2.y);
        v2u o; o.x = pk2(g0 * pg8::sigm(g0) * oacc[dt][0] * rn, g1 * pg8::sigm(g1) * oacc[dt][1] * rn); o.y = pk2(g2 * pg8::sigm(g2) * oacc[dt][2] * rn, g3 * pg8::sigm(g3) * oacc[dt][3] * rn);
        *(v2u*)(rp + 16 * dt + 4 * qq) = o; }
}

__device__ __forceinline__ void c2_phase(Frame& F) {
    fresh_ids(F);
    int tid_ = F.wv * 64 + lane_id(); asm volatile("" : "+v"(tid_)); const int tid = tid_;
    const int nu = (F.rank < 128) ? (128 - F.rank + F.NR_() - 1) / F.NR_() : 0, k0 = F.xi * 128 + F.rank;
    RetPre P;
    if (nu > 0) ret_load(F, k0, tid, P);
    merge_items(F);
    for (int k = 0; k < nu; ++k) {
        ret_stage(F, k0 + k * F.NR_(), tid, P);
        ret_gate_dma(F, k0 + k * F.NR_(), tid);
        LDS_BARRIER();
        if (k + 1 < nu) ret_load(F, k0 + (k + 1) * F.NR_(), tid, P);
        ret_compute(F, k0 + k * F.NR_(), tid, k + 1 < nu);
        LDS_BARRIER();
    }
}

__device__ __forceinline__ void c1_phase(Frame& F) {
    fresh_ids(F);
    int tid_ = F.wv * 64 + lane_id(); asm volatile("" : "+v"(tid_)); const int tid = tid_;
    const bool split = F.NR_() > 8;
    const int a0 = split ? F.rank - 8 : F.rank, astride = split ? F.NR_() - 8 : F.NR_();
    const int na = (split && F.rank < 8) ? 0 : (a0 < 192 ? (192 - a0 + astride - 1) / astride : 0), ab = F.xi * 192;
    for (int repa = 0; repa < REP_C1A; ++repa)
    if (na > 0) {
        AttnPre P; attn_load(F, ab + a0, tid, P);
        for (int k = 0; k < na; ++k) {
            attn_stage(F, tid, P, attn_decode(ab + a0 + k * astride).nbk == 0);
            LDS_BARRIER();
            if (k + 1 < na) attn_load(F, ab + a0 + (k + 1) * astride, tid, P);
            attn_compute(F, ab + a0 + k * astride, tid);
            LDS_BARRIER();
        }
    }
    for (int repk = 0; repk < REP_C1K; ++repk)
    if (split) { if (F.rank < 8) kvseq_unit(F, F.xi * 8 + F.rank); }
    else { for (int u = F.rank; u < 8; u += F.NR_()) kvseq_unit(F, F.xi * 8 + u); }
}

constexpr int STEPS_L0 = NCH * 5 + 1 + 2 + 1, STEPS_L1 = NCH * 5 + 1 + 1 + 2 + 1, NSTEPS = 2 + STEPS_L0 + STEPS_L1;

#ifndef NVG
#define NVG
#endif
#ifndef LBW
#define LBW 2
#endif
__global__ void __launch_bounds__(NWAVES * 64, LBW) NVG fwd(const Args args) {
    extern __shared__ __attribute__((aligned(16))) unsigned char lds_raw[];
    Frame F;
    F.lds = (LAS unsigned char*)lds_raw;
    F.G = gridDim.x; F.wv = __builtin_amdgcn_readfirstlane(threadIdx.x >> 6);
    F.ws = args.ws; F.out = args.out; F.ctl = (gu32*)(args.ws + WS_CTL);
    for (int u = threadIdx.x; u < (LDS_BYTES - LDSCTL_OFF) / 4; u += NWAVES * 64) ((LAS unsigned*)(F.lds + LDSCTL_OFF))[u] = 0u;
    __syncthreads();
    XcdBarrier bar; bar.bar = (unsigned*)(F.ctl + CW_BAR); bar.x = 0; bar.st = nullptr; bar.wv = F.wv;
    if (!MK_MULTI) bar = xcd_barrier_post((unsigned*)(F.ctl + CW_BAR), (volatile LAS unsigned*)(F.lds + MISC_OFF + 32), F.wv);
    const int lo = args.lo, hi = args.hi; int seq = 0;
    volatile LAS unsigned* misc = (volatile LAS unsigned*)(F.lds + MISC_OFF);
    const unsigned my_xcc = xb_xcc_id();
    if (!MK_MULTI && threadIdx.x == 0) misc[48] = xb_add((unsigned*)(F.ctl + CW_RANK + 64 * my_xcc), 1u);
    __syncthreads();
    const int hw_rank = __builtin_amdgcn_readfirstlane((int)misc[48]);
    F.xi = (int)(blockIdx.x & 7); F.rank = (int)(blockIdx.x >> 3);
    bool xl = false; int lgen = 0;
#define STEP_ON (seq >= lo && seq < hi)
#define FRESH_WS unsigned char* ws = args.ws; asm volatile("" : "+s"(ws))
#define STEP_END do { if (!MK_MULTI && STEP_ON && seq + 1 < hi) { for (int rb = 0; rb < REP_BAR; ++rb) xcd_barrier(bar); } ++seq; } while (0)
#define STEP_END_L do { if (!MK_MULTI && STEP_ON && seq + 1 < hi) { if (xl) xl_barrier(F.ctl, bar.bar, F.xi, F.NR_(), lgen, F.wv); else xcd_barrier(bar); } ++seq; } while (0)
    LAS unsigned char* ring = F.lds;

    const bool side = (F.G == 256);
    if (STEP_ON) {
#ifndef SKIP_PRO
        for (int rp = 0; rp < REP_PRO; ++rp) {
        adaln_phase(F, args);
        rope_phase(F);
        absmax_phase(F, args);
        convert_mixer_weights(F, args, 0);
        if (!side) convert_ffn_weights(F, args.in[I_WFG], args.in[I_WFU], args.in[I_WFD], 0, 0, FFN_ITEMS, (int)blockIdx.x * NWAVES + F.wv, F.G * NWAVES);
        __syncthreads(); }
#endif
    }
    STEP_END;
    if (!MK_MULTI && lo == 0 && hi > 1) {
        if (threadIdx.x == 0) { unsigned ok = (F.G % 8 == 0) ? 1u : 0u, idx = 0u, npop = 0u;
            for (unsigned j = 0; j < 16; ++j) { const unsigned c = xb_ld(&bar.bar[XB_XCNT(j)]); if (c) { if (c != (unsigned)F.NR_()) ok = 0u; if (j < my_xcc) ++idx; ++npop; } }
            if (npop != 8u) ok = 0u;
            misc[49] = ok; misc[50] = idx; }
        __syncthreads();
        xl = misc[49] != 0u;
        if (xl) { F.xi = __builtin_amdgcn_readfirstlane((int)misc[50]); F.rank = hw_rank; }
    }
    if (STEP_ON) { convert_win(F, args, 0); __syncthreads(); for (int rep = 0; rep < REP_A; ++rep) phase_a(F, args); }
    STEP_END;

    for (int l = 0; l < DEPTH; ++l) {
        const bool moe = (l & 1) != 0;
        for (int rmix = 0; rmix < (l == 0 ? REP_MIX : 1); ++rmix)
        for (int ch = 0; ch < NCH; ++ch) {
            F.crow = ch * TC; fresh_ids(F);
            if (STEP_ON && side && F.rank >= 8) {
                const int gwi = ((F.rank - 8) * 8 + F.xi) * NWAVES + F.wv, ngw = 192 * NWAVES;
                constexpr int FI = FFN_ITEMS;
                if (l == 0) { if (ch == 0) { convert_ffn_weights(F, args.in[I_WFG], args.in[I_WFU], args.in[I_WFD], 0, 0, FI, gwi, ngw); convert_ffn_weights(F, args.in[I_WEG], args.in[I_WEU], args.in[I_WED], 1, FI, 2 * FI, gwi, ngw); }
                              else convert_ffn_weights(F, args.in[I_WEG], args.in[I_WEU], args.in[I_WED], 1, 2 * FI, 4 * FI, gwi, ngw); }
                else { if (ch == 0) { convert_ffn_weights(F, args.in[I_WEG], args.in[I_WEU], args.in[I_WED], 1, 0, FI, gwi, ngw); convert_ffn_weights(F, args.in[I_WEG], args.in[I_WEU], args.in[I_WED], 1, 4 * FI, 4 * FI + FI * 3 / 2, gwi, ngw); }
                       else convert_ffn_weights(F, args.in[I_WEG], args.in[I_WEU], args.in[I_WED], 1, 4 * FI + FI * 3 / 2, 8 * FI, gwi, ngw); }
                __syncthreads();
            }
            if (STEP_ON) {
#ifndef SKIP_B
                FRESH_WS;
                pg8::Gemm g{(const bf16*)(ws + WS_H + (size_t)ch * TC * DM), (const bf16*)(ws + WS_WM + WM_WIN), TC, NCOL, DM / 2}; pg8::StaticOrder S; S.init(TC, NCOL, F.G, F.vb_());
                pg8::EpiI8 E{(bf16*)(ws + WS_PROJ), PCOL, (const float*)(ws + WS_RS) + (size_t)ch * TC, ((const float*)(ws + WS_WSC))[l], ws + WS_G8 + (size_t)ch * TC * GCOL, PCOL / 256};
                for (int rep = 0; rep < REP_B; ++rep) pg8::gemm_phase<pg8::EpiI8, pg8::StaticOrder, true, true, 2>(ring, F.wv, g, S, E);
#endif
            }
            STEP_END_L;
            if (STEP_ON) {
#ifndef SKIP_C1
                for (int rep = 0; rep < REP_C1; ++rep) c1_phase(F);
#endif

            }
            STEP_END_L;
#ifndef SKIP_C2
            if (STEP_ON) { for (int rep = 0; rep < REP_C2; ++rep) c2_phase(F); }
#endif

            if (ch == NCH - 1) STEP_END; else STEP_END_L;
        }
        fresh_ids(F);
        if (STEP_ON) {
#ifndef SKIP_E
            FRESH_WS;
            pg8::Gemm g{(const bf16*)(ws + WS_ATT), (const bf16*)(ws + WS_WM + WM_WA), T, DM, 256}; pg8::StaticOrder S; S.init(T, DM, F.G, F.vb_());
            pg8::EpiGate<0> E{ws + WS_G8, GCOL, (bf16*)(ws + WS_MRG), DM};
            for (int rep = 0; rep < REP_E; ++rep) pg8::gemm_phase<pg8::EpiGate<0>, pg8::StaticOrder, true, true>(ring, F.wv, g, S, E);
#endif
        }
        if (STEP_ON) {
#ifndef SKIP_F
            FRESH_WS;
            pg8::Gemm g{(const bf16*)(ws + WS_RET), (const bf16*)(ws + WS_WM + WM_WR), T, DM, DM}; pg8::StaticOrder S; S.init(T, DM, F.G, F.vb_());
            pg8::EpiGate<1> E{ws + WS_G8 + DM, GCOL, (bf16*)(ws + WS_MRG), DM};
            pg8::gemm_phase<pg8::EpiGate<1>, pg8::StaticOrder, true, true>(ring, F.wv, g, S, E);
#endif
        }
        STEP_END_L;
        fresh_ids(F);
        if (STEP_ON) {
#ifndef SKIP_G
            FRESH_WS;
            pg8::Gemm g{(const bf16*)(ws + WS_MRG), (const bf16*)(ws + WS_WM + WM_WMIX), T, DM, DM}; pg8::StaticOrder S; S.init(T, DM, F.G, F.vb_());
            pg8::EpiBf16 E{(bf16*)(ws + WS_Y), DM};
            for (int rep = 0; rep < REP_G; ++rep) pg8::gemm_phase<pg8::EpiBf16, pg8::StaticOrder, true, true>(ring, F.wv, g, S, E);
#endif
        }
        STEP_END_L;
#ifndef SKIP_H
        fresh_ids(F);
        if (STEP_ON) {
#pragma nounroll
            for (int j = 0; j < 2; ++j) { const int e = 2 * F.xi + j; phase_h(F, args, l, moe, e >> 3, (e & 7) * F.NR_() + F.rank, F.G, j == 0); __syncthreads(); }
        }
#endif
        if (moe) STEP_END; else STEP_END_L;
        if (moe) { if (STEP_ON) phase_h2(F, F.G, F.G); STEP_END; }
        const int fvb = moe ? (int)blockIdx.x : F.vb_();
        {
            LAS int* tendL = (LAS int*)(F.lds + MISC_OFF + 128);
            if (F.wv == 0 && lane_id() == 0) { int acc = 0;
                for (int e = 0; e < 8; ++e) { const int c = moe ? (int)__hip_atomic_load((unsigned*)(F.ctl + CW_ECNT + e), RLX_AGENT) : (e == 0 ? T : 0); acc += (c + 255) >> 8; tendL[e] = acc; } }
            if (F.wv == 1 && lane_id() < 8) ((LAS float*)(F.lds + MISC_OFF + 256))[lane_id()] = ((const float*)(F.ws + WS_WSCF))[lane_id()];
            __syncthreads();
            const int ttot = __builtin_amdgcn_readfirstlane(tendL[7]);
            for (int rffn = 0; rffn < (l == 0 ? REP_FFN0 : 1); ++rffn) {
            if (STEP_ON) {
#ifndef SKIP_I
                FRESH_WS;
                const bf16* arows = moe ? (const bf16*)(ws + WS_SORT) : (const bf16*)(ws + WS_H);
                pg8::Gemm g{arows, (const bf16*)(ws + WS_WF), ttot * 256, 2 * FF, DM / 2};
                pg8::FfnOrder S; S.so.init(ttot * 256, 2 * FF, F.G, fvb); S.tend = tendL; S.estride = (unsigned)WF_E;
                pg8::EpiSwigluI8 E{ws + WS_U, FF, moe ? (const float*)(ws + WS_RSS) : (const float*)(ws + WS_RS), (const LAS float*)(F.lds + MISC_OFF + 256)};
                for (int rep = 0; rep < REP_I; ++rep) pg8::gemm_phase<pg8::EpiSwigluI8, pg8::FfnOrder, true, true, 2>(ring, F.wv, g, S, E);
#endif
            }
            if (moe) STEP_END; else STEP_END_L;
            if (STEP_ON) {
#ifndef SKIP_J
                FRESH_WS;
                pg8::Gemm g{(const bf16*)(ws + WS_U), (const bf16*)(ws + WS_WF + WF_GU), ttot * 256, DM, FF / 2};
                pg8::FfnOrder S; S.so.init(ttot * 256, DM, F.G, fvb); S.tend = tendL; S.estride = (unsigned)WF_E;
                pg8::EpiBf16 E{(bf16*)(ws + WS_YS), DM};
                for (int rep = 0; rep < REP_J; ++rep) pg8::gemm_phase<pg8::EpiBf16, pg8::FfnOrder, true, true, 1>(ring, F.wv, g, S, E);
#endif
            }
            if (moe) STEP_END; else STEP_END_L;
            }
        }
        if (STEP_ON) {
#ifndef SKIP_K
            phase_k(F, args, l, moe, moe ? (int)blockIdx.x : (2 * F.xi + (F.rank >> 4)) * (F.G >> 4) + (F.rank & 15));
            if (l + 1 < DEPTH) { convert_mixer_weights(F, args, l + 1); convert_win(F, args, l + 1);
                if (!side) convert_ffn_weights(F, args.in[I_WEG], args.in[I_WEU], args.in[I_WED], 1, 0, NEXP * FFN_ITEMS, (int)blockIdx.x * NWAVES + F.wv, F.G * NWAVES); }
#endif

        }
        STEP_END;
    }
#undef STEP_ON
#undef STEP_END
}

extern "C" void kernel_launch(void* const* d_in, const int* in_sizes, int n_in, void* d_out, int out_size, void* d_ws, size_t ws_size, hipStream_t stream) {
    static int grid = 0;
    if (grid == 0) {
        if (n_in != 20 || in_sizes[0] != T * DM || out_size != T * DM || ws_size < WS_END) { fprintf(stderr, "kernel_launch: unexpected shapes / workspace (%zu < %zu)\n", ws_size, (size_t)WS_END); grid = -1; return; }
        int dev = 0, cus = 0, per_cu = 0;
        if (hipGetDevice(&dev) != hipSuccess || hipDeviceGetAttribute(&cus, hipDeviceAttributeMultiprocessorCount, dev) != hipSuccess) { grid = -1; return; }
        if (hipFuncSetAttribute((const void*)fwd, hipFuncAttributeMaxDynamicSharedMemorySize, LDS_BYTES) != hipSuccess) { grid = -1; return; }
        if (hipOccupancyMaxActiveBlocksPerMultiprocessor(&per_cu, (const void*)fwd, NWAVES * 64, LDS_BYTES) != hipSuccess || per_cu < 1) { fprintf(stderr, "kernel_launch: occupancy query says %d\n", per_cu); }
        (void)hipGetLastError();
        grid = cus;
    }
    if (grid < 0) return;
    (void)hipMemsetAsync((char*)d_ws + WS_CTL, 0, CTL_ZERO_BYTES, stream);
    Args a{};
    for (int i = 0; i < 20; ++i) a.in[i] = (const float*)d_in[i];
    a.out = (float*)d_out; a.ws = (unsigned char*)d_ws;
#if MK_MULTI
    for (int s = 0; s < NSTEPS; ++s) { a.lo = s; a.hi = s + 1; hipLaunchKernelGGL(fwd, dim3(grid), dim3(NWAVES * 64), LDS_BYTES, stream, a); }
#else
    a.lo = 0; a.hi = 1 << 30;
    hipLaunchKernelGGL(fwd, dim3(grid), dim3(NWAVES * 64), LDS_BYTES, stream, a);
#endif
}
```

```cpp
#include <hip/hip_runtime.h>
#include <cstdio>
#include <cstdint>

#define REP_B 1
#define REP_C1 1
#define REP_BAR 1
#define REP_H0 1
#define REP_PRO 1
#define REP_MIX 1
#define REP_FFN0 1
#define REP_SH 1
#define REP_SC 1
#define REP_CVT 1
#define REP_A 1
#define REP_C1A 1
#define REP_C1K 1
#define REP_D 1
#define REP_C2 1
#define REP_E 1
#define REP_G 1
#define REP_I 1
#define REP_J 1
#ifndef MK_MULTI
#define MK_MULTI 0
#endif

__device__ __forceinline__ int lane_id() { int r; asm volatile("v_mbcnt_lo_u32_b32 %0, -1, 0\n\tv_mbcnt_hi_u32_b32 %0, -1, %0" : "=v"(r)); return r; }
namespace pg8 {
#define PG8_LAS __attribute__((address_space(3)))
#define PG8_GAS __attribute__((address_space(1)))
typedef unsigned short bf16_t;
typedef short bf16x8 __attribute__((ext_vector_type(8)));
typedef float f32x4 __attribute__((ext_vector_type(4)));
typedef unsigned u32x4 __attribute__((ext_vector_type(4)));
typedef int v8i32 __attribute__((ext_vector_type(8)));
typedef int v4i32 __attribute__((ext_vector_type(4)));
constexpr int BM = 256, BK = 64, HALF = 128, HTB = HALF * BK * 2, STAGE_BYTES = 8 * HTB, NXCD = 8, WGM = 8;

__host__ __device__ __forceinline__ int lds_byte(int r, int c) { const int st = (r >> 4) * 2 + (c >> 5), rr = r & 15, cc = c & 31, ob = rr * 64 + cc * 2; return st * 1024 + (ob ^ (((ob >> 9) & 1) << 5)); }
__host__ __device__ __forceinline__ void stage_rc(int b, int& R, int& C) { const int st = b / 1024, sb = b % 1024, swz = sb ^ (((sb >> 9) & 1) << 5); R = (st >> 1) * 16 + swz / 64; C = (st & 1) * 32 + (swz % 64) / 2; }
__host__ __device__ __forceinline__ int perm32(int rho) { const int n = rho >> 4, i = rho & 15; return 8 * (i >> 2) + 4 * n + (i & 3); }

struct Unit { int pm, pn; unsigned boff; int e; };
struct Gemm { const bf16_t* A; const bf16_t* Bt; int M, N, K; const int* gsrc; };

struct StaticOrder {
    int nM, nN, nwg, G, c;
    __host__ __device__ void init(int M, int N, int G_, int c_) { nM = M / BM; nN = N / BM; nwg = nM * nN; G = G_; c = c_; }
    __host__ __device__ bool next(int i, Unit& u) const {
        const int L = i * G + c; if (L >= nwg) return false;
        int wgid = L; { const int q = nwg / NXCD, r = nwg % NXCD, xcd = wgid % NXCD, off = wgid / NXCD; wgid = (xcd < r ? xcd * (q + 1) : r * (q + 1) + (xcd - r) * q) + off; }
        const int nig = WGM * nN, gid = wgid / nig, fm = gid * WGM, gsz = (nM - fm) < WGM ? (nM - fm) : WGM;
        u.pm = fm + ((wgid % nig) % gsz); u.pn = (wgid % nig) / gsz; u.boff = 0; u.e = 0; return true;
    }
};
struct FfnOrder {
    StaticOrder so; const PG8_LAS int* tend; unsigned estride;
    __device__ bool next(int i, Unit& u) const {
        if (!so.next(i, u)) return false;
        const int ta = u.pm; int e = 0;
#pragma unroll
        for (int k = 0; k < 7; ++k) e += (ta >= tend[k]) ? 1 : 0;
        u.boff = (unsigned)e * estride; u.e = e; return true;
    }
};

__device__ __forceinline__ unsigned cvt_pk_bf16(float lo, float hi) { unsigned r; asm volatile("v_cvt_pk_bf16_f32 %0, %1, %2" : "=v"(r) : "v"(lo), "v"(hi)); return r; }
__device__ __forceinline__ float bflo(unsigned w) { return __builtin_bit_cast(float, w << 16); }
__device__ __forceinline__ float bfhi(unsigned w) { return __builtin_bit_cast(float, w & 0xffff0000u); }
__device__ __forceinline__ float sigm(float x) { return __builtin_amdgcn_rcpf(1.0f + __expf(-x)); }

struct EpiBf16 {
    static constexpr bool PERM = true; static constexpr int NVM = 16;
    bf16_t* O; int ldc;
    __device__ __forceinline__ void operator()(const f32x4 (&acc)[2][2][4][2], const Unit& u, int wr, int wc, int fr, int fq) const {
        const int row0 = u.pm * BM + wr * 64 + fr; const int col0 = u.pn * BM + wc * 32 + 8 * fq;
#pragma unroll
        for (int ai = 0; ai < 2; ++ai)
#pragma unroll
            for (int m = 0; m < 4; ++m) { bf16_t* rowp = O + (size_t)(row0 + ai * HALF + m * 16) * ldc + col0;
#pragma unroll
                for (int bj = 0; bj < 2; ++bj) { const f32x4 v0 = acc[ai][bj][m][0], v1 = acc[ai][bj][m][1];
                    u32x4 w; w.x = cvt_pk_bf16(v0[0], v0[1]); w.y = cvt_pk_bf16(v0[2], v0[3]); w.z = cvt_pk_bf16(v1[0], v1[1]); w.w = cvt_pk_bf16(v1[2], v1[3]);
                    *(PG8_GAS u32x4*)(rowp + bj * HALF) = w; } }
    }
};
constexpr int SC_OFF = 131072 + 320 + 1024;
__device__ __forceinline__ void stage_row_scales(PG8_LAS unsigned char* lds, const float* rs0, int wid) {
    int ln; asm volatile("v_mbcnt_lo_u32_b32 %0, -1, 0\n\tv_mbcnt_hi_u32_b32 %0, -1, %0" : "=v"(ln));
    const float* p = rs0 + (wid >> 2) * 64 + ln; PG8_LAS unsigned char* d = lds + SC_OFF + wid * 512;
    asm volatile("" ::: "memory");
    __builtin_amdgcn_global_load_lds((const unsigned*)p, (PG8_LAS unsigned*)d, 4, 0, 0);
    __builtin_amdgcn_global_load_lds((const unsigned*)(p + HALF), (PG8_LAS unsigned*)(d + 256), 4, 0, 0);
    asm volatile("" ::: "memory");
}
__device__ __forceinline__ void load_row_scales(PG8_LAS unsigned char* lds, int wid, int fr, float ws, float (&sc)[2][4]) {
    asm volatile("" ::: "memory");
    const PG8_LAS float* sl = (const PG8_LAS float*)(lds + SC_OFF + wid * 512) + fr;
#pragma unroll
    for (int ai = 0; ai < 2; ++ai)
#pragma unroll
        for (int m = 0; m < 4; ++m) sc[ai][m] = sl[ai * 64 + m * 16] * ws;
}
struct EpiI8 {
    static constexpr bool PERM = true, HAS_STAGE = true; static constexpr int NVM = 18;
    bf16_t* O; int ldc; const float* rs; float ws; unsigned char* G8; int ntb;
    static constexpr int GC8 = 2048;
    __device__ __forceinline__ void stage(PG8_LAS unsigned char* lds, const Unit& u, int wid) const { stage_row_scales(lds, rs + u.pm * BM, wid); }
    __device__ __forceinline__ void operator()(const f32x4 (&acc)[2][2][4][2], const Unit& u, int wr, int wc, int fr, int fq, PG8_LAS unsigned char* lds, int wid) const {
        const int row0 = u.pm * BM + wr * 64 + fr;
        float scv[2][4]; load_row_scales(lds, wid, fr, ws, scv);
        if (u.pn < ntb) {
            const int col0 = u.pn * BM + wc * 32 + 8 * fq;
#pragma unroll
            for (int ai = 0; ai < 2; ++ai)
#pragma unroll
                for (int m = 0; m < 4; ++m) { const int row = row0 + ai * HALF + m * 16; const float sc = scv[ai][m]; bf16_t* rowp = O + (size_t)row * ldc + col0;
#pragma unroll
                    for (int bj = 0; bj < 2; ++bj) { const v4i32 a0 = __builtin_bit_cast(v4i32, acc[ai][bj][m][0]), a1 = __builtin_bit_cast(v4i32, acc[ai][bj][m][1]);
                        u32x4 w; w.x = cvt_pk_bf16((float)a0[0] * sc, (float)a0[1] * sc); w.y = cvt_pk_bf16((float)a0[2] * sc, (float)a0[3] * sc); w.z = cvt_pk_bf16((float)a1[0] * sc, (float)a1[1] * sc); w.w = cvt_pk_bf16((float)a1[2] * sc, (float)a1[3] * sc);
                        *(PG8_GAS u32x4*)(rowp + bj * HALF) = w; } }
        } else {
            const int col0 = (u.pn - ntb) * BM + wc * 32 + 8 * fq;
            typedef int i32x2 __attribute__((ext_vector_type(2)));
#pragma unroll
            for (int ai = 0; ai < 2; ++ai)
#pragma unroll
                for (int m = 0; m < 4; ++m) { const int row = row0 + ai * HALF + m * 16; const float sc = scv[ai][m]; unsigned char* rowp = G8 + (size_t)row * GC8 + col0;
#pragma unroll
                    for (int bj = 0; bj < 2; ++bj) { const v4i32 a0 = __builtin_bit_cast(v4i32, acc[ai][bj][m][0]), a1 = __builtin_bit_cast(v4i32, acc[ai][bj][m][1]);
                        int w0 = 0, w1 = 0;
                        w0 = __builtin_amdgcn_cvt_pk_fp8_f32((float)a0[0] * sc, (float)a0[1] * sc, w0, false); w0 = __builtin_amdgcn_cvt_pk_fp8_f32((float)a0[2] * sc, (float)a0[3] * sc, w0, true);
                        w1 = __builtin_amdgcn_cvt_pk_fp8_f32((float)a1[0] * sc, (float)a1[1] * sc, w1, false); w1 = __builtin_amdgcn_cvt_pk_fp8_f32((float)a1[2] * sc, (float)a1[3] * sc, w1, true);
                        *(PG8_GAS i32x2*)(rowp + bj * HALF) = (i32x2){w0, w1}; } }
        }
    }
};
template <int ADD> struct EpiGate {
    static constexpr bool PERM = true; static constexpr int NVM = 16;
    const unsigned char* Gt; int ldg; bf16_t* O; int ldc;
    typedef int i32x2 __attribute__((ext_vector_type(2))); typedef float f32x2v __attribute__((ext_vector_type(2)));
    __device__ __forceinline__ void one(const f32x4 v0, const f32x4 v1, const i32x2 g, const u32x4 t, bf16_t* p) const {
        const f32x2v g01 = __builtin_amdgcn_cvt_pk_f32_fp8(g.x, false), g23 = __builtin_amdgcn_cvt_pk_f32_fp8(g.x, true), g45 = __builtin_amdgcn_cvt_pk_f32_fp8(g.y, false), g67 = __builtin_amdgcn_cvt_pk_f32_fp8(g.y, true);
        float o[8];
        o[0] = sigm(g01.x) * v0[0]; o[1] = sigm(g01.y) * v0[1]; o[2] = sigm(g23.x) * v0[2]; o[3] = sigm(g23.y) * v0[3];
        o[4] = sigm(g45.x) * v1[0]; o[5] = sigm(g45.y) * v1[1]; o[6] = sigm(g67.x) * v1[2]; o[7] = sigm(g67.y) * v1[3];
        if (ADD) { o[0] += bflo(t.x); o[1] += bfhi(t.x); o[2] += bflo(t.y); o[3] += bfhi(t.y); o[4] += bflo(t.z); o[5] += bfhi(t.z); o[6] += bflo(t.w); o[7] += bfhi(t.w); }
        u32x4 w; w.x = cvt_pk_bf16(o[0], o[1]); w.y = cvt_pk_bf16(o[2], o[3]); w.z = cvt_pk_bf16(o[4], o[5]); w.w = cvt_pk_bf16(o[6], o[7]);
        *(PG8_GAS u32x4*)p = w;
    }
    __device__ __forceinline__ void operator()(const f32x4 (&acc)[2][2][4][2], const Unit& u, int wr, int wc, int fr, int fq) const {
        const int row0 = u.pm * BM + wr * 64 + fr; const int col0 = u.pn * BM + wc * 32 + 8 * fq;
        i32x2 gt[2][4][2]; u32x4 t0[4][2], t1[4][2];
#pragma unroll
        for (int ai = 0; ai < 2; ++ai)
#pragma unroll
            for (int m = 0; m < 4; ++m)
#pragma unroll
                for (int bj = 0; bj < 2; ++bj) { const size_t row = (size_t)(row0 + ai * HALF + m * 16);
                    gt[ai][m][bj] = *(const PG8_GAS i32x2*)(Gt + row * ldg + col0 + bj * HALF);
                    if (ai == 0) { t0[m][bj] = (u32x4){0u, 0u, 0u, 0u}; if (ADD) t0[m][bj] = *(const PG8_GAS u32x4*)(O + row * ldc + col0 + bj * HALF); } }
#pragma unroll
        for (int m = 0; m < 4; ++m) {
#pragma unroll
            for (int bj = 0; bj < 2; ++bj) { const size_t row = (size_t)(row0 + m * 16); one(acc[0][bj][m][0], acc[0][bj][m][1], gt[0][m][bj], t0[m][bj], O + row * ldc + col0 + bj * HALF); }
#pragma unroll
            for (int bj = 0; bj < 2; ++bj) { const size_t row = (size_t)(row0 + HALF + m * 16); t1[m][bj] = (u32x4){0u, 0u, 0u, 0u}; if (ADD) t1[m][bj] = *(const PG8_GAS u32x4*)(O + row * ldc + col0 + bj * HALF); }
            __builtin_amdgcn_sched_barrier(0);
        }
#pragma unroll
        for (int m = 0; m < 4; ++m)
#pragma unroll
            for (int bj = 0; bj < 2; ++bj) { const size_t row = (size_t)(row0 + HALF + m * 16); one(acc[1][bj][m][0], acc[1][bj][m][1], gt[1][m][bj], t1[m][bj], O + row * ldc + col0 + bj * HALF); }
    }
};
struct EpiSwiglu {
    static constexpr bool PERM = true; static constexpr int NVM = 8;
    unsigned char* O; int ldc;
    __device__ __forceinline__ void operator()(const f32x4 (&acc)[2][2][4][2], const Unit& u, int wr, int wc, int fr, int fq) const {
        const int row0 = u.pm * BM + wr * 64 + fr; const int col0 = u.pn * HALF + wc * 32 + 8 * fq;
#pragma unroll
        for (int ai = 0; ai < 2; ++ai)
#pragma unroll
            for (int m = 0; m < 4; ++m) { unsigned char* rowp = O + (size_t)(row0 + ai * HALF + m * 16) * ldc + col0;
                float o[8];
#pragma unroll
                for (int n = 0; n < 2; ++n)
#pragma unroll
                    for (int k = 0; k < 4; ++k) { const float g = acc[ai][0][m][n][k], up = acc[ai][1][m][n][k]; o[n * 4 + k] = g * sigm(g) * up; }
                int w0 = 0, w1 = 0;
                w0 = __builtin_amdgcn_cvt_pk_fp8_f32(o[0], o[1], w0, false); w0 = __builtin_amdgcn_cvt_pk_fp8_f32(o[2], o[3], w0, true);
                w1 = __builtin_amdgcn_cvt_pk_fp8_f32(o[4], o[5], w1, false); w1 = __builtin_amdgcn_cvt_pk_fp8_f32(o[6], o[7], w1, true);
                typedef int i32x2 __attribute__((ext_vector_type(2)));
                *(PG8_GAS i32x2*)rowp = (i32x2){w0, w1}; }
    }
};

__device__ __forceinline__ v8i32 cat8(bf16x8 a, bf16x8 b) { return __builtin_shufflevector(__builtin_bit_cast(v4i32, a), __builtin_bit_cast(v4i32, b), 0, 1, 2, 3, 4, 5, 6, 7); }
constexpr int W8_SHIFT = 8;
constexpr int W8_SCALE = (127 - W8_SHIFT / 2) * 0x01010101, ONE_SCALE = W8_SCALE;
template <class E, class = void> struct EpiStage {
    static __device__ __forceinline__ void stage(const E&, PG8_LAS unsigned char*, const Unit&, int) {}
    template <class A> static __device__ __forceinline__ void run(const E& e, const A& acc, const Unit& u, int wr, int wc, int fr, int fq, PG8_LAS unsigned char*, int) { e(acc, u, wr, wc, fr, fq); } };
template <class E> struct EpiStage<E, decltype((void)E::HAS_STAGE)> {
    static __device__ __forceinline__ void stage(const E& e, PG8_LAS unsigned char* lds, const Unit& u, int wid) { e.stage(lds, u, wid); }
    template <class A> static __device__ __forceinline__ void run(const E& e, const A& acc, const Unit& u, int wr, int wc, int fr, int fq, PG8_LAS unsigned char* lds, int wid) { e(acc, u, wr, wc, fr, fq, lds, wid); } };
struct EpiSwigluI8 {
    static constexpr bool PERM = true, HAS_STAGE = true; static constexpr int NVM = 10;
    unsigned char* O; int ldc; const float* rs; const PG8_LAS float* wscL;
    __device__ __forceinline__ void stage(PG8_LAS unsigned char* lds, const Unit& u, int wid) const { stage_row_scales(lds, rs + u.pm * BM, wid); }
    __device__ __forceinline__ void operator()(const f32x4 (&acc)[2][2][4][2], const Unit& u, int wr, int wc, int fr, int fq, PG8_LAS unsigned char* lds, int wid) const {
        const int row0 = u.pm * BM + wr * 64 + fr; const int col0 = u.pn * HALF + wc * 32 + 8 * fq;
        float scv[2][4]; load_row_scales(lds, wid, fr, wscL[u.e], scv);
#pragma unroll
        for (int ai = 0; ai < 2; ++ai)
#pragma unroll
            for (int m = 0; m < 4; ++m) { const int row = row0 + ai * HALF + m * 16; const float sc = scv[ai][m]; unsigned char* rowp = O + (size_t)row * ldc + col0;
                typedef float f32x2v __attribute__((ext_vector_type(2))); typedef int i32x2 __attribute__((ext_vector_type(2)));
                const f32x2v sc2 = (f32x2v){sc, sc}, nl2 = (f32x2v){-1.44269504f, -1.44269504f}, one2 = (f32x2v){1.0f, 1.0f};
                f32x2v o[4];
#pragma unroll
                for (int n = 0; n < 2; ++n) { const v4i32 gi = __builtin_bit_cast(v4i32, acc[ai][0][m][n]), ui = __builtin_bit_cast(v4i32, acc[ai][1][m][n]);
#pragma unroll
                    for (int k = 0; k < 2; ++k) { const f32x2v g = (f32x2v){(float)gi[2 * k], (float)gi[2 * k + 1]} * sc2, up = (f32x2v){(float)ui[2 * k], (float)ui[2 * k + 1]} * sc2;
                        const f32x2v t = g * nl2; const f32x2v d = (f32x2v){__builtin_amdgcn_exp2f(t.x), __builtin_amdgcn_exp2f(t.y)} + one2;
                        o[n * 2 + k] = (g * (f32x2v){__builtin_amdgcn_rcpf(d.x), __builtin_amdgcn_rcpf(d.y)}) * up; } }
                int w0 = 0, w1 = 0;
                w0 = __builtin_amdgcn_cvt_pk_fp8_f32(o[0].x, o[0].y, w0, false); w0 = __builtin_amdgcn_cvt_pk_fp8_f32(o[1].x, o[1].y, w0, true);
                w1 = __builtin_amdgcn_cvt_pk_fp8_f32(o[2].x, o[2].y, w1, false); w1 = __builtin_amdgcn_cvt_pk_fp8_f32(o[3].x, o[3].y, w1, true);
                *(PG8_GAS i32x2*)rowp = (i32x2){w0, w1}; }
    }
};
constexpr int GI_OFF = SC_OFF + 4096;
template <class Epi, class Sched, bool ALIGN_EPI = false, bool SP2 = false, int MODE = 0, bool GATHER = false>
__device__ __forceinline__ void gemm_phase(PG8_LAS unsigned char* lds, const int wv, const Gemm g, const Sched& S, const Epi& E) {
    int tid_ = wv * 64 + lane_id(); asm volatile("" : "+v"(tid_));
    const int tid = tid_, wid = __builtin_amdgcn_readfirstlane(tid >> 6), lane = tid & 63, wr = wid >> 2, wc = wid & 3, fr = lane & 15, fq = lane >> 4;
    constexpr bool FP8 = (MODE == 1), I8 = (MODE == 2);
    int K_ = g.K; asm volatile("" : "+s"(K_)); const int K = K_, nt = K / BK;
    unsigned voffA, voffB;
    { int R, C; stage_rc(tid * 16, R, C); const int Rb = Epi::PERM ? ((R & ~31) + perm32(R & 31)) : R;
        voffA = (unsigned)(R * K + C) * 2u; voffB = (unsigned)(Rb * K + C) * 2u; }
    int gR_, gC_; stage_rc(tid * 16, gR_, gC_); const int gR = gR_; const unsigned gcol = (unsigned)gC_ * 2u, growb = (unsigned)K * 2u;
    unsigned gA0 = 0u, gA1 = 0u, gA2 = 0u, gA3 = 0u;
    const unsigned pstep = 64u * (unsigned)K * 2u;
    const unsigned kstep = (unsigned)(BK * 2);
    const unsigned hstep = (unsigned)HALF * (unsigned)K * 2u;
    const unsigned tstep = 2u * hstep;
    const unsigned ldsw = (unsigned)wid * 1024u;
    const char* const Ab = (const char*)g.A; const char* const Bb = (const char*)g.Bt;
    const int aoff = lds_byte(wr * 64 + fr, fq * 8), boff = lds_byte(wc * 32 + fr, fq * 8);
#define PG8_SA(b, h) (((b) * 2 + (h)) * HTB)
#define PG8_SB(b, h) ((4 + (b) * 2 + (h)) * HTB)
#define PG8_STAGE(bufoff, gbase, uoff, voff) do { _Pragma("unroll") for (int _i = 0; _i < 2; ++_i) \
        __builtin_amdgcn_global_load_lds((const unsigned*)((gbase) + (size_t)(unsigned)(((uoff) + _i * pstep) + (voff))), (PG8_LAS unsigned*)(lds + (bufoff) + ldsw + _i * 8192), 16, 0, 0); } while (0)
#define PG8_STA(bufoff, uoff, h) do { if constexpr (GATHER) { \
        __builtin_amdgcn_global_load_lds((const unsigned*)(Ab + (size_t)(unsigned)((uoff) + ((h) ? gA2 : gA0))), (PG8_LAS unsigned*)(lds + (bufoff) + ldsw), 16, 0, 0); \
        __builtin_amdgcn_global_load_lds((const unsigned*)(Ab + (size_t)(unsigned)((uoff) + ((h) ? gA3 : gA1))), (PG8_LAS unsigned*)(lds + (bufoff) + ldsw + 8192), 16, 0, 0); \
    } else PG8_STAGE(bufoff, Ab, (uoff) + ((h) ? hstep : 0u), voffA); } while (0)
#define PG8_LDA(dst, b, h) do { _Pragma("unroll") for (int m = 0; m < 4; ++m) { if constexpr (FP8) { dst##8[m] = __builtin_shufflevector(*(const PG8_LAS v4i32*)(lds + PG8_SA(b, h) + aoff + m * 2048), *(const PG8_LAS v4i32*)(lds + PG8_SA(b, h) + aoff + m * 2048 + 1024), 0, 1, 2, 3, 4, 5, 6, 7); } else { \
        _Pragma("unroll") for (int k = 0; k < 2; ++k) dst[m][k] = *(const PG8_LAS bf16x8*)(lds + PG8_SA(b, h) + aoff + m * 2048 + k * 1024); } } } while (0)
#define PG8_LDB(dst, b, h) do { _Pragma("unroll") for (int n = 0; n < 2; ++n) { if constexpr (FP8) { dst##8[n] = __builtin_shufflevector(*(const PG8_LAS v4i32*)(lds + PG8_SB(b, h) + boff + n * 2048), *(const PG8_LAS v4i32*)(lds + PG8_SB(b, h) + boff + n * 2048 + 1024), 0, 1, 2, 3, 4, 5, 6, 7); } else { \
        _Pragma("unroll") for (int k = 0; k < 2; ++k) dst[n][k] = *(const PG8_LAS bf16x8*)(lds + PG8_SB(b, h) + boff + n * 2048 + k * 1024); } } } while (0)
#define PG8_MMA(ai, bj, At, Bt) do { __builtin_amdgcn_s_setprio(1); if constexpr (FP8) { _Pragma("unroll") for (int m = 0; m < 4; ++m) _Pragma("unroll") for (int n = 0; n < 2; ++n) \
        asm volatile("v_mfma_scale_f32_16x16x128_f8f6f4 %0, %1, %2, %0, %3, %3 op_sel_hi:[0,0,0]" : "+v"(acc[ai][bj][m][n]) : "v"(Bt##8[n]), "v"(At##8[m]), "v"(scl8)); } else { \
        _Pragma("unroll") for (int m = 0; m < 4; ++m) _Pragma("unroll") for (int n = 0; n < 2; ++n) _Pragma("unroll") for (int k = 0; k < 2; ++k) { if constexpr (I8) \
        acc[ai][bj][m][n] = __builtin_bit_cast(f32x4, __builtin_amdgcn_mfma_i32_16x16x64_i8(__builtin_bit_cast(v4i32, Bt[n][k]), __builtin_bit_cast(v4i32, At[m][k]), __builtin_bit_cast(v4i32, acc[ai][bj][m][n]), 0, 0, 0)); else \
        acc[ai][bj][m][n] = __builtin_amdgcn_mfma_f32_16x16x32_bf16(Bt[n][k], At[m][k], acc[ai][bj][m][n], 0, 0, 0); } } __builtin_amdgcn_s_setprio(0); } while (0)
#define PG8_WAIT_V(n) asm volatile("s_waitcnt vmcnt(" #n ")" ::: "memory")
#define PG8_WAIT_L(n) asm volatile("s_waitcnt lgkmcnt(" #n ")" ::: "memory")
#define PG8_WAIT_VR(rlx) asm volatile("s_cmp_lg_u32 %0, 0\n\ts_cbranch_scc1 1f\n\ts_waitcnt vmcnt(8)\n1:\n\ts_waitcnt vmcnt(%1)" :: "s"(rlx), "n"(8 + Epi::NVM) : "scc", "memory")
#define PG8_BAR __builtin_amdgcn_s_barrier()
#define PG8_SCHED __builtin_amdgcn_sched_barrier(0)
    Unit cur, nxt; int ui = 0;
    if (!S.next(0, cur)) return;
    EpiStage<Epi>::stage(E, lds, cur, wid);
    f32x4 acc[2][2][4][2];
#pragma unroll
    for (int a = 0; a < 2; ++a)
#pragma unroll
        for (int b = 0; b < 2; ++b)
#pragma unroll
            for (int m = 0; m < 4; ++m)
#pragma unroll
                for (int n = 0; n < 2; ++n) acc[a][b][m][n] = (f32x4){0.f, 0.f, 0.f, 0.f};
    int scl8 = W8_SCALE; asm volatile("" : "+v"(scl8));
    bf16x8 At[4][2], B0[2][2], B1[2][2]; v8i32 At8[4], B08[2], B18[2];
    unsigned cA = GATHER ? 0u : (unsigned)cur.pm * tstep, cB = (unsigned)cur.pn * tstep + cur.boff;
    if constexpr (GATHER) { const int* gp = g.gsrc + cur.pm * BM + gR;
        gA0 = (unsigned)gp[0] * growb + gcol; gA1 = (unsigned)gp[64] * growb + gcol; gA2 = (unsigned)gp[128] * growb + gcol; gA3 = (unsigned)gp[192] * growb + gcol; }
    if constexpr (SP2) {
        PG8_STAGE(PG8_SB(0, 0), Bb, cB, voffB); PG8_STAGE(PG8_SB(0, 1), Bb, cB + hstep, voffB); PG8_STA(PG8_SA(0, 0), cA, 0); PG8_STA(PG8_SA(0, 1), cA, 1);
        if (wr == 1) PG8_BAR;
        PG8_WAIT_V(2); PG8_BAR;
        PG8_STAGE(PG8_SB(1, 0), Bb, cB + kstep, voffB); PG8_STA(PG8_SA(1, 0), cA + kstep, 0); PG8_STAGE(PG8_SB(1, 1), Bb, cB + hstep + kstep, voffB);
        PG8_WAIT_V(6); PG8_BAR;
    } else {
        PG8_STAGE(PG8_SB(0, 0), Bb, cB, voffB); PG8_STA(PG8_SA(0, 0), cA, 0); PG8_STAGE(PG8_SB(0, 1), Bb, cB + hstep, voffB); PG8_STA(PG8_SA(0, 1), cA, 1);
        if (wr == 1) PG8_BAR;
        PG8_WAIT_V(4); PG8_BAR;
        PG8_STAGE(PG8_SB(1, 0), Bb, cB + kstep, voffB); PG8_STA(PG8_SA(1, 0), cA + kstep, 0); PG8_STAGE(PG8_SB(1, 1), Bb, cB + hstep + kstep, voffB);
        PG8_WAIT_V(6); PG8_BAR;
    }
    for (;;) {
        const bool has_next = S.next(ui + 1, nxt);
        const unsigned nA = GATHER ? 0u : (has_next ? (unsigned)nxt.pm * tstep : cA), nB = has_next ? (unsigned)nxt.pn * tstep + nxt.boff : cB;
        if constexpr (GATHER) { if (has_next) {
            const int* gp = g.gsrc + nxt.pm * BM + gR; PG8_LAS unsigned char* d = lds + GI_OFF + wid * 1024;
            asm volatile("" ::: "memory");
            __builtin_amdgcn_global_load_lds((const unsigned*)gp, (PG8_LAS unsigned*)d, 4, 0, 0); __builtin_amdgcn_global_load_lds((const unsigned*)(gp + 64), (PG8_LAS unsigned*)(d + 256), 4, 0, 0);
            __builtin_amdgcn_global_load_lds((const unsigned*)(gp + 128), (PG8_LAS unsigned*)(d + 512), 4, 0, 0); __builtin_amdgcn_global_load_lds((const unsigned*)(gp + 192), (PG8_LAS unsigned*)(d + 768), 4, 0, 0);
            asm volatile("" ::: "memory"); } }
        int t = 0;
        do {
            const bool last = (t == nt - 2);
            const unsigned a1 = cA + (unsigned)(t + 1) * kstep;
            const unsigned a2 = last ? nA : cA + (unsigned)(t + 2) * kstep, b2 = last ? nB : cB + (unsigned)(t + 2) * kstep;
            const unsigned a3 = a2 + kstep, b3 = b2 + kstep;
            if constexpr (SP2) {
            const int rlx = __builtin_amdgcn_readfirstlane(((t == 0) && (ui > 0)) ? 1 : 0);
            PG8_LDB(B0, 0, 0); PG8_LDB(B1, 0, 1); PG8_SCHED; PG8_LDA(At, 0, 0); PG8_STA(PG8_SA(1, 1), a1, 1);
            PG8_WAIT_VR(rlx); PG8_WAIT_L(0); PG8_BAR; PG8_MMA(0, 0, At, B0); PG8_MMA(0, 1, At, B1); PG8_BAR; PG8_SCHED;
            if constexpr (GATHER) { if (last && has_next) {
                const PG8_LAS unsigned* sl = (const PG8_LAS unsigned*)(lds + GI_OFF + wid * 1024) + lane;
                gA0 = sl[0] * growb + gcol; gA1 = sl[64] * growb + gcol; gA2 = sl[128] * growb + gcol; gA3 = sl[192] * growb + gcol; } }
            PG8_LDA(At, 0, 1); PG8_STAGE(PG8_SB(0, 0), Bb, b2, voffB); PG8_STAGE(PG8_SB(0, 1), Bb, b2 + hstep, voffB); PG8_STA(PG8_SA(0, 0), a2, 0);
            PG8_WAIT_VR(rlx); PG8_WAIT_L(0); PG8_BAR; PG8_MMA(1, 0, At, B0); PG8_MMA(1, 1, At, B1); PG8_BAR; PG8_SCHED;
            PG8_LDB(B0, 1, 0); PG8_LDB(B1, 1, 1); PG8_SCHED; PG8_LDA(At, 1, 0); PG8_STA(PG8_SA(0, 1), a2, 1);
            PG8_WAIT_V(8); PG8_WAIT_L(0); PG8_BAR; PG8_MMA(0, 0, At, B0); PG8_MMA(0, 1, At, B1); PG8_BAR; PG8_SCHED;
            PG8_LDA(At, 1, 1); PG8_STAGE(PG8_SB(1, 0), Bb, b3, voffB); PG8_STAGE(PG8_SB(1, 1), Bb, b3 + hstep, voffB); PG8_STA(PG8_SA(1, 0), a3, 0);
            PG8_WAIT_V(8); PG8_WAIT_L(0); PG8_BAR; PG8_MMA(1, 0, At, B0); PG8_MMA(1, 1, At, B1); PG8_BAR; PG8_SCHED;
            } else {
            PG8_LDB(B0, 0, 0); PG8_SCHED; PG8_LDA(At, 0, 0); PG8_STA(PG8_SA(1, 1), a1, 1);
            PG8_WAIT_L(8); PG8_BAR; PG8_WAIT_L(0); PG8_MMA(0, 0, At, B0); PG8_BAR; PG8_SCHED;
            PG8_LDB(B1, 0, 1); PG8_STAGE(PG8_SB(0, 0), Bb, b2, voffB);
            PG8_BAR; PG8_WAIT_L(0); PG8_MMA(0, 1, At, B1); PG8_BAR;
            PG8_LDA(At, 0, 1); PG8_STA(PG8_SA(0, 0), a2, 0);
            PG8_BAR; PG8_WAIT_L(0); PG8_MMA(1, 0, At, B0); PG8_BAR; PG8_SCHED;
            PG8_STAGE(PG8_SB(0, 1), Bb, b2 + hstep, voffB);
            PG8_WAIT_V(6); PG8_BAR; PG8_MMA(1, 1, At, B1); PG8_BAR;
            PG8_LDB(B0, 1, 0); PG8_SCHED; PG8_LDA(At, 1, 0); PG8_STA(PG8_SA(0, 1), a2, 1);
            PG8_WAIT_L(8); PG8_BAR; PG8_WAIT_L(0); PG8_MMA(0, 0, At, B0); PG8_BAR; PG8_SCHED;
            PG8_LDB(B1, 1, 1); PG8_STAGE(PG8_SB(1, 0), Bb, b3, voffB);
            PG8_BAR; PG8_WAIT_L(0); PG8_MMA(0, 1, At, B1); PG8_BAR;
            PG8_LDA(At, 1, 1); PG8_STA(PG8_SA(1, 0), a3, 0);
            PG8_BAR; PG8_WAIT_L(0); PG8_MMA(1, 0, At, B0); PG8_BAR; PG8_SCHED;
            PG8_STAGE(PG8_SB(1, 1), Bb, b3 + hstep, voffB);
            PG8_WAIT_V(6); PG8_BAR; PG8_MMA(1, 1, At, B1); PG8_BAR;
            }
            t += 2;
        } while (t < nt);
        if constexpr (FP8) asm volatile("s_nop 15\n\ts_nop 15" ::: "memory");
        if constexpr (ALIGN_EPI) { if (wr == 0) PG8_BAR; }
        { int l2 = lane; asm volatile("" : "+v"(l2)); EpiStage<Epi>::run(E, acc, cur, wr, wc, l2 & 15, l2 >> 4, lds, wid); }
        if (!has_next) break;
#pragma unroll
        for (int a = 0; a < 2; ++a)
#pragma unroll
            for (int b = 0; b < 2; ++b)
#pragma unroll
                for (int m = 0; m < 4; ++m)
#pragma unroll
                    for (int n = 0; n < 2; ++n) acc[a][b][m][n] = (f32x4){0.f, 0.f, 0.f, 0.f};
        cur = nxt; cA = nA; cB = nB; ++ui; EpiStage<Epi>::stage(E, lds, cur, wid);
        if constexpr (ALIGN_EPI) { if (wr == 1) PG8_BAR; }
    }
    PG8_WAIT_V(0);
    if constexpr (!ALIGN_EPI) { if (wr == 0) PG8_BAR; }
    PG8_BAR;
#undef PG8_SA
#undef PG8_SB
#undef PG8_STAGE
#undef PG8_LDA
#undef PG8_LDB
#undef PG8_MMA
#undef PG8_WAIT_V
#undef PG8_WAIT_L
#undef PG8_WAIT_VR
#undef PG8_BAR
#undef PG8_SCHED
}
}

constexpr int BATCH = 16, SEQ = 2048, DM = 1024, T = BATCH * SEQ, DEPTH = 2;
constexpr int NCOL = 7424, FF = 2816, NEXP = 8;
constexpr int OFF_QA = 0, OFF_KA = 768, OFF_VA = 1536, OFF_QR = 2304, OFF_KR = 2816, OFF_VR = 3328, OFF_GR = 4352, OFF_GA = 5376, OFF_GT = 6400;
constexpr int PCOL = 5376, GCOL = 2048;
constexpr int CB = 8, TC = CB * SEQ, NCH = BATCH / CB;
constexpr float EPS = 1e-6f;
constexpr int NWAVES = 8;

constexpr size_t MiB = 1u << 20;
constexpr size_t WS_CTL = 0, CTL_ZERO_BYTES = 1 * MiB;
constexpr size_t WS_MOD = 1 * MiB;
constexpr size_t WS_ROPE = 2 * MiB;
constexpr size_t WS_ROUTEA = 3 * MiB;
constexpr size_t WS_SRC = 3 * MiB + 512 * 1024;
constexpr size_t WS_ROUTEB = 4 * MiB;
constexpr size_t WS_ROUTEP = 4 * MiB + 512 * 1024;
constexpr size_t WS_WSCF = 5 * MiB + 160 * 1024;
constexpr size_t WS_RSS = 5 * MiB + 512 * 1024;
constexpr size_t WS_WSC = 5 * MiB + 128 * 1024;
constexpr size_t WS_RS = 5 * MiB + 256 * 1024;
constexpr size_t WS_BBASE = 5 * MiB;
constexpr size_t WS_WM = 6 * MiB;
constexpr size_t WM_WIN = 0, WM_WA = (size_t)NCOL * DM, WM_WR = WM_WA + (size_t)DM * 256 * 2, WM_WMIX = WM_WR + (size_t)DM * DM * 2, WM_END = WM_WMIX + (size_t)DM * DM * 2;
static_assert(WM_END <= 12 * MiB, "mixer weights");
constexpr size_t WS_WF = 18 * MiB;
constexpr size_t WF_GU = (size_t)2 * FF * DM, WF_D = (size_t)DM * FF, WF_E = WF_GU + WF_D;
static_assert(NEXP * WF_E <= 66 * MiB, "ffn weights");
constexpr size_t WS_H = 84 * MiB;
constexpr size_t WS_BIG = 116 * MiB;
constexpr size_t WS_XB = WS_BIG;
constexpr size_t WS_Y = WS_BIG + 64 * MiB;
constexpr size_t WS_RET = WS_Y;
constexpr size_t WS_PROJ = WS_BIG + 128 * MiB;
constexpr size_t WS_MRG = WS_PROJ;
constexpr size_t WS_G8 = WS_BIG + 296 * MiB;
constexpr size_t WS_OG = WS_BIG + 360 * MiB;
constexpr size_t OGR_B = 5 * MiB / 2;
constexpr size_t RPT_OFF = 3 * MiB / 2;
constexpr size_t WS_LSE = WS_BIG + 400 * MiB;
constexpr size_t WS_ATT = WS_BIG + 401 * MiB;
constexpr size_t WS_YS = WS_BIG + 64 * MiB;
constexpr size_t WS_SORT = WS_BIG + 64 * MiB;
constexpr size_t WS_U = WS_BIG + 196 * MiB;
constexpr size_t WS_END = WS_BIG + 417 * MiB;
static_assert((size_t)TC * PCOL * 2 <= 168 * MiB && (size_t)T * GCOL <= 64 * MiB && (size_t)264 * 256 * 1024 * 2 <= 132 * MiB && (size_t)264 * 256 * FF <= 182 * MiB && (size_t)3 * TC * 256 * 2 <= 24 * MiB && (size_t)CB * 8 * 16 * 8192 * 2 <= 16 * MiB && (size_t)T * DM * 2 <= 168 * MiB && (size_t)T * 256 * 2 <= 16 * MiB, "big map");

constexpr int CW_TMO = 0;
constexpr int CW_FMAX = 96;
constexpr int CW_WMAX = 80;
constexpr int CW_ECNT = 64;
constexpr int CW_RANK = 1024;
constexpr int CW_LBAR = 2048;
constexpr int CW_BAR = 4096;

constexpr int RING_BYTES = 131072;
constexpr int LDSCTL_OFF = RING_BYTES, MISC_OFF = LDSCTL_OFF + 320;
constexpr int LDS_BYTES = 147456;

#define GAS __attribute__((address_space(1)))
#define LAS __attribute__((address_space(3)))
typedef unsigned short bf16;
typedef unsigned v4u __attribute__((ext_vector_type(4)));
typedef unsigned v2u __attribute__((ext_vector_type(2)));
typedef int v4i __attribute__((ext_vector_type(4)));
typedef int v2i __attribute__((ext_vector_type(2)));
typedef float f32x4 __attribute__((ext_vector_type(4)));
typedef float f32x2 __attribute__((ext_vector_type(2)));
typedef short bf16x8 __attribute__((ext_vector_type(8)));
typedef short bf16x4 __attribute__((ext_vector_type(4)));
typedef GAS unsigned gu32;
#define RLX_AGENT __ATOMIC_RELAXED, __HIP_MEMORY_SCOPE_AGENT
#define LDS_WAIT() asm volatile("s_waitcnt lgkmcnt(0)" ::: "memory")
__device__ __forceinline__ unsigned f2bf(float f) { unsigned u = __builtin_bit_cast(unsigned, f); return (u + 0x7fffu + ((u >> 16) & 1u)) >> 16; }
__device__ __forceinline__ unsigned pk2(float lo, float hi) { return f2bf(lo) | (f2bf(hi) << 16); }
__device__ __forceinline__ float bflo(unsigned w) { return __builtin_bit_cast(float, w << 16); }
__device__ __forceinline__ float bfhi(unsigned w) { return __builtin_bit_cast(float, w & 0xffff0000u); }
__device__ __forceinline__ float bf2f(bf16 b) { return __builtin_bit_cast(float, (unsigned)b << 16); }

#define XB_TMO      128
#define XB_XCNT(j)  (256  + 64 * (j))
#define XB_XSUB(j)  (1280 + 64 * (j))
#define XB_XGEN(j)  (2304 + 64 * (j))
#define XB_TOP      3328
#define XB_TOPGEN   3392
#define XCD_BAR_WORDS 3456
#define XB_SPIN_CAP (1u << 22)

__device__ __forceinline__ unsigned xb_ld(unsigned* p)              { return __hip_atomic_load(p, __ATOMIC_RELAXED, __HIP_MEMORY_SCOPE_AGENT); }
__device__ __forceinline__ unsigned xb_add(unsigned* p, unsigned v) { return __hip_atomic_fetch_add(p, v, __ATOMIC_RELAXED, __HIP_MEMORY_SCOPE_AGENT); }
__device__ __forceinline__ unsigned xb_xcc_id() { return (unsigned)__builtin_amdgcn_s_getreg((3 << 11) | 20) & 0xFu; }
#define XB_SPIN(cond, bar) do { unsigned _sp = 0; while (cond) { __builtin_amdgcn_s_sleep(1); \
    if ((++_sp & 255u) == 0u) { if (xb_ld(&(bar)[XB_TMO])) break; if (_sp > XB_SPIN_CAP) { atomicAdd(&(bar)[XB_TMO], 1u); break; } } } } while (0)

struct XcdBarrier { unsigned* bar; unsigned x; volatile LAS unsigned* st; int wv; };

__device__ __forceinline__ XcdBarrier xcd_barrier_post(unsigned* bar, volatile LAS unsigned* st, int wv) {
    XcdBarrier b; b.bar = bar; b.x = xb_xcc_id(); b.st = st; b.wv = wv;
    if (wv == 0 && lane_id() == 0) (void)xb_add(&bar[XB_XCNT(b.x)], 1u);
    return b;
}
__device__ __forceinline__ void xcd_barrier_complete(unsigned* bar, unsigned x, unsigned& nloc, unsigned& nx) {
    const unsigned G = gridDim.x * gridDim.y * gridDim.z;
    unsigned sum, cnt, mine, sp = 0u;
    for (;;) {
        sum = 0u; cnt = 0u; mine = 0u;
#pragma unroll
        for (unsigned j = 0; j < 16; ++j) { const unsigned c = xb_ld(&bar[XB_XCNT(j)]); sum += c; cnt += (c > 0u) ? 1u : 0u; mine = (j == x) ? c : mine; }
        if (sum == G) break;
        __builtin_amdgcn_s_sleep(1);
        if ((++sp & 255u) == 0u) { if (xb_ld(&bar[XB_TMO])) break; if (sp > XB_SPIN_CAP) { atomicAdd(&bar[XB_TMO], 1u); break; } }
    }
    nloc = mine > 0u ? mine : 1u; nx = cnt > 0u ? cnt : 1u;
}
__device__ __forceinline__ void xcd_barrier(const XcdBarrier& b) {
    asm volatile("s_waitcnt vmcnt(0)" ::: "memory");
    __syncthreads();
    if (b.wv == 0 && lane_id() == 0) {
        unsigned* bar = b.bar;
        __builtin_amdgcn_s_waitcnt(0);
        unsigned nloc = b.st[0], nx = b.st[1];
        if (nloc == 0u) { xcd_barrier_complete(bar, b.x, nloc, nx); b.st[0] = nloc; b.st[1] = nx; }
        const unsigned old = xb_add(&bar[XB_XSUB(b.x)], 1u);
        const unsigned gen = old / nloc;
        if (old + 1u == (gen + 1u) * nloc) {
            __builtin_amdgcn_fence(__ATOMIC_RELEASE, "agent");
            asm volatile("s_waitcnt vmcnt(0)" ::: "memory");
            const unsigned og = xb_add(&bar[XB_TOP], 1u);
            const unsigned tg = og / nx;
            if (og + 1u == (tg + 1u) * nx) xb_add(&bar[XB_TOPGEN], 1u);
            else XB_SPIN(xb_ld(&bar[XB_TOPGEN]) == tg, bar);
            __builtin_amdgcn_fence(__ATOMIC_ACQUIRE, "agent");
            xb_add(&bar[XB_XGEN(b.x)], 1u);
            asm volatile("s_waitcnt vmcnt(0)" ::: "memory");
        } else {
            XB_SPIN(xb_ld(&bar[XB_XGEN(b.x)]) == gen, bar);
            __builtin_amdgcn_fence(__ATOMIC_ACQUIRE, "agent");
            asm volatile("s_waitcnt vmcnt(0)" ::: "memory");
        }
    }
    __syncthreads();
}

__device__ __forceinline__ void xl_barrier(gu32* ctl, unsigned* bar, int xi, int NR, int& gen, int wv) {
    asm volatile("s_waitcnt vmcnt(0)" ::: "memory");
    __syncthreads();
    if (wv == 0 && lane_id() == 0) {
        unsigned* c = (unsigned*)(ctl + CW_LBAR + 64 * xi);
        (void)xb_add(c, 1u);
        const unsigned target = (unsigned)NR * (unsigned)(gen + 1);
        XB_SPIN(xb_ld(c) < target, bar);
        __builtin_amdgcn_fence(__ATOMIC_ACQUIRE, "agent");
        asm volatile("s_waitcnt vmcnt(0)" ::: "memory");
    }
    __syncthreads();
    ++gen;
}

#define DPP_REDUCE(v, OP, IDENT) do { \
        v = OP(v, __builtin_bit_cast(float, __builtin_amdgcn_update_dpp(__builtin_bit_cast(int, v), __builtin_bit_cast(int, v), 0xB1, 0xF, 0xF, false)));    \
        v = OP(v, __builtin_bit_cast(float, __builtin_amdgcn_update_dpp(__builtin_bit_cast(int, v), __builtin_bit_cast(int, v), 0x4E, 0xF, 0xF, false)));    \
        v = OP(v, __builtin_bit_cast(float, __builtin_amdgcn_update_dpp(__builtin_bit_cast(int, v), __builtin_bit_cast(int, v), 0x141, 0xF, 0xF, false)));   \
        v = OP(v, __builtin_bit_cast(float, __builtin_amdgcn_update_dpp(__builtin_bit_cast(int, v), __builtin_bit_cast(int, v), 0x140, 0xF, 0xF, false)));   \
        v = OP(v, __builtin_bit_cast(float, __builtin_amdgcn_update_dpp(__builtin_bit_cast(int, (float)(IDENT)), __builtin_bit_cast(int, v), 0x142, 0xA, 0xF, false)));   \
        v = OP(v, __builtin_bit_cast(float, __builtin_amdgcn_update_dpp(__builtin_bit_cast(int, (float)(IDENT)), __builtin_bit_cast(int, v), 0x143, 0xC, 0xF, false)));   \
    } while (0)
__device__ __forceinline__ float dpp_add(float a, float b) { return a + b; }
__device__ __forceinline__ float wave_sum(float v) {
    DPP_REDUCE(v, dpp_add, 0.0f);
    return __builtin_bit_cast(float, __builtin_amdgcn_readlane(__builtin_bit_cast(int, v), 63));
}
__device__ __forceinline__ float wave_max_nonneg(float v) {
    DPP_REDUCE(v, fmaxf, 0.0f);
    return __builtin_bit_cast(float, __builtin_amdgcn_readlane(__builtin_bit_cast(int, v), 63));
}
__device__ __forceinline__ float sq4(f32x4 v) { return (v.x * v.x + v.y * v.y) + (v.z * v.z + v.w * v.w); }
__device__ __forceinline__ float log2_gamma(int h) { return log2f(1.0f - exp2f(-5.0f - (float)h)); }

__device__ __forceinline__ void cvt_item(const float* W, int N, int k0, int n0, bf16* WT, int K, int drow0, LAS float* scr, int lane) {
    float wv[32];
#pragma unroll
    for (int i = 0; i < 32; ++i) { const int kk = 2 * i + (lane >> 5); wv[i] = W[(size_t)(k0 + kk) * N + n0 + (lane & 31)]; }
#pragma unroll
    for (int i = 0; i < 32; ++i) { const int kk = 2 * i + (lane >> 5); scr[kk * 33 + (lane & 31)] = wv[i]; }
    LDS_WAIT(); asm volatile("" ::: "memory");
    const int c = lane & 7;
#pragma unroll
    for (int j = 0; j < 4; ++j) { const int n = (lane >> 3) + 8 * j; const LAS float* s = scr + (8 * c) * 33 + n;
        v4u o; o.x = pk2(s[0 * 33], s[1 * 33]); o.y = pk2(s[2 * 33], s[3 * 33]); o.z = pk2(s[4 * 33], s[5 * 33]); o.w = pk2(s[6 * 33], s[7 * 33]);
        *(GAS v4u*)(WT + (size_t)(drow0 + n) * K + k0 + 8 * c) = o; }
    LDS_WAIT(); asm volatile("" ::: "memory");
}

__device__ __forceinline__ void cvt_item8(const float* W, int N, int k0, int n0, unsigned char* WT, int K, int drow0, LAS float* scr, int lane) {
    float wv[32];
#pragma unroll
    for (int i = 0; i < 32; ++i) { const int kk = 2 * i + (lane >> 5); wv[i] = W[(size_t)(k0 + kk) * N + n0 + (lane & 31)]; }
#pragma unroll
    for (int i = 0; i < 32; ++i) { const int kk = 2 * i + (lane >> 5); scr[kk * 33 + (lane & 31)] = wv[i]; }
    LDS_WAIT(); asm volatile("" ::: "memory");
    const int c = lane & 3; const float sc = (float)(1 << pg8::W8_SHIFT);
#pragma unroll
    for (int j = 0; j < 2; ++j) { const int n = (lane >> 2) + 16 * j; const LAS float* sp = scr + (16 * c) * 33 + n;
        int w[4];
#pragma unroll
        for (int q = 0; q < 4; ++q) { int t = 0; t = __builtin_amdgcn_cvt_pk_fp8_f32(sp[(4 * q + 0) * 33] * sc, sp[(4 * q + 1) * 33] * sc, t, false); t = __builtin_amdgcn_cvt_pk_fp8_f32(sp[(4 * q + 2) * 33] * sc, sp[(4 * q + 3) * 33] * sc, t, true); w[q] = t; }
        *(GAS v4i*)(WT + (size_t)(drow0 + n) * K + k0 + 16 * c) = (v4i){w[0], w[1], w[2], w[3]}; }
    LDS_WAIT(); asm volatile("" ::: "memory");
}

__device__ __forceinline__ void cvt_item_i8(const float* W, int N, int k0, int n0, signed char* WT, int K, int drow0, float q, LAS float* scr, int lane) {
    float wv[32];
#pragma unroll
    for (int i = 0; i < 32; ++i) { const int kk = 2 * i + (lane >> 5); wv[i] = W[(size_t)(k0 + kk) * N + n0 + (lane & 31)]; }
#pragma unroll
    for (int i = 0; i < 32; ++i) { const int kk = 2 * i + (lane >> 5); scr[kk * 33 + (lane & 31)] = wv[i]; }
    LDS_WAIT(); asm volatile("" ::: "memory");
    const int c = lane & 3;
#pragma unroll
    for (int j = 0; j < 2; ++j) { const int n = (lane >> 2) + 16 * j; const LAS float* sp = scr + (16 * c) * 33 + n;
        int w[4];
#pragma unroll
        for (int t = 0; t < 4; ++t) { const int a = __float2int_rn(__builtin_amdgcn_fmed3f(sp[(4 * t + 0) * 33] * q, -127.f, 127.f)), b = __float2int_rn(__builtin_amdgcn_fmed3f(sp[(4 * t + 1) * 33] * q, -127.f, 127.f)), cc = __float2int_rn(__builtin_amdgcn_fmed3f(sp[(4 * t + 2) * 33] * q, -127.f, 127.f)), d = __float2int_rn(__builtin_amdgcn_fmed3f(sp[(4 * t + 3) * 33] * q, -127.f, 127.f));
            w[t] = (int)((unsigned)(a & 255) | ((unsigned)(b & 255) << 8) | ((unsigned)(cc & 255) << 16) | ((unsigned)(d & 255) << 24)); }
        *(GAS v4i*)(WT + (size_t)(drow0 + n) * K + k0 + 16 * c) = (v4i){w[0], w[1], w[2], w[3]}; }
    LDS_WAIT(); asm volatile("" ::: "memory");
}

struct Args { const float* in[20]; float* out; unsigned char* ws; int lo, hi; };
struct Frame {
    LAS unsigned char* lds;
    gu32* ctl;
    int G, wv;
    int xi, rank;
    int crow;
    __device__ __forceinline__ int NR_() const { return G >> 3; }
    __device__ __forceinline__ int vb_() const { return rank * 8 + xi; }
    __device__ __forceinline__ int vid_() const { return xi * (G >> 3) + rank; }
    float* out; unsigned char* ws;
};
__device__ __forceinline__ void fresh_ids(Frame& F) { int a = __builtin_amdgcn_readfirstlane(F.xi), b = __builtin_amdgcn_readfirstlane(F.rank); asm volatile("" : "+s"(a), "+s"(b)); F.xi = a; F.rank = b; }
enum { I_X = 0, I_C, I_WADA, I_BADA, I_NPM, I_WIN, I_WATT, I_WRET, I_WMIX, I_NPOM, I_NPF, I_WFG, I_WFU, I_WFD, I_WROUT, I_BROUT, I_WEG, I_WEU, I_WED, I_NPOF };

__device__ __forceinline__ void convert_mixer_weights(Frame& F, const Args& A_, int l) {
    int tid_ = F.wv * 64 + lane_id(); asm volatile("" : "+v"(tid_)); const int tid = tid_, lane = tid & 63, wave = __builtin_amdgcn_readfirstlane(tid >> 6), gw = blockIdx.x * NWAVES + wave, NGW = F.G * NWAVES;
    LAS float* scr = (LAS float*)(F.lds + wave * 16384);
    bf16* wm = (bf16*)(F.ws + WS_WM);
    constexpr int I_A = (256 / 64) * (DM / 32), I_R = (DM / 64) * (DM / 32), NIT = I_A + 2 * I_R;
    for (int it = gw; it < NIT; it += NGW) {
        int r = it;
        if (r < I_A) { const int nb = DM / 32, kb = r / nb, n0 = (r % nb) * 32; cvt_item(A_.in[I_WATT] + (size_t)l * 256 * DM, DM, kb * 64, n0, (bf16*)((char*)wm + WM_WA), 256, n0, scr, lane); continue; } r -= I_A;
        if (r < I_R) { const int nb = DM / 32, kb = r / nb, n0 = (r % nb) * 32; cvt_item(A_.in[I_WRET] + (size_t)l * DM * DM, DM, kb * 64, n0, (bf16*)((char*)wm + WM_WR), DM, n0, scr, lane); continue; } r -= I_R;
        { const int nb = DM / 32, kb = r / nb, n0 = (r % nb) * 32; cvt_item(A_.in[I_WMIX] + (size_t)l * DM * DM, DM, kb * 64, n0, (bf16*)((char*)wm + WM_WMIX), DM, n0, scr, lane); }
    }
}
__device__ __forceinline__ float max4(f32x4 v) { return fmaxf(fmaxf(fabsf(v.x), fabsf(v.y)), fmaxf(fabsf(v.z), fabsf(v.w))); }
__device__ __forceinline__ void absmax_phase(Frame& F, const Args& A_) {
    int tid_ = F.wv * 64 + lane_id(); asm volatile("" : "+v"(tid_)); const int tid = tid_, lane = tid & 63; const int b = blockIdx.x;
    if (F.G >= 256) {
        { constexpr int N4 = DM * NCOL / 4, SL = (N4 + 127) / 128; const int l = b & 1, sl = (b >> 1) & 127;
          if (b < 256) { const f32x4* W = (const f32x4*)(A_.in[I_WIN] + (size_t)l * DM * NCOL); const int end = (sl + 1) * SL < N4 ? (sl + 1) * SL : N4; float mx = 0.f;
            for (int i = sl * SL + tid; i < end; i += 8 * 512) { f32x4 v[8];
#pragma unroll
                for (int u = 0; u < 8; ++u) { const int ii = i + u * 512; v[u] = W[ii < end ? ii : i]; }
#pragma unroll
                for (int u = 0; u < 8; ++u) mx = fmaxf(mx, max4(v[u])); }
            mx = wave_max_nonneg(mx);
            if (lane == 0) __hip_atomic_fetch_max((unsigned*)(F.ctl + CW_WMAX + l), __builtin_bit_cast(unsigned, mx), RLX_AGENT); } }
        { constexpr int NH = 128 * FF / 4, N4 = 2 * NH, NS = 28, SL = (N4 + NS - 1) / NS; const int t = b % 9, sl = b / 9;
          if (sl < NS) { const f32x4* Wg = (const f32x4*)(t == 0 ? A_.in[I_WFG] : A_.in[I_WEG] + (size_t)(t - 1) * DM * FF); const f32x4* Wu = (const f32x4*)(t == 0 ? A_.in[I_WFU] : A_.in[I_WEU] + (size_t)(t - 1) * DM * FF);
            const int end = (sl + 1) * SL < N4 ? (sl + 1) * SL : N4; float mx = 0.f;
            for (int i = sl * SL + tid; i < end; i += 4 * 512) { f32x4 v[4];
#pragma unroll
                for (int u = 0; u < 4; ++u) { int ii = i + u * 512; if (ii >= end) ii = i; v[u] = ii < NH ? Wg[ii] : Wu[ii - NH]; }
#pragma unroll
                for (int u = 0; u < 4; ++u) mx = fmaxf(mx, max4(v[u])); }
            mx = wave_max_nonneg(mx);
            if (lane == 0) __hip_atomic_fetch_max((unsigned*)(F.ctl + CW_FMAX + t), __builtin_bit_cast(unsigned, mx), RLX_AGENT); } }
    } else {
        for (int l = 0; l < DEPTH; ++l) { constexpr int N4 = DM * NCOL / 4; const f32x4* W = (const f32x4*)(A_.in[I_WIN] + (size_t)l * DM * NCOL); float mx = 0.f;
            for (int i = b * 512 + tid; i < N4; i += F.G * 512) mx = fmaxf(mx, max4(W[i]));
            mx = wave_max_nonneg(mx);
            if (lane == 0) __hip_atomic_fetch_max((unsigned*)(F.ctl + CW_WMAX + l), __builtin_bit_cast(unsigned, mx), RLX_AGENT); }
        for (int t = 0; t < 9; ++t) { constexpr int NH = 128 * FF / 4; const f32x4* Wg = (const f32x4*)(t == 0 ? A_.in[I_WFG] : A_.in[I_WEG] + (size_t)(t - 1) * DM * FF); const f32x4* Wu = (const f32x4*)(t == 0 ? A_.in[I_WFU] : A_.in[I_WEU] + (size_t)(t - 1) * DM * FF); float mx = 0.f;
            for (int i = b * 512 + tid; i < NH; i += F.G * 512) mx = fmaxf(mx, fmaxf(max4(Wg[i]), max4(Wu[i])));
            mx = wave_max_nonneg(mx);
            if (lane == 0) __hip_atomic_fetch_max((unsigned*)(F.ctl + CW_FMAX + t), __builtin_bit_cast(unsigned, mx), RLX_AGENT); }
    }
}
__device__ __forceinline__ void convert_win(Frame& F, const Args& A_, int l) {
    int tid_ = F.wv * 64 + lane_id(); asm volatile("" : "+v"(tid_)); const int tid = tid_, lane = tid & 63, wave = __builtin_amdgcn_readfirstlane(tid >> 6), gw = blockIdx.x * NWAVES + wave, NGW = F.G * NWAVES;
    LAS float* scr = (LAS float*)(F.lds + wave * 16384);
    const float mx = fmaxf(__builtin_bit_cast(float, __hip_atomic_load((unsigned*)(F.ctl + CW_WMAX + l), RLX_AGENT)), 1e-30f);
    const float q = 127.0f / mx;
    if (blockIdx.x == 0 && tid == 0) ((float*)(F.ws + WS_WSC))[l] = mx * (1.0f / 127.0f);
    constexpr int I_IN = (DM / 64) * (NCOL / 32);
    for (int it = gw; it < I_IN; it += NGW) { const int nb = NCOL / 32, kb = it / nb, n0 = (it % nb) * 32;
        cvt_item_i8(A_.in[I_WIN] + (size_t)l * DM * NCOL, NCOL, kb * 64, n0, (signed char*)(F.ws + WS_WM + WM_WIN), DM, n0, q, scr, lane); }
}
__device__ __forceinline__ void convert_ffn_weights(Frame& F, const float* wg, const float* wu, const float* wd, int tmax0, int it_lo, int it_hi, int gwi, int ngw) {
    int tid_ = F.wv * 64 + lane_id(); asm volatile("" : "+v"(tid_)); const int tid = tid_, lane = tid & 63, wave = __builtin_amdgcn_readfirstlane(tid >> 6);
    LAS float* scr = (LAS float*)(F.lds + wave * 16384);
    constexpr int I_G = (DM / 64) * (FF / 32), I_D = (FF / 64) * (DM / 32), PER = 2 * I_G + I_D;
    for (int it = it_lo + gwi; it < it_hi; it += ngw) {
        const int e = it / PER; int r = it % PER;
        unsigned char* wgu_t = F.ws + WS_WF + (size_t)e * WF_E; unsigned char* wd_t = wgu_t + WF_GU;
        if (r < 2 * I_G) { const int up = r >= I_G; if (up) r -= I_G; const int nb = FF / 32, kb = r / nb, n0 = (r % nb) * 32;
            const float mx = 1.25f * fmaxf(__builtin_bit_cast(float, __hip_atomic_load((unsigned*)(F.ctl + CW_FMAX + tmax0 + e), RLX_AGENT)), 1e-30f);
            if (r == 0 && !up && lane == 0) ((float*)(F.ws + WS_WSCF))[e] = mx * (1.0f / 127.0f);
            cvt_item_i8((up ? wu : wg) + (size_t)e * DM * FF, FF, kb * 64, n0, (signed char*)wgu_t, DM, (n0 >> 7) * 256 + (n0 & 127) + (up ? 128 : 0), 127.0f / mx, scr, lane); continue; }
        r -= 2 * I_G;
        { const int nb = DM / 32, kb = r / nb, n0 = (r % nb) * 32; cvt_item8(wd + (size_t)e * FF * DM, DM, kb * 64, n0, wd_t, FF, n0, scr, lane); }
    }
}
constexpr int FFN_ITEMS = 2 * (DM / 64) * (FF / 32) + (FF / 64) * (DM / 32);

__device__ __forceinline__ void adaln_phase(Frame& F, const Args& A_) {
    int tid_ = F.wv * 64 + lane_id(); asm volatile("" : "+v"(tid_)); const int tid = tid_, lane = tid & 63, wave = __builtin_amdgcn_readfirstlane(tid >> 6), gw = blockIdx.x * NWAVES + wave, NGW = F.G * NWAVES; (void)lane; (void)gw; (void)NGW; (void)tid;
    LAS float* cact = (LAS float*)F.lds;
    LAS float* part = (LAS float*)(F.lds + 65536);
    const float* c = A_.in[I_C];
    for (int i = tid; i < BATCH * DM; i += 512) { const float v = c[i]; cact[i] = v / (1.0f + __expf(-v)); }
    __syncthreads();
    float* mod = (float*)(F.ws + WS_MOD);
    for (int item = blockIdx.x; item < DEPTH * 96; item += F.G) {
        const int l = item / 96, n0 = (item % 96) * 64, n = n0 + lane;
        const float* W = A_.in[I_WADA] + (size_t)l * DM * 6 * DM;
        float acc[16];
#pragma unroll
        for (int b = 0; b < 16; ++b) acc[b] = 0.f;
        const int kb = wave * 128;
        for (int k = kb; k < kb + 128; k += 16) {
            float wv[16];
#pragma unroll
            for (int i = 0; i < 16; ++i) wv[i] = W[(size_t)(k + i) * 6144 + n];
#pragma unroll
            for (int q = 0; q < 4; ++q)
#pragma unroll
                for (int b = 0; b < 16; ++b) { const f32x4 cv = *(const LAS f32x4*)(cact + b * DM + k + 4 * q); acc[b] += (cv.x * wv[4 * q] + cv.y * wv[4 * q + 1]) + (cv.z * wv[4 * q + 2] + cv.w * wv[4 * q + 3]); }
        }
#pragma unroll
        for (int b = 0; b < 16; ++b) part[(wave * 16 + b) * 64 + lane] = acc[b];
        __syncthreads();
        for (int o = tid; o < 1024; o += 512) { const int b = o >> 6, nn = o & 63; float s = 0.f;
#pragma unroll
            for (int w = 0; w < 8; ++w) s += part[(w * 16 + b) * 64 + nn];
            mod[((size_t)l * 16 + b) * 6144 + n0 + nn] = s + A_.in[I_BADA][(size_t)l * 6144 + n0 + nn]; }
        __syncthreads();
    }
}
__device__ __forceinline__ void rope_phase(Frame& F) {
    int tid_ = F.wv * 64 + lane_id(); asm volatile("" : "+v"(tid_)); const int tid = tid_, lane = tid & 63, wave = __builtin_amdgcn_readfirstlane(tid >> 6), gw = blockIdx.x * NWAVES + wave, NGW = F.G * NWAVES; (void)lane; (void)gw; (void)NGW; (void)tid;
    float* rope = (float*)(F.ws + WS_ROPE);
    for (int i = blockIdx.x * 512 + tid; i < SEQ * 32; i += F.G * 512) {
        const int pos = i >> 5, k = i & 31;
        const float inv = 1.0f / powf(10000.0f, (float)k / 32.0f);
        const float ang = (float)pos * inv;
        float s, c; sincosf(ang, &s, &c);
        rope[pos * 64 + k] = c; rope[pos * 64 + 32 + k] = s;
    }
}

__device__ __forceinline__ void norm_mod_store(const f32x4 (&v)[4], const float* gain, const float* sc, const float* sh, signed char* orow, float* rsp, int lane) {
    float ss = 0.f;
#pragma unroll
    for (int j = 0; j < 4; ++j) ss += sq4(v[j]);
    const float r = rsqrtf(wave_sum(ss) * (1.0f / DM) + EPS);
    f32x4 o[4]; float mx = 0.f;
#pragma unroll
    for (int j = 0; j < 4; ++j) { const int k = 4 * lane + 256 * j;
        const f32x4 g = *(const f32x4*)(gain + k), s1 = *(const f32x4*)(sc + k), s0 = *(const f32x4*)(sh + k);
        o[j] = (v[j] * r) * g * (s1 + 1.0f) + s0;
        mx = fmaxf(mx, fmaxf(fmaxf(fabsf(o[j].x), fabsf(o[j].y)), fmaxf(fabsf(o[j].z), fabsf(o[j].w)))); }
    mx = wave_max_nonneg(mx);
    mx = fmaxf(mx, 1e-20f);
    const float q = 127.0f / mx;
#pragma unroll
    for (int j = 0; j < 4; ++j) { const int k = 4 * lane + 256 * j;
        const int a = __float2int_rn(o[j].x * q), b = __float2int_rn(o[j].y * q), c = __float2int_rn(o[j].z * q), d = __float2int_rn(o[j].w * q);
        *(unsigned*)(orow + k) = (unsigned)(a & 255) | ((unsigned)(b & 255) << 8) | ((unsigned)(c & 255) << 16) | ((unsigned)(d & 255) << 24); }
    if (lane == 0) *rsp = mx * (1.0f / 127.0f);
}
__device__ __forceinline__ void norm_mod_store_reg(const f32x4 (&v)[4], const f32x4 (&vn)[4], const f32x4 (&vs)[4], signed char* orow, float* rsp, int lane) {
    float ss = 0.f;
#pragma unroll
    for (int j = 0; j < 4; ++j) ss += sq4(v[j]);
    const float r = rsqrtf(wave_sum(ss) * (1.0f / DM) + EPS);
    f32x4 o[4]; float mx = 0.f;
#pragma unroll
    for (int j = 0; j < 4; ++j) { o[j] = (v[j] * r) * vn[j] + vs[j];
        mx = fmaxf(mx, fmaxf(fmaxf(fabsf(o[j].x), fabsf(o[j].y)), fmaxf(fabsf(o[j].z), fabsf(o[j].w)))); }
    mx = wave_max_nonneg(mx);
    mx = fmaxf(mx, 1e-20f);
    const float q = 127.0f / mx;
#pragma unroll
    for (int j = 0; j < 4; ++j) { const int k = 4 * lane + 256 * j;
        const int a = __float2int_rn(o[j].x * q), b = __float2int_rn(o[j].y * q), c = __float2int_rn(o[j].z * q), d = __float2int_rn(o[j].w * q);
        *(unsigned*)(orow + k) = (unsigned)(a & 255) | ((unsigned)(b & 255) << 8) | ((unsigned)(c & 255) << 16) | ((unsigned)(d & 255) << 24); }
    if (lane == 0) *rsp = mx * (1.0f / 127.0f);
}
__device__ __forceinline__ void load_row_bf16(const bf16* row, f32x4 (&v)[4], int lane) {
#pragma unroll
    for (int j = 0; j < 4; ++j) { const v2u w = *(const v2u*)(row + 4 * lane + 256 * j); v[j] = (f32x4){bflo(w.x), bfhi(w.x), bflo(w.y), bfhi(w.y)}; }
}

constexpr int RW = 2;
__device__ __forceinline__ void phase_a(Frame& F, const Args& A_) {
    int tid_ = F.wv * 64 + lane_id(); asm volatile("" : "+v"(tid_)); const int tid = tid_, lane = tid & 63, wave = __builtin_amdgcn_readfirstlane(tid >> 6), gw = blockIdx.x * NWAVES + wave, NGW = F.G * NWAVES;
    const float* mod = (const float*)(F.ws + WS_MOD); signed char* hb = (signed char*)(F.ws + WS_H);
    const int WPB = NGW / BATCH, blw = gw / WPB, wi = gw % WPB, mbase = blw * SEQ, mend = mbase + SEQ;
    if (blw >= BATCH) return;
    const float* mb = mod + (size_t)blw * 6144;
    f32x4 vn[4], vs[4];
#pragma unroll
    for (int j = 0; j < 4; ++j) { const int k = 4 * lane + 256 * j; vn[j] = *(const f32x4*)(A_.in[I_NPM] + k) * (*(const f32x4*)(mb + 1024 + k) + 1.0f); vs[j] = *(const f32x4*)(mb + k); }
    f32x4 nx[RW][4];
#define PA_ISSUE(mm0) do { _Pragma("unroll") for (int r = 0; r < RW; ++r) { const int m = (mm0) + r * WPB < mend ? (mm0) + r * WPB : (mm0); \
        _Pragma("unroll") for (int j = 0; j < 4; ++j) nx[r][j] = *(const f32x4*)(A_.in[I_X] + (size_t)m * DM + 4 * lane + 256 * j); } } while (0)
    if (mbase + wi < mend) PA_ISSUE(mbase + wi);
    for (int m0 = mbase + wi; m0 < mend; m0 += RW * WPB) {
        f32x4 v[RW][4];
#pragma unroll
        for (int r = 0; r < RW; ++r)
#pragma unroll
            for (int j = 0; j < 4; ++j) v[r][j] = nx[r][j];
        if (m0 + RW * WPB < mend) PA_ISSUE(m0 + RW * WPB);
#pragma unroll
        for (int r = 0; r < RW; ++r) { const int m = m0 + r * WPB; if (m < mend) norm_mod_store_reg(v[r], vn, vs, hb + (size_t)m * DM, (float*)(F.ws + WS_RS) + m, lane); }
    }
#undef PA_ISSUE
}

template <bool L0, bool MOE>
__device__ __forceinline__ void phase_h_t(Frame& F, const Args& A_, int l, int ch, int bi, int nb, bool first) {
    constexpr bool moe = MOE;
    int tid_ = F.wv * 64 + lane_id(); asm volatile("" : "+v"(tid_)); const int tid = tid_, lane = tid & 63, wave = __builtin_amdgcn_readfirstlane(tid >> 6), gw = bi * NWAVES + wave, NGW = nb * NWAVES;
    const float* mod = (const float*)(F.ws + WS_MOD) + (size_t)l * 16 * 6144; unsigned char* h8 = F.ws + WS_H;
    const bf16* Y = (const bf16*)(F.ws + WS_Y);
    const float* xin = A_.in[I_X]; bf16* xb = (bf16*)(F.ws + WS_XB);
    LAS float* wr = (LAS float*)F.lds;
    LAS int* cntL = (LAS int*)(F.lds + MISC_OFF + 64);
    if (moe) {
        if (first) for (int i = tid; i < DM * NEXP; i += 512) wr[i] = A_.in[I_WROUT][i];
        if (tid < 8) cntL[tid] = 0;
        __syncthreads();
    }
    const float* gpost = A_.in[I_NPOM] + (size_t)l * DM; const float* gffn = A_.in[I_NPF] + (size_t)l * DM;
    const int WPB = NGW / CB, blw = gw / WPB, wi = gw % WPB, mbase = ch * TC + blw * SEQ, mend = mbase + SEQ;
    const float* mb = mod + (size_t)(ch * CB + blw) * 6144;
    f32x4 vg1[4], vgf[4];
#pragma unroll
    for (int j = 0; j < 4; ++j) { const int k = 4 * lane + 256 * j; vg1[j] = *(const f32x4*)(mb + 2048 + k) * *(const f32x4*)(gpost + k); vgf[j] = *(const f32x4*)(gffn + k) * (*(const f32x4*)(mb + 4096 + k) + 1.0f); }
    v2u ry[RW][4], rx[RW][4]; f32x4 rxf[RW][4];
#define PH_ISSUE(mm0) do { _Pragma("unroll") for (int r = 0; r < RW; ++r) { const int m = (mm0) + r * WPB < mend ? (mm0) + r * WPB : (mm0); \
        _Pragma("unroll") for (int j = 0; j < 4; ++j) { ry[r][j] = *(const v2u*)(Y + (size_t)m * DM + 4 * lane + 256 * j); \
            if (L0) rxf[r][j] = *(const f32x4*)(xin + (size_t)m * DM + 4 * lane + 256 * j); else rx[r][j] = *(const v2u*)(xb + (size_t)m * DM + 4 * lane + 256 * j); } } } while (0)
    constexpr bool PF = !MOE;
    if (PF && mbase + wi < mend) PH_ISSUE(mbase + wi);
    for (int m0 = mbase + wi; m0 < mend; m0 += RW * WPB) {
        const int NGWr = WPB;
        f32x4 y[RW][4], x[RW][4], h[RW][4]; float ss[RW], ss2[RW];
        f32x4 vsh[4];
#pragma unroll
        for (int j = 0; j < 4; ++j) vsh[j] = *(const f32x4*)(mb + 3072 + 4 * lane + 256 * j);
        if (!PF) PH_ISSUE(m0);
#pragma unroll
        for (int r = 0; r < RW; ++r)
#pragma unroll
            for (int j = 0; j < 4; ++j) { const v2u w = ry[r][j]; y[r][j] = (f32x4){bflo(w.x), bfhi(w.x), bflo(w.y), bfhi(w.y)};
                if (L0) x[r][j] = rxf[r][j]; else { const v2u u = rx[r][j]; x[r][j] = (f32x4){bflo(u.x), bfhi(u.x), bflo(u.y), bfhi(u.y)}; } }
        if (PF && m0 + RW * WPB < mend) PH_ISSUE(m0 + RW * WPB);
#pragma unroll
        for (int r = 0; r < RW; ++r) { ss[r] = 0.f;
#pragma unroll
            for (int j = 0; j < 4; ++j) ss[r] += sq4(y[r][j]); }
#pragma unroll
        for (int r = 0; r < RW; ++r) ss[r] = wave_sum(ss[r]);
#pragma unroll
        for (int r = 0; r < RW; ++r) { const int m = m0 + r * NGWr < mend ? m0 + r * NGWr : m0;
            const float rr = rsqrtf(ss[r] * (1.0f / DM) + EPS); ss2[r] = 0.f;
#pragma unroll
            for (int j = 0; j < 4; ++j) { const int k = 4 * lane + 256 * j;
                x[r][j] = x[r][j] + vg1[j] * (y[r][j] * rr);
                if (m0 + r * NGWr < mend) *(v2u*)(xb + (size_t)m * DM + k) = (v2u){pk2(x[r][j].x, x[r][j].y), pk2(x[r][j].z, x[r][j].w)};
                ss2[r] += sq4(x[r][j]); } }
#pragma unroll
        for (int r = 0; r < RW; ++r) ss2[r] = wave_sum(ss2[r]);
#pragma unroll
        for (int r = 0; r < RW; ++r) { const int m = m0 + r * NGWr < mend ? m0 + r * NGWr : m0;
            const float r2 = rsqrtf(ss2[r] * (1.0f / DM) + EPS); float mx = 0.f;
#pragma unroll
            for (int j = 0; j < 4; ++j) {
                h[r][j] = (x[r][j] * r2) * vgf[j] + vsh[j];
                mx = fmaxf(mx, fmaxf(fmaxf(fabsf(h[r][j].x), fabsf(h[r][j].y)), fmaxf(fabsf(h[r][j].z), fabsf(h[r][j].w)))); }
            mx = wave_max_nonneg(mx);
            mx = fmaxf(mx, 1e-20f); const float q = 127.0f / mx;
            if (m0 + r * NGWr < mend) {
#pragma unroll
                for (int j = 0; j < 4; ++j) { const int k = 4 * lane + 256 * j;
                    const int a = __float2int_rn(h[r][j].x * q), b = __float2int_rn(h[r][j].y * q), c = __float2int_rn(h[r][j].z * q), d = __float2int_rn(h[r][j].w * q);
                    *(unsigned*)(h8 + (size_t)m * DM + k) = (unsigned)(a & 255) | ((unsigned)(b & 255) << 8) | ((unsigned)(c & 255) << 16) | ((unsigned)(d & 255) << 24); }
                if (lane == 0) ((float*)(F.ws + WS_RS))[m] = mx * (1.0f / 127.0f); } }
        if (moe) {
            float lg[RW][8];
#pragma unroll
            for (int r = 0; r < RW; ++r) {
#pragma unroll
                for (int e = 0; e < 8; ++e) lg[r][e] = 0.f;
#pragma unroll
                for (int j = 0; j < 4; ++j)
#pragma unroll
                    for (int i = 0; i < 4; ++i) { const int k = 4 * lane + 256 * j + i; const f32x4 wa = *(const LAS f32x4*)(wr + k * 8), wb = *(const LAS f32x4*)(wr + k * 8 + 4); const float hv = h[r][j][i];
                        lg[r][0] += hv * wa.x; lg[r][1] += hv * wa.y; lg[r][2] += hv * wa.z; lg[r][3] += hv * wa.w; lg[r][4] += hv * wb.x; lg[r][5] += hv * wb.y; lg[r][6] += hv * wb.z; lg[r][7] += hv * wb.w; } }
#pragma unroll
            for (int e = 0; e < 8; ++e)
#pragma unroll
                for (int r = 0; r < RW; ++r) lg[r][e] = wave_sum(lg[r][e]) + A_.in[I_BROUT][e];
#pragma unroll
            for (int r = 0; r < RW; ++r) { const int m = m0 + r * NGWr;
                int e1 = 0; float v1 = lg[r][0];
#pragma unroll
                for (int e = 1; e < 8; ++e) if (lg[r][e] > v1) { v1 = lg[r][e]; e1 = e; }
                int e2 = -1; float v2 = -3.0e38f;
#pragma unroll
                for (int e = 0; e < 8; ++e) if (e != e1 && lg[r][e] > v2) { v2 = lg[r][e]; e2 = e; }
                const float p1 = 1.0f / (1.0f + __expf(v2 - v1)), p2 = 1.0f - p1;
                if (lane == 0 && m < mend) {
                    const int lr1 = __hip_atomic_fetch_add(cntL + e1, 1, __ATOMIC_RELAXED, __HIP_MEMORY_SCOPE_WORKGROUP);
                    const int lr2 = __hip_atomic_fetch_add(cntL + e2, 1, __ATOMIC_RELAXED, __HIP_MEMORY_SCOPE_WORKGROUP);
                    *(v4i*)(F.ws + WS_ROUTEA + (size_t)m * 16) = (v4i){e1, lr1, e2, lr2};
                    *(f32x2*)(F.ws + WS_ROUTEP + (size_t)m * 8) = (f32x2){p1, p2};
                } }
        }
    }
#undef PH_ISSUE
    if (moe) {
        __syncthreads();
        if (tid < 8) { const int c = cntL[tid]; const unsigned base = __hip_atomic_fetch_add((unsigned*)(F.ctl + CW_ECNT + tid), (unsigned)c, RLX_AGENT);
            ((int*)(F.ws + WS_BBASE))[(ch * 256 + bi) * 8 + tid] = (int)base; }
    }
}
__device__ __forceinline__ void phase_h(Frame& F, const Args& A_, int l, bool moe, int ch, int bi, int nb, bool first) {
    static_assert(DEPTH == 2, "layer 0 is the dense one and reads the f32 input, layer 1 the MoE one: only those two variants are instantiated");
    (void)moe;
    if (l == 0) phase_h_t<true, false>(F, A_, l, ch, bi, nb, first); else phase_h_t<false, true>(F, A_, l, ch, bi, nb, first);
}
__device__ __forceinline__ void phase_h2(Frame& F, int nb_first, int nb_last) {
    int tid_ = F.wv * 64 + lane_id(); asm volatile("" : "+v"(tid_)); const int tid = tid_;
    LAS int* offL = (LAS int*)(F.lds + MISC_OFF + 96);
    LAS int* bbL = (LAS int*)F.lds;
    for (int i = tid; i < NCH * 256 * 8; i += 512) bbL[i] = ((const int*)(F.ws + WS_BBASE))[i];
    if (tid == 0) { int off = 0;
        for (int e = 0; e < 8; ++e) { const int c = (int)__hip_atomic_load((unsigned*)(F.ctl + CW_ECNT + e), RLX_AGENT); offL[e] = off; off += ((c + 255) >> 8) << 8; } }
    __syncthreads();
    int* src = (int*)(F.ws + WS_SRC); float* rss = (float*)(F.ws + WS_RSS);
    if (blockIdx.x == F.G - 1) {
        for (int e = 0; e < 8; ++e) { const int c = (int)__hip_atomic_load((unsigned*)(F.ctl + CW_ECNT + e), RLX_AGENT), pe = ((c + 255) >> 8) << 8;
            for (int p = c + tid; p < pe; p += 512) { src[offL[e] + p] = 0; rss[offL[e] + p] = 0.f; } } }
    for (int m = (int)blockIdx.x * 512 + tid; m < T; m += F.G * 512) {
        const v4i a = *(const v4i*)(F.ws + WS_ROUTEA + (size_t)m * 16); const float rs = ((const float*)(F.ws + WS_RS))[m];
        const int ch = m / TC, r = m % TC, nb = (ch == NCH - 1) ? nb_last : nb_first, WPB = nb * NWAVES / CB, bi = ((r / SEQ) * WPB + (r % SEQ) % WPB) / NWAVES;
        const int pos1 = offL[a.x] + bbL[(ch * 256 + bi) * 8 + a.x] + a.y, pos2 = offL[a.z] + bbL[(ch * 256 + bi) * 8 + a.z] + a.w;
        *(v2i*)(F.ws + WS_ROUTEB + (size_t)m * 8) = (v2i){pos1, pos2}; rss[pos1] = rs; rss[pos2] = rs; src[pos1] = m; src[pos2] = m;
    }
    __syncthreads();
}
__device__ __forceinline__ void phase_k(Frame& F, const Args& A_, int l, bool moe, int kb) {
    int tid_ = F.wv * 64 + lane_id(); asm volatile("" : "+v"(tid_)); const int tid = tid_, lane = tid & 63, wave = __builtin_amdgcn_readfirstlane(tid >> 6), gw = kb * NWAVES + wave, NGW = F.G * NWAVES;
    const float* mod = (const float*)(F.ws + WS_MOD) + (size_t)l * 16 * 6144; signed char* hb = (signed char*)(F.ws + WS_H);
    const bf16* ys = (const bf16*)(F.ws + WS_YS);
    const float* gpost = A_.in[I_NPOF] + (size_t)l * DM;
    const int WPB = NGW / BATCH, blw = gw / WPB, wi = gw % WPB, mbase = blw * SEQ, mend = mbase + SEQ;
    if (blw >= BATCH) return;
    const float* mb = mod + (size_t)blw * 6144; const float* mb2 = mb + 16 * 6144;
    f32x4 vg2[4], vn[4], vs[4];
#pragma unroll
    for (int j = 0; j < 4; ++j) { const int k = 4 * lane + 256 * j; vg2[j] = *(const f32x4*)(mb + 5120 + k) * *(const f32x4*)(gpost + k);
        if (l + 1 < DEPTH) { vn[j] = *(const f32x4*)(A_.in[I_NPM] + (size_t)(l + 1) * DM + k) * (*(const f32x4*)(mb2 + 1024 + k) + 1.0f); vs[j] = *(const f32x4*)(mb2 + k); } else { vn[j] = vg2[j]; vs[j] = vg2[j]; } }
    v2u rya[RW][4], ryb[RW][4], rxx[RW][4]; v2i npos[RW]; f32x2 np[RW], cp[RW];
#pragma unroll
    for (int r = 0; r < RW; ++r) { npos[r] = (v2i){0, 0}; np[r] = (f32x2){0.f, 0.f}; cp[r] = np[r]; }
#define PK_POS(mm0) do { _Pragma("unroll") for (int r = 0; r < RW; ++r) { const int m = (mm0) + r * WPB < mend ? (mm0) + r * WPB : mbase + wi; \
        npos[r] = *(const v2i*)(F.ws + WS_ROUTEB + (size_t)m * 8); np[r] = *(const f32x2*)(F.ws + WS_ROUTEP + (size_t)m * 8); } } while (0)
#define PK_ROWS(mm0) do { _Pragma("unroll") for (int r = 0; r < RW; ++r) { const int m = (mm0) + r * WPB < mend ? (mm0) + r * WPB : (mm0); \
        _Pragma("unroll") for (int j = 0; j < 4; ++j) { \
            if (moe) { rya[r][j] = *(const v2u*)(ys + (size_t)npos[r].x * DM + 4 * lane + 256 * j); ryb[r][j] = *(const v2u*)(ys + (size_t)npos[r].y * DM + 4 * lane + 256 * j); } \
            else rya[r][j] = *(const v2u*)(ys + (size_t)m * DM + 4 * lane + 256 * j); \
            rxx[r][j] = *(const v2u*)((const bf16*)(F.ws + WS_XB) + (size_t)m * DM + 4 * lane + 256 * j); } cp[r] = np[r]; } } while (0)
    if (mbase + wi < mend) { if (moe) PK_POS(mbase + wi); PK_ROWS(mbase + wi); if (moe) PK_POS(mbase + wi + RW * WPB); }
    for (int m0 = mbase + wi; m0 < mend; m0 += RW * WPB) {
        f32x4 y[RW][4], x[RW][4]; float ss[RW];
#pragma unroll
        for (int r = 0; r < RW; ++r) { const f32x2 p = cp[r];
#pragma unroll
            for (int j = 0; j < 4; ++j) { const v2u a = rya[r][j], u = rxx[r][j];
                if (moe) { const v2u b = ryb[r][j]; y[r][j] = (f32x4){bflo(a.x) * p.x + bflo(b.x) * p.y, bfhi(a.x) * p.x + bfhi(b.x) * p.y, bflo(a.y) * p.x + bflo(b.y) * p.y, bfhi(a.y) * p.x + bfhi(b.y) * p.y}; }
                else y[r][j] = (f32x4){bflo(a.x), bfhi(a.x), bflo(a.y), bfhi(a.y)};
                x[r][j] = (f32x4){bflo(u.x), bfhi(u.x), bflo(u.y), bfhi(u.y)}; } }
        if (m0 + RW * WPB < mend) { PK_ROWS(m0 + RW * WPB); if (moe) PK_POS(m0 + 2 * RW * WPB); }
#pragma unroll
        for (int r = 0; r < RW; ++r) { ss[r] = 0.f;
#pragma unroll
            for (int j = 0; j < 4; ++j) ss[r] += sq4(y[r][j]); }
#pragma unroll
        for (int r = 0; r < RW; ++r) ss[r] = wave_sum(ss[r]);
#pragma unroll
        for (int r = 0; r < RW; ++r) { const int m = m0 + r * WPB; if (m < mend) {
            const float rr = rsqrtf(ss[r] * (1.0f / DM) + EPS);
#pragma unroll
            for (int j = 0; j < 4; ++j) { const int k = 4 * lane + 256 * j;
                x[r][j] = x[r][j] + vg2[j] * (y[r][j] * rr);
                if (l + 1 < DEPTH) *(v2u*)((bf16*)(F.ws + WS_XB) + (size_t)m * DM + k) = (v2u){pk2(x[r][j].x, x[r][j].y), pk2(x[r][j].z, x[r][j].w)};
                else *(f32x4*)(F.out + (size_t)m * DM + k) = x[r][j]; }
            if (l + 1 < DEPTH) norm_mod_store_reg(x[r], vn, vs, hb + (size_t)m * DM, (float*)(F.ws + WS_RS) + m, lane); } }
    }
#undef PK_POS
#undef PK_ROWS
}

typedef short v4s16 __attribute__((ext_vector_type(4)));
__device__ __forceinline__ v2u tr4(const LAS bf16* tile, int stride, int r0, int c0, int fr) {
    const LAS bf16* p = tile + (r0 + (fr >> 2)) * stride + c0 + 4 * (fr & 3);
    return __builtin_bit_cast(v2u, __builtin_amdgcn_ds_read_tr16_b64_v4i16((LAS v4s16*)p));
}
#define LDS_BARRIER() asm volatile("s_waitcnt lgkmcnt(0)\n\ts_barrier" ::: "memory")
struct AttnPre { v4u q[2], k[4], v[4]; };
struct AttnId { int bl, g, h4, dsh, r, nbk, head; };
__device__ __forceinline__ AttnId attn_decode(int uid) {
    AttnId a; a.bl = uid / 192; int rem = uid % 192; a.g = rem >> 6; rem &= 63; a.h4 = rem >> 4; const int blk = rem & 15;
    a.dsh = 2 * a.g; const int d = 1 << a.dsh; a.r = blk & (d - 1); a.nbk = blk >> a.dsh; a.head = a.g * 4 + a.h4; return a;
}
__device__ __forceinline__ void attn_load(Frame& F, int uid, int tid, AttnPre& P) {
    const AttnId a = attn_decode(uid);
    const bf16* proj = (const bf16*)(F.ws + WS_PROJ);
#pragma unroll
    for (int k = 0; k < 2; ++k) { const int it = tid + 512 * k, i = it >> 3, c = it & 7; const size_t row = (size_t)a.bl * SEQ + (((size_t)a.nbk * 128 + i) << a.dsh) + a.r;
        P.q[k] = *(const v4u*)(proj + row * PCOL + OFF_QA + a.head * 64 + c * 8); }
#pragma unroll
    for (int k = 0; k < 4; ++k) { const int it = tid + 512 * k, kj = it >> 3, c = it & 7; const int si = (a.nbk - 1) * 128 + kj;
        P.k[k] = (v4u){0u, 0u, 0u, 0u}; P.v[k] = (v4u){0u, 0u, 0u, 0u};
        if (si >= 0) { const size_t row = (size_t)a.bl * SEQ + ((size_t)si << a.dsh) + a.r; P.k[k] = *(const v4u*)(proj + row * PCOL + OFF_KA + a.head * 64 + c * 8); P.v[k] = *(const v4u*)(proj + row * PCOL + OFF_VA + a.head * 64 + c * 8); } }
}
__device__ __forceinline__ void attn_stage(Frame& F, int tid, const AttnPre& P, bool np) {
    LAS bf16* Qs = (LAS bf16*)F.lds; LAS bf16* Ks = Qs + 128 * 72; LAS bf16* Vs = Ks + 256 * 72;
#pragma unroll
    for (int k = 0; k < 2; ++k) { const int it = tid + 512 * k, i = it >> 3, c = it & 7; *(LAS v4u*)(Qs + i * 72 + c * 8) = P.q[k]; }
#pragma unroll
    for (int k = 0; k < 4; ++k) { const int it = tid + 512 * k, kj = it >> 3, c = it & 7; if (!(np && k < 2)) *(LAS v4u*)(Ks + kj * 72 + c * 8) = P.k[k]; *(LAS v4u*)(Vs + kj * 72 + c * 8) = P.v[k]; }
}
__device__ __forceinline__ void attn_compute(Frame& F, int uid, int tid) {
    const int lane = tid & 63, w = __builtin_amdgcn_readfirstlane(tid >> 6), fr = lane & 15, qq = lane >> 4;
    const AttnId a = attn_decode(uid);
    const float slope_d = exp2f(-8.0f * (float)(a.head + 1) / 12.0f) * (float)(1 << a.dsh);
    const LAS bf16* Qs = (const LAS bf16*)F.lds; const LAS bf16* Ks = Qs + 128 * 72; const LAS bf16* Vs = Ks + 256 * 72;
    bf16x8 qf[2];
#pragma unroll
    for (int ks = 0; ks < 2; ++ks) qf[ks] = *(const LAS bf16x8*)(Qs + (16 * w + fr) * 72 + 32 * ks + 8 * qq);
    const int t0 = (a.nbk == 0) ? 8 - w : 0;
    f32x4 sc[9];
#pragma unroll
    for (int tt = 0; tt < 9; ++tt) { f32x4 acc = (f32x4){0.f, 0.f, 0.f, 0.f};
        if (tt >= t0) {
#pragma unroll
            for (int ks = 0; ks < 2; ++ks) { const bf16x8 av = *(const LAS bf16x8*)(Ks + (16 * (w + tt) + fr) * 72 + 32 * ks + 8 * qq); acc = __builtin_amdgcn_mfma_f32_16x16x32_bf16(av, qf[ks], acc, 0, 0, 0); } }
        sc[tt] = acc; }
    const int iq = 16 * w + fr; float mx = -3.0e38f;
#pragma unroll
    for (int tt = 0; tt < 9; ++tt) if (tt >= t0) {
#pragma unroll
        for (int i = 0; i < 4; ++i) { const int kj = 16 * (w + tt) + 4 * qq + i; const int dist = 128 + iq - kj; const bool valid = (dist >= 0) && (dist <= 128) && (a.nbk > 0 || kj >= 128);
            const float sv = valid ? (sc[tt][i] * 0.125f - slope_d * (float)dist) : -1.0e30f; sc[tt][i] = sv; mx = fmaxf(mx, sv); } }
    mx = fmaxf(mx, __shfl_xor(mx, 16)); mx = fmaxf(mx, __shfl_xor(mx, 32));
    float sum = 0.f;
#pragma unroll
    for (int tt = 0; tt < 9; ++tt) {
        if (tt >= t0) {
#pragma unroll
            for (int i = 0; i < 4; ++i) { const float p = __expf(sc[tt][i] - mx); sc[tt][i] = p; sum += p; }
        } else sc[tt] = (f32x4){0.f, 0.f, 0.f, 0.f}; }
    sum += __shfl_xor(sum, 16); sum += __shfl_xor(sum, 32);
    const float inv = 1.0f / sum;
    f32x4 oacc[4];
#pragma unroll
    for (int dt = 0; dt < 4; ++dt) oacc[dt] = (f32x4){0.f, 0.f, 0.f, 0.f};
#pragma unroll
    for (int s = 0; s < 5; ++s) if (2 * s + 1 >= t0) {
        v4u pw; pw.x = pk2(sc[2 * s][0] * inv, sc[2 * s][1] * inv); pw.y = pk2(sc[2 * s][2] * inv, sc[2 * s][3] * inv);
        if (s < 4) { pw.z = pk2(sc[2 * s + 1][0] * inv, sc[2 * s + 1][1] * inv); pw.w = pk2(sc[2 * s + 1][2] * inv, sc[2 * s + 1][3] * inv); } else { pw.z = 0u; pw.w = 0u; }
        const bf16x8 pf = __builtin_bit_cast(bf16x8, pw);
        const int key0 = 16 * (w + 2 * s) + 4 * qq; int key1 = key0 + 16; if (key1 > 252) key1 = 252;
#pragma unroll
        for (int dt = 0; dt < 4; ++dt) { const v2u lo = tr4(Vs, 72, key0, 16 * dt, fr), hi = tr4(Vs, 72, key1, 16 * dt, fr);
            const bf16x8 av = __builtin_bit_cast(bf16x8, (v4u){lo.x, lo.y, hi.x, hi.y}); oacc[dt] = __builtin_amdgcn_mfma_f32_16x16x32_bf16(av, pf, oacc[dt], 0, 0, 0); }
    }
    const size_t lrow = (((size_t)a.nbk * 128 + iq) << a.dsh) + a.r, row = (size_t)a.bl * SEQ + lrow;
    bf16* og = (bf16*)(F.ws + WS_OG) + (size_t)a.bl * OGR_B + ((size_t)a.g * SEQ + lrow) * 256 + a.h4 * 64;
#pragma unroll
    for (int dt = 0; dt < 4; ++dt) { v2u o; o.x = pk2(oacc[dt][0], oacc[dt][1]); o.y = pk2(oacc[dt][2], oacc[dt][3]); *(v2u*)(og + 16 * dt + 4 * qq) = o; }
    if (qq == 0) ((float*)(F.ws + WS_LSE))[((size_t)a.g * TC + row) * 4 + a.h4] = mx + __logf(sum);
}

__device__ __forceinline__ void rot8(const bf16* p, const float* rope, int pos, int d0, float scl, float (&o1)[8], float (&o2)[8]) {
    const v4u a = *(const v4u*)(p + d0), b = *(const v4u*)(p + d0 + 32);
    const float t1[8] = {bflo(a.x), bfhi(a.x), bflo(a.y), bfhi(a.y), bflo(a.z), bfhi(a.z), bflo(a.w), bfhi(a.w)};
    const float t2[8] = {bflo(b.x), bfhi(b.x), bflo(b.y), bfhi(b.y), bflo(b.z), bfhi(b.z), bflo(b.w), bfhi(b.w)};
    const f32x4 c0 = *(const f32x4*)(rope + pos * 64 + d0), c1 = *(const f32x4*)(rope + pos * 64 + d0 + 4), s0 = *(const f32x4*)(rope + pos * 64 + 32 + d0), s1 = *(const f32x4*)(rope + pos * 64 + 32 + d0 + 4);
    const float cs[8] = {c0.x, c0.y, c0.z, c0.w, c1.x, c1.y, c1.z, c1.w}, sn[8] = {s0.x, s0.y, s0.z, s0.w, s1.x, s1.y, s1.z, s1.w};
#pragma unroll
    for (int j = 0; j < 8; ++j) { o1[j] = (t1[j] * cs[j] - t2[j] * sn[j]) * scl; o2[j] = (t1[j] * sn[j] + t2[j] * cs[j]) * scl; }
}

struct KvPre { v4u k1, k2, v[4]; f32x4 c0, c1, s0, s1; };
__device__ __forceinline__ void kvseq_load(Frame& F, int bl, int h, int c, int tid, KvPre& P) {
    const bf16* proj = (const bf16*)(F.ws + WS_PROJ); const float* rope = (const float*)(F.ws + WS_ROPE);
    { const int j = tid >> 2, d0 = (tid & 3) * 8; const size_t row = (size_t)bl * SEQ + c * 128 + j; const int pos = c * 128 + j;
      const bf16* kp = proj + row * PCOL + OFF_KR + h * 64;
      P.k1 = *(const v4u*)(kp + d0); P.k2 = *(const v4u*)(kp + d0 + 32);
      P.c0 = *(const f32x4*)(rope + pos * 64 + d0); P.c1 = *(const f32x4*)(rope + pos * 64 + d0 + 4); P.s0 = *(const f32x4*)(rope + pos * 64 + 32 + d0); P.s1 = *(const f32x4*)(rope + pos * 64 + 32 + d0 + 4); }
#pragma unroll
    for (int k = 0; k < 4; ++k) { const int it = tid + 512 * k, j = it >> 4, cc = it & 15; const size_t row = (size_t)bl * SEQ + c * 128 + j;
        P.v[k] = *(const v4u*)(proj + row * PCOL + OFF_VR + h * 128 + cc * 8); }
}
__device__ __forceinline__ void rot8r(const v4u a, const v4u b, const f32x4 c0, const f32x4 c1, const f32x4 s0, const f32x4 s1, float scl, v4u& o1, v4u& o2) {
    const float t1[8] = {bflo(a.x), bfhi(a.x), bflo(a.y), bfhi(a.y), bflo(a.z), bfhi(a.z), bflo(a.w), bfhi(a.w)};
    const float t2[8] = {bflo(b.x), bfhi(b.x), bflo(b.y), bfhi(b.y), bflo(b.z), bfhi(b.z), bflo(b.w), bfhi(b.w)};
    const float cs[8] = {c0.x, c0.y, c0.z, c0.w, c1.x, c1.y, c1.z, c1.w}, sn[8] = {s0.x, s0.y, s0.z, s0.w, s1.x, s1.y, s1.z, s1.w};
    float r1[8], r2[8];
#pragma unroll
    for (int j = 0; j < 8; ++j) { r1[j] = (t1[j] * cs[j] - t2[j] * sn[j]) * scl; r2[j] = (t1[j] * sn[j] + t2[j] * cs[j]) * scl; }
    o1 = (v4u){pk2(r1[0], r1[1]), pk2(r1[2], r1[3]), pk2(r1[4], r1[5]), pk2(r1[6], r1[7])};
    o2 = (v4u){pk2(r2[0], r2[1]), pk2(r2[2], r2[3]), pk2(r2[4], r2[5]), pk2(r2[6], r2[7])};
}
__device__ __forceinline__ void kvseq_unit(Frame& F, int bh) {
    int tid_ = F.wv * 64 + lane_id(); asm volatile("" : "+v"(tid_)); const int tid = tid_, lane = tid & 63, w = __builtin_amdgcn_readfirstlane(tid >> 6), fr = lane & 15, qq = lane >> 4;
    const int bl = bh >> 3, h = bh & 7;
    const float l2g = log2_gamma(h), gam = exp2f(l2g), g127 = exp2f(127.0f * l2g), g128 = exp2f(128.0f * l2g);
    constexpr int KVB = 128 * 72 + 128 * 136;
    f32x4 st[4];
#pragma unroll
    for (int mt = 0; mt < 4; ++mt) st[mt] = (f32x4){0.f, 0.f, 0.f, 0.f};
    KvPre P0, P1; kvseq_load(F, bl, h, 0, tid, P0); kvseq_load(F, bl, h, 1, tid, P1);
    const float kscl = 0.125f * exp2f(-(float)(tid >> 2) * l2g);
    bf16* rpt = (bf16*)(F.ws + WS_OG) + (size_t)bl * OGR_B + RPT_OFF + (size_t)(h * 16) * 8192 + (size_t)(16 * w + fr) * 64 + 4 * qq;
#define KVSEQ_STEP(P, c, bufi) do { LAS bf16* Ks = (LAS bf16*)F.lds + (bufi) * KVB; LAS bf16* Vs = Ks + 128 * 72; \
        { const int j = tid >> 2, d0 = (tid & 3) * 8; v4u o1, o2; rot8r(P.k1, P.k2, P.c0, P.c1, P.s0, P.s1, kscl, o1, o2); \
          *(LAS v4u*)(Ks + j * 72 + d0) = o1; *(LAS v4u*)(Ks + j * 72 + d0 + 32) = o2; } \
        _Pragma("unroll") for (int k = 0; k < 4; ++k) { const int it = tid + 512 * k, j = it >> 4, cc = it & 15; *(LAS v4u*)(Vs + j * 136 + cc * 8) = P.v[k]; } \
        _Pragma("unroll") for (int mt = 0; mt < 4; ++mt) *(v2u*)(rpt + (size_t)(c) * 8192 + 16 * mt) = (v2u){pk2(gam * st[mt][0], gam * st[mt][1]), pk2(gam * st[mt][2], gam * st[mt][3])}; \
        LDS_BARRIER(); \
        if ((c) + 2 < 16) kvseq_load(F, bl, h, (c) + 2, tid, P); \
        f32x4 acc[4]; \
        _Pragma("unroll") for (int mt = 0; mt < 4; ++mt) acc[mt] = (f32x4){0.f, 0.f, 0.f, 0.f}; \
        _Pragma("unroll") for (int ks = 0; ks < 4; ++ks) { \
            const v2u blo = tr4(Vs, 136, 32 * ks + 4 * qq, 16 * w, fr), bhi = tr4(Vs, 136, 32 * ks + 16 + 4 * qq, 16 * w, fr); \
            const bf16x8 bv = __builtin_bit_cast(bf16x8, (v4u){blo.x, blo.y, bhi.x, bhi.y}); \
            _Pragma("unroll") for (int mt = 0; mt < 4; ++mt) { \
                const v2u alo = tr4(Ks, 72, 32 * ks + 4 * qq, 16 * mt, fr), ahi = tr4(Ks, 72, 32 * ks + 16 + 4 * qq, 16 * mt, fr); \
                acc[mt] = __builtin_amdgcn_mfma_f32_16x16x32_bf16(__builtin_bit_cast(bf16x8, (v4u){alo.x, alo.y, ahi.x, ahi.y}), bv, acc[mt], 0, 0, 0); } } \
        _Pragma("unroll") for (int mt = 0; mt < 4; ++mt) st[mt] = st[mt] * g128 + acc[mt] * g127; } while (0)
    for (int c = 0; c < 16; c += 2) { KVSEQ_STEP(P0, c, 0); KVSEQ_STEP(P1, c + 1, 1); }
    LDS_BARRIER();
#undef KVSEQ_STEP
}
__device__ __forceinline__ void merge_items(Frame& F) {
    int tid_ = F.wv * 64 + lane_id(); asm volatile("" : "+v"(tid_)); const int tid = tid_;
    const bf16* og = (const bf16*)(F.ws + WS_OG) + (size_t)F.xi * OGR_B; const float* lse = (const float*)(F.ws + WS_LSE); bf16* att = (bf16*)(F.ws + WS_ATT) + (size_t)F.crow * 256;
    const int istr = F.NR_() * 512;
    for (int item0 = F.rank * 512 + tid; item0 < SEQ * 32; item0 += 4 * istr) {
        float l0[4], l1[4], l2[4]; v4u a[4], b[4], c[4];
#pragma unroll
        for (int q = 0; q < 4; ++q) { const int item = item0 + q * istr < SEQ * 32 ? item0 + q * istr : item0; const int row = F.xi * SEQ + (item >> 5), ch = item & 31, h4 = ch >> 3;
            l0[q] = lse[((size_t)0 * TC + row) * 4 + h4]; l1[q] = lse[((size_t)1 * TC + row) * 4 + h4]; l2[q] = lse[((size_t)2 * TC + row) * 4 + h4];
            const size_t lr = (size_t)(item >> 5) * 256 + ch * 8;
            a[q] = *(const v4u*)(og + lr); b[q] = *(const v4u*)(og + (size_t)SEQ * 256 + lr); c[q] = *(const v4u*)(og + (size_t)2 * SEQ * 256 + lr); }
#pragma unroll
        for (int q = 0; q < 4; ++q) { const int item = item0 + q * istr; if (item < SEQ * 32) { const int row = F.xi * SEQ + (item >> 5), ch = item & 31;
            const float mx = fmaxf(l0[q], fmaxf(l1[q], l2[q])); float w0 = __expf(l0[q] - mx), w1 = __expf(l1[q] - mx), w2 = __expf(l2[q] - mx); const float inv = 1.0f / (w0 + w1 + w2); w0 *= inv; w1 *= inv; w2 *= inv;
            v4u o;
            o.x = pk2(w0 * bflo(a[q].x) + w1 * bflo(b[q].x) + w2 * bflo(c[q].x), w0 * bfhi(a[q].x) + w1 * bfhi(b[q].x) + w2 * bfhi(c[q].x));
            o.y = pk2(w0 * bflo(a[q].y) + w1 * bflo(b[q].y) + w2 * bflo(c[q].y), w0 * bfhi(a[q].y) + w1 * bfhi(b[q].y) + w2 * bfhi(c[q].y));
            o.z = pk2(w0 * bflo(a[q].z) + w1 * bflo(b[q].z) + w2 * bflo(c[q].z), w0 * bfhi(a[q].z) + w1 * bfhi(b[q].z) + w2 * bfhi(c[q].z));
            o.w = pk2(w0 * bflo(a[q].w) + w1 * bflo(b[q].w) + w2 * bflo(c[q].w), w0 * bfhi(a[q].w) + w1 * bfhi(b[q].w) + w2 * bfhi(c[q].w));
            *(v4u*)(att + (size_t)row * 256 + ch * 8) = o; } }
    }
}
struct RetPre { v4u q1, q2, k1, k2, v[4], r[2]; f32x4 c0, c1, s0, s1; };
__device__ __forceinline__ void ret_load(Frame& F, int kid, int tid, RetPre& P) {
    const int bh = kid >> 4, c = kid & 15, bl = bh >> 3, h = bh & 7;
    const bf16* proj = (const bf16*)(F.ws + WS_PROJ); const float* rope = (const float*)(F.ws + WS_ROPE);
    { const int j = tid >> 2, d0 = (tid & 3) * 8; const size_t row = (size_t)bl * SEQ + c * 128 + j; const int pos = c * 128 + j;
      const bf16* qp = proj + row * PCOL + OFF_QR + h * 64; const bf16* kp = proj + row * PCOL + OFF_KR + h * 64;
      P.q1 = *(const v4u*)(qp + d0); P.q2 = *(const v4u*)(qp + d0 + 32); P.k1 = *(const v4u*)(kp + d0); P.k2 = *(const v4u*)(kp + d0 + 32);
      P.c0 = *(const f32x4*)(rope + pos * 64 + d0); P.c1 = *(const f32x4*)(rope + pos * 64 + d0 + 4); P.s0 = *(const f32x4*)(rope + pos * 64 + 32 + d0); P.s1 = *(const f32x4*)(rope + pos * 64 + 32 + d0 + 4); }
#pragma unroll
    for (int k = 0; k < 4; ++k) { const int it = tid + 512 * k, j = it >> 4, cc = it & 15; const size_t row = (size_t)bl * SEQ + c * 128 + j;
        P.v[k] = *(const v4u*)(proj + row * PCOL + OFF_VR + h * 128 + cc * 8); }
    { const bf16* rp = (const bf16*)(F.ws + WS_OG) + (size_t)bl * OGR_B + RPT_OFF + (size_t)(kid & 127) * 8192;
#pragma unroll
      for (int k = 0; k < 2; ++k) { const int it = tid + 512 * k, dv = it >> 3, cc = it & 7; P.r[k] = *(const v4u*)(rp + dv * 64 + cc * 8); } }
}
__device__ __forceinline__ void ret_stage(Frame& F, int kid, int tid, const RetPre& P) {
    const int h = (kid >> 4) & 7; const float l2g = log2_gamma(h);
    LAS bf16* Qs = (LAS bf16*)F.lds; LAS bf16* Ks = Qs + 128 * 72; LAS bf16* Rs = Ks + 128 * 72; LAS bf16* Vs = Rs + 128 * 72;
    { const int j = tid >> 2, d0 = (tid & 3) * 8; v4u o1, o2;
      rot8r(P.q1, P.q2, P.c0, P.c1, P.s0, P.s1, exp2f((float)j * l2g), o1, o2);
      *(LAS v4u*)(Qs + j * 72 + d0) = o1; *(LAS v4u*)(Qs + j * 72 + d0 + 32) = o2;
      rot8r(P.k1, P.k2, P.c0, P.c1, P.s0, P.s1, 0.125f * exp2f(-(float)j * l2g), o1, o2);
      *(LAS v4u*)(Ks + j * 72 + d0) = o1; *(LAS v4u*)(Ks + j * 72 + d0 + 32) = o2; }
#pragma unroll
    for (int k = 0; k < 4; ++k) { const int it = tid + 512 * k, j = it >> 4, cc = it & 15; *(LAS v4u*)(Vs + j * 136 + cc * 8) = P.v[k]; }
#pragma unroll
    for (int k = 0; k < 2; ++k) { const int it = tid + 512 * k, dv = it >> 3, cc = it & 7; *(LAS v4u*)(Rs + dv * 72 + cc * 8) = P.r[k]; }
}
constexpr int RET_GS_OFF = (128 * 72 * 3 + 128 * 136) * 2;
__device__ __forceinline__ void ret_gate_dma(Frame& F, int kid, int tid) {
    const int lane = tid & 63, w = __builtin_amdgcn_readfirstlane(tid >> 6);
    const int bh = kid >> 4, c = kid & 15, bl = bh >> 3, h = bh & 7;
    const bf16* gp = (const bf16*)(F.ws + WS_PROJ) + ((size_t)bl * SEQ + c * 128 + 16 * w) * PCOL + OFF_GR + h * 128;
    asm volatile("" ::: "memory");
#pragma unroll
    for (int k = 0; k < 4; ++k) { const int p = k * 64 + lane, r = p >> 4, cc = (p & 15) ^ r;
        __builtin_amdgcn_global_load_lds((const unsigned*)(gp + (size_t)r * PCOL + cc * 8), (LAS unsigned*)(F.lds + RET_GS_OFF + w * 4096 + k * 1024), 16, 0, 0); }
    asm volatile("" ::: "memory");
}
constexpr int RET_NLOADS = 14;
__device__ __forceinline__ void ret_compute(Frame& F, int kid, int tid, bool younger) {
    const int lane = tid & 63, w = __builtin_amdgcn_readfirstlane(tid >> 6), fr = lane & 15, qq = lane >> 4;
    const int bh = kid >> 4, c = kid & 15, bl = bh >> 3, h = bh & 7;
    const bf16* proj = (const bf16*)(F.ws + WS_PROJ);
    const LAS bf16* Qs = (const LAS bf16*)F.lds;
    const LAS bf16* Ks = Qs + 128 * 72;
    const LAS bf16* Rs = Ks + 128 * 72;
    const LAS bf16* Vs = Rs + 128 * 72;
    bf16x8 qf[2];
#pragma unroll
    for (int ks = 0; ks < 2; ++ks) qf[ks] = *(const LAS bf16x8*)(Qs + (16 * w + fr) * 72 + 32 * ks + 8 * qq);
    f32x4 oacc[8];
#pragma unroll
    for (int dt = 0; dt < 8; ++dt) oacc[dt] = (f32x4){0.f, 0.f, 0.f, 0.f};
    const int iq = 16 * w + fr;
#pragma unroll
    for (int s = 0; s < 4; ++s) {
        if (2 * s <= w) {
            f32x4 sa = (f32x4){0.f, 0.f, 0.f, 0.f}, sb = (f32x4){0.f, 0.f, 0.f, 0.f};
#pragma unroll
            for (int ks = 0; ks < 2; ++ks) { const bf16x8 av = *(const LAS bf16x8*)(Ks + (32 * s + fr) * 72 + 32 * ks + 8 * qq); sa = __builtin_amdgcn_mfma_f32_16x16x32_bf16(av, qf[ks], sa, 0, 0, 0); }
            if (2 * s + 1 <= w) {
#pragma unroll
                for (int ks = 0; ks < 2; ++ks) { const bf16x8 av = *(const LAS bf16x8*)(Ks + (32 * s + 16 + fr) * 72 + 32 * ks + 8 * qq); sb = __builtin_amdgcn_mfma_f32_16x16x32_bf16(av, qf[ks], sb, 0, 0, 0); }
            }
#pragma unroll
            for (int i = 0; i < 4; ++i) { const int ka = 32 * s + 4 * qq + i; if (ka > iq) sa[i] = 0.f; if (ka + 16 > iq) sb[i] = 0.f; }
            const bf16x8 pf = __builtin_bit_cast(bf16x8, (v4u){pk2(sa[0], sa[1]), pk2(sa[2], sa[3]), pk2(sb[0], sb[1]), pk2(sb[2], sb[3])});
#pragma unroll
            for (int dt = 0; dt < 8; ++dt) { const v2u lo = tr4(Vs, 136, 32 * s + 4 * qq, 16 * dt, fr), hi = tr4(Vs, 136, 32 * s + 16 + 4 * qq, 16 * dt, fr);
                const bf16x8 av = __builtin_bit_cast(bf16x8, (v4u){lo.x, lo.y, hi.x, hi.y}); oacc[dt] = __builtin_amdgcn_mfma_f32_16x16x32_bf16(av, pf, oacc[dt], 0, 0, 0); }
        }
    }
#pragma unroll
    for (int dt = 0; dt < 8; ++dt)
#pragma unroll
        for (int ks = 0; ks < 2; ++ks) { const bf16x8 av = *(const LAS bf16x8*)(Rs + (16 * dt + fr) * 72 + 32 * ks + 8 * qq); oacc[dt] = __builtin_amdgcn_mfma_f32_16x16x32_bf16(av, qf[ks], oacc[dt], 0, 0, 0); }
    float ss = 0.f;
#pragma unroll
    for (int dt = 0; dt < 8; ++dt) ss += sq4(oacc[dt]);
    ss += __shfl_xor(ss, 16); ss += __shfl_xor(ss, 32);
    const float rn = rsqrtf(ss * (1.0f / 128.0f) + EPS);
    const size_t row = (size_t)bl * SEQ + c * 128 + iq;
    bf16* rp = (bf16*)(F.ws + WS_RET) + (row + (size_t)F.crow) * DM + h * 128;
    if (younger) asm volatile("s_waitcnt vmcnt(%0)" :: "n"(RET_NLOADS) : "memory"); else asm volatile("s_waitcnt vmcnt(0)" ::: "memory");
    const LAS unsigned char* gs = F.lds + RET_GS_OFF + w * 4096 + fr * 256 + (qq & 1) * 8;
#pragma unroll
    for (int dt = 0; dt < 8; ++dt) { const v2u gw2 = *(const LAS v2u*)(gs + (((2 * dt + (qq >> 1)) ^ fr) << 4));
        const float g0 = bflo(gw2.x), g1 = bfhi(gw2.x), g2 = bflo(gw2.y), g3 = bfhi(gw2.y);
        v2u o; o.x = pk2(g0 * pg8::sigm(g0) * oacc[dt][0] * rn, g1 * pg8::sigm(g1) * oacc[dt][1] * rn); o.y = pk2(g2 * pg8::sigm(g2) * oacc[dt][2] * rn, g3 * pg8::sigm(g3) * oacc[dt][3] * rn);
        *(v2u*)(rp + 16 * dt + 4 * qq) = o; }
}

__device__ __forceinline__ void c2_phase(Frame& F) {
    fresh_ids(F);
    int tid_ = F.wv * 64 + lane_id(); asm volatile("" : "+v"(tid_)); const int tid = tid_;
    const int nu = (F.rank < 128) ? (128 - F.rank + F.NR_() - 1) / F.NR_() : 0, k0 = F.xi * 128 + F.rank;
    RetPre P;
    if (nu > 0) ret_load(F, k0, tid, P);
    merge_items(F);
    for (int k = 0; k < nu; ++k) {
        ret_stage(F, k0 + k * F.NR_(), tid, P);
        ret_gate_dma(F, k0 + k * F.NR_(), tid);
        LDS_BARRIER();
        if (k + 1 < nu) ret_load(F, k0 + (k + 1) * F.NR_(), tid, P);
        ret_compute(F, k0 + k * F.NR_(), tid, k + 1 < nu);
        LDS_BARRIER();
    }
}

__device__ __forceinline__ void c1_phase(Frame& F) {
    fresh_ids(F);
    int tid_ = F.wv * 64 + lane_id(); asm volatile("" : "+v"(tid_)); const int tid = tid_;
    const bool split = F.NR_() > 8;
    const int a0 = split ? F.rank - 8 : F.rank, astride = split ? F.NR_() - 8 : F.NR_();
    const int na = (split && F.rank < 8) ? 0 : (a0 < 192 ? (192 - a0 + astride - 1) / astride : 0), ab = F.xi * 192;
    for (int repa = 0; repa < REP_C1A; ++repa)
    if (na > 0) {
        AttnPre P; attn_load(F, ab + a0, tid, P);
        for (int k = 0; k < na; ++k) {
            attn_stage(F, tid, P, attn_decode(ab + a0 + k * astride).nbk == 0);
            LDS_BARRIER();
            if (k + 1 < na) attn_load(F, ab + a0 + (k + 1) * astride, tid, P);
            attn_compute(F, ab + a0 + k * astride, tid);
            LDS_BARRIER();
        }
    }
    for (int repk = 0; repk < REP_C1K; ++repk)
    if (split) { if (F.rank < 8) kvseq_unit(F, F.xi * 8 + F.rank); }
    else { for (int u = F.rank; u < 8; u += F.NR_()) kvseq_unit(F, F.xi * 8 + u); }
}

constexpr int STEPS_L0 = NCH * 5 + 1 + 2 + 1, STEPS_L1 = NCH * 5 + 1 + 1 + 2 + 1, NSTEPS = 2 + STEPS_L0 + STEPS_L1;

#ifndef NVG
#define NVG
#endif
#ifndef LBW
#define LBW 2
#endif
__global__ void __launch_bounds__(NWAVES * 64, LBW) NVG fwd(const Args args) {
    extern __shared__ __attribute__((aligned(16))) unsigned char lds_raw[];
    Frame F;
    F.lds = (LAS unsigned char*)lds_raw;
    F.G = gridDim.x; F.wv = __builtin_amdgcn_readfirstlane(threadIdx.x >> 6);
    F.ws = args.ws; F.out = args.out; F.ctl = (gu32*)(args.ws + WS_CTL);
    for (int u = threadIdx.x; u < (LDS_BYTES - LDSCTL_OFF) / 4; u += NWAVES * 64) ((LAS unsigned*)(F.lds + LDSCTL_OFF))[u] = 0u;
    __syncthreads();
    XcdBarrier bar; bar.bar = (unsigned*)(F.ctl + CW_BAR); bar.x = 0; bar.st = nullptr; bar.wv = F.wv;
    if (!MK_MULTI) bar = xcd_barrier_post((unsigned*)(F.ctl + CW_BAR), (volatile LAS unsigned*)(F.lds + MISC_OFF + 32), F.wv);
    const int lo = args.lo, hi = args.hi; int seq = 0;
    volatile LAS unsigned* misc = (volatile LAS unsigned*)(F.lds + MISC_OFF);
    const unsigned my_xcc = xb_xcc_id();
    if (!MK_MULTI && threadIdx.x == 0) misc[48] = xb_add((unsigned*)(F.ctl + CW_RANK + 64 * my_xcc), 1u);
    __syncthreads();
    const int hw_rank = __builtin_amdgcn_readfirstlane((int)misc[48]);
    F.xi = (int)(blockIdx.x & 7); F.rank = (int)(blockIdx.x >> 3);
    bool xl = false; int lgen = 0;
#define STEP_ON (seq >= lo && seq < hi)
#define FRESH_WS unsigned char* ws = args.ws; asm volatile("" : "+s"(ws))
#define STEP_END do { if (!MK_MULTI && STEP_ON && seq + 1 < hi) { for (int rb = 0; rb < REP_BAR; ++rb) xcd_barrier(bar); } ++seq; } while (0)
#define STEP_END_L do { if (!MK_MULTI && STEP_ON && seq + 1 < hi) { if (xl) xl_barrier(F.ctl, bar.bar, F.xi, F.NR_(), lgen, F.wv); else xcd_barrier(bar); } ++seq; } while (0)
    LAS unsigned char* ring = F.lds;

    const bool side = (F.G == 256);
    if (STEP_ON) {
#ifndef SKIP_PRO
        for (int rp = 0; rp < REP_PRO; ++rp) {
        adaln_phase(F, args);
        rope_phase(F);
        absmax_phase(F, args);
        convert_mixer_weights(F, args, 0);
        if (!side) convert_ffn_weights(F, args.in[I_WFG], args.in[I_WFU], args.in[I_WFD], 0, 0, FFN_ITEMS, (int)blockIdx.x * NWAVES + F.wv, F.G * NWAVES);
        __syncthreads(); }
#endif
    }
    STEP_END;
    if (!MK_MULTI && lo == 0 && hi > 1) {
        if (threadIdx.x == 0) { unsigned ok = (F.G % 8 == 0) ? 1u : 0u, idx = 0u, npop = 0u;
            for (unsigned j = 0; j < 16; ++j) { const unsigned c = xb_ld(&bar.bar[XB_XCNT(j)]); if (c) { if (c != (unsigned)F.NR_()) ok = 0u; if (j < my_xcc) ++idx; ++npop; } }
            if (npop != 8u) ok = 0u;
            misc[49] = ok; misc[50] = idx; }
        __syncthreads();
        xl = misc[49] != 0u;
        if (xl) { F.xi = __builtin_amdgcn_readfirstlane((int)misc[50]); F.rank = hw_rank; }
    }
    if (STEP_ON) { convert_win(F, args, 0); __syncthreads(); for (int rep = 0; rep < REP_A; ++rep) phase_a(F, args); }
    STEP_END;

    for (int l = 0; l < DEPTH; ++l) {
        const bool moe = (l & 1) != 0;
        for (int rmix = 0; rmix < (l == 0 ? REP_MIX : 1); ++rmix)
        for (int ch = 0; ch < NCH; ++ch) {
            F.crow = ch * TC; fresh_ids(F);
            if (STEP_ON && side && F.rank >= 8) {
                const int gwi = ((F.rank - 8) * 8 + F.xi) * NWAVES + F.wv, ngw = 192 * NWAVES;
                constexpr int FI = FFN_ITEMS;
                if (l == 0) { if (ch == 0) { convert_ffn_weights(F, args.in[I_WFG], args.in[I_WFU], args.in[I_WFD], 0, 0, FI, gwi, ngw); convert_ffn_weights(F, args.in[I_WEG], args.in[I_WEU], args.in[I_WED], 1, FI, 2 * FI, gwi, ngw); }
                              else convert_ffn_weights(F, args.in[I_WEG], args.in[I_WEU], args.in[I_WED], 1, 2 * FI, 4 * FI, gwi, ngw); }
                else { if (ch == 0) { convert_ffn_weights(F, args.in[I_WEG], args.in[I_WEU], args.in[I_WED], 1, 0, FI, gwi, ngw); convert_ffn_weights(F, args.in[I_WEG], args.in[I_WEU], args.in[I_WED], 1, 4 * FI, 4 * FI + FI * 3 / 2, gwi, ngw); }
                       else convert_ffn_weights(F, args.in[I_WEG], args.in[I_WEU], args.in[I_WED], 1, 4 * FI + FI * 3 / 2, 8 * FI, gwi, ngw); }
                __syncthreads();
            }
            if (STEP_ON) {
#ifndef SKIP_B
                FRESH_WS;
                pg8::Gemm g{(const bf16*)(ws + WS_H + (size_t)ch * TC * DM), (const bf16*)(ws + WS_WM + WM_WIN), TC, NCOL, DM / 2}; pg8::StaticOrder S; S.init(TC, NCOL, F.G, F.vb_());
                pg8::EpiI8 E{(bf16*)(ws + WS_PROJ), PCOL, (const float*)(ws + WS_RS) + (size_t)ch * TC, ((const float*)(ws + WS_WSC))[l], ws + WS_G8 + (size_t)ch * TC * GCOL, PCOL / 256};
                for (int rep = 0; rep < REP_B; ++rep) pg8::gemm_phase<pg8::EpiI8, pg8::StaticOrder, true, true, 2>(ring, F.wv, g, S, E);
#endif
            }
            STEP_END_L;
            if (STEP_ON) {
#ifndef SKIP_C1
                for (int rep = 0; rep < REP_C1; ++rep) c1_phase(F);
#endif

            }
            STEP_END_L;
#ifndef SKIP_C2
            if (STEP_ON) { for (int rep = 0; rep < REP_C2; ++rep) c2_phase(F); }
#endif

            if (ch == NCH - 1) STEP_END; else STEP_END_L;
        }
        fresh_ids(F);
        if (STEP_ON) {
#ifndef SKIP_E
            FRESH_WS;
            pg8::Gemm g{(const bf16*)(ws + WS_ATT), (const bf16*)(ws + WS_WM + WM_WA), T, DM, 256}; pg8::StaticOrder S; S.init(T, DM, F.G, F.vb_());
            pg8::EpiGate<0> E{ws + WS_G8, GCOL, (bf16*)(ws + WS_MRG), DM};
            for (int rep = 0; rep < REP_E; ++rep) pg8::gemm_phase<pg8::EpiGate<0>, pg8::StaticOrder, true, true>(ring, F.wv, g, S, E);
#endif
        }
        if (STEP_ON) {
#ifndef SKIP_F
            FRESH_WS;
            pg8::Gemm g{(const bf16*)(ws + WS_RET), (const bf16*)(ws + WS_WM + WM_WR), T, DM, DM}; pg8::StaticOrder S; S.init(T, DM, F.G, F.vb_());
            pg8::EpiGate<1> E{ws + WS_G8 + DM, GCOL, (bf16*)(ws + WS_MRG), DM};
            pg8::gemm_phase<pg8::EpiGate<1>, pg8::StaticOrder, true, true>(ring, F.wv, g, S, E);
#endif
        }
        STEP_END_L;
        fresh_ids(F);
        if (STEP_ON) {
#ifndef SKIP_G
            FRESH_WS;
            pg8::Gemm g{(const bf16*)(ws + WS_MRG), (const bf16*)(ws + WS_WM + WM_WMIX), T, DM, DM}; pg8::StaticOrder S; S.init(T, DM, F.G, F.vb_());
            pg8::EpiBf16 E{(bf16*)(ws + WS_Y), DM};
            for (int rep = 0; rep < REP_G; ++rep) pg8::gemm_phase<pg8::EpiBf16, pg8::StaticOrder, true, true>(ring, F.wv, g, S, E);
#endif
        }
        STEP_END_L;
#ifndef SKIP_H
        fresh_ids(F);
        if (STEP_ON) {
#pragma nounroll
            for (int j = 0; j < 2; ++j) { const int e = 2 * F.xi + j; phase_h(F, args, l, moe, e >> 3, (e & 7) * F.NR_() + F.rank, F.G, j == 0); __syncthreads(); }
        }
#endif
        if (moe) STEP_END; else STEP_END_L;
        if (moe) { if (STEP_ON) phase_h2(F, F.G, F.G); STEP_END; }
        const int fvb = moe ? (int)blockIdx.x : F.vb_();
        {
            LAS int* tendL = (LAS int*)(F.lds + MISC_OFF + 128);
            if (F.wv == 0 && lane_id() == 0) { int acc = 0;
                for (int e = 0; e < 8; ++e) { const int c = moe ? (int)__hip_atomic_load((unsigned*)(F.ctl + CW_ECNT + e), RLX_AGENT) : (e == 0 ? T : 0); acc += (c + 255) >> 8; tendL[e] = acc; } }
            if (F.wv == 1 && lane_id() < 8) ((LAS float*)(F.lds + MISC_OFF + 256))[lane_id()] = ((const float*)(F.ws + WS_WSCF))[lane_id()];
            __syncthreads();
            const int ttot = __builtin_amdgcn_readfirstlane(tendL[7]);
            for (int rffn = 0; rffn < (l == 0 ? REP_FFN0 : 1); ++rffn) {
            if (STEP_ON) {
#ifndef SKIP_I
                FRESH_WS;
                pg8::Gemm g{(const bf16*)(ws + WS_H), (const bf16*)(ws + WS_WF), ttot * 256, 2 * FF, DM / 2, (const int*)(ws + WS_SRC)};
                pg8::FfnOrder S; S.so.init(ttot * 256, 2 * FF, F.G, fvb); S.tend = tendL; S.estride = (unsigned)WF_E;
                pg8::EpiSwigluI8 E{ws + WS_U, FF, moe ? (const float*)(ws + WS_RSS) : (const float*)(ws + WS_RS), (const LAS float*)(F.lds + MISC_OFF + 256)};
                if (moe) pg8::gemm_phase<pg8::EpiSwigluI8, pg8::FfnOrder, true, true, 2, true>(ring, F.wv, g, S, E);
                else pg8::gemm_phase<pg8::EpiSwigluI8, pg8::FfnOrder, true, true, 2>(ring, F.wv, g, S, E);
#endif
            }
            if (moe) STEP_END; else STEP_END_L;
            if (STEP_ON) {
#ifndef SKIP_J
                FRESH_WS;
                pg8::Gemm g{(const bf16*)(ws + WS_U), (const bf16*)(ws + WS_WF + WF_GU), ttot * 256, DM, FF / 2};
                pg8::FfnOrder S; S.so.init(ttot * 256, DM, F.G, fvb); S.tend = tendL; S.estride = (unsigned)WF_E;
                pg8::EpiBf16 E{(bf16*)(ws + WS_YS), DM};
                for (int rep = 0; rep < REP_J; ++rep) pg8::gemm_phase<pg8::EpiBf16, pg8::FfnOrder, true, true, 1>(ring, F.wv, g, S, E);
#endif
            }
            if (moe) STEP_END; else STEP_END_L;
            }
        }
        if (STEP_ON) {
#ifndef SKIP_K
            phase_k(F, args, l, moe, moe ? (int)blockIdx.x : (2 * F.xi + (F.rank >> 4)) * (F.G >> 4) + (F.rank & 15));
            if (l + 1 < DEPTH) { convert_mixer_weights(F, args, l + 1); convert_win(F, args, l + 1);
                if (!side) convert_ffn_weights(F, args.in[I_WEG], args.in[I_WEU], args.in[I_WED], 1, 0, NEXP * FFN_ITEMS, (int)blockIdx.x * NWAVES + F.wv, F.G * NWAVES); }
#endif

        }
        STEP_END;
    }
#undef STEP_ON
#undef STEP_END
}

extern "C" void kernel_launch(void* const* d_in, const int* in_sizes, int n_in, void* d_out, int out_size, void* d_ws, size_t ws_size, hipStream_t stream) {
    static int grid = 0;
    if (grid == 0) {
        if (n_in != 20 || in_sizes[0] != T * DM || out_size != T * DM || ws_size < WS_END) { fprintf(stderr, "kernel_launch: unexpected shapes / workspace (%zu < %zu)\n", ws_size, (size_t)WS_END); grid = -1; return; }
        int dev = 0, cus = 0, per_cu = 0;
        if (hipGetDevice(&dev) != hipSuccess || hipDeviceGetAttribute(&cus, hipDeviceAttributeMultiprocessorCount, dev) != hipSuccess) { grid = -1; return; }
        if (hipFuncSetAttribute((const void*)fwd, hipFuncAttributeMaxDynamicSharedMemorySize, LDS_BYTES) != hipSuccess) { grid = -1; return; }
        if (hipOccupancyMaxActiveBlocksPerMultiprocessor(&per_cu, (const void*)fwd, NWAVES * 64, LDS_BYTES) != hipSuccess || per_cu < 1) { fprintf(stderr, "kernel_launch: occupancy query says %d\n", per_cu); }
        (void)hipGetLastError();
        grid = cus;
    }
    if (grid < 0) return;
    (void)hipMemsetAsync((char*)d_ws + WS_CTL, 0, CTL_ZERO_BYTES, stream);
    Args a{};
    for (int i = 0; i < 20; ++i) a.in[i] = (const float*)d_in[i];
    a.out = (float*)d_out; a.ws = (unsigned char*)d_ws;
#if MK_MULTI
    for (int s = 0; s < NSTEPS; ++s) { a.lo = s; a.hi = s + 1; hipLaunchKernelGGL(fwd, dim3(grid), dim3(NWAVES * 64), LDS_BYTES, stream, a); }
#else
    a.lo = 0; a.hi = 1 << 30;
    hipLaunchKernelGGL(fwd, dim3(grid), dim3(NWAVES * 64), LDS_BYTES, stream, a);
#endif
}
```

```cpp
#include <hip/hip_runtime.h>
#include <cstdio>
#include <cstdint>

#define REP_B 1
#define REP_C1 1
#define REP_BAR 1
#define REP_H0 1
#define REP_PRO 1
#define REP_MIX 1
#define REP_FFN0 1
#define REP_SH 1
#define REP_SC 1
#define REP_CVT 1
#define REP_A 1
#define REP_C1A 1
#define REP_C1K 1
#define REP_D 1
#define REP_C2 1
#define REP_E 1
#define REP_G 1
#define REP_I 1
#define REP_J 1
#ifndef MK_MULTI
#define MK_MULTI 0
#endif

__device__ __forceinline__ int lane_id() { int r; asm volatile("v_mbcnt_lo_u32_b32 %0, -1, 0\n\tv_mbcnt_hi_u32_b32 %0, -1, %0" : "=v"(r)); return r; }
namespace pg8 {
#define PG8_LAS __attribute__((address_space(3)))
#define PG8_GAS __attribute__((address_space(1)))
typedef unsigned short bf16_t;
typedef short bf16x8 __attribute__((ext_vector_type(8)));
typedef float f32x4 __attribute__((ext_vector_type(4)));
typedef unsigned u32x4 __attribute__((ext_vector_type(4)));
typedef int v8i32 __attribute__((ext_vector_type(8)));
typedef int v4i32 __attribute__((ext_vector_type(4)));
constexpr int BM = 256, BK = 64, HALF = 128, HTB = HALF * BK * 2, STAGE_BYTES = 8 * HTB, NXCD = 8, WGM = 8;

__host__ __device__ __forceinline__ int lds_byte(int r, int c) { const int st = (r >> 4) * 2 + (c >> 5), rr = r & 15, cc = c & 31, ob = rr * 64 + cc * 2; return st * 1024 + (ob ^ (((ob >> 9) & 1) << 5)); }
__host__ __device__ __forceinline__ void stage_rc(int b, int& R, int& C) { const int st = b / 1024, sb = b % 1024, swz = sb ^ (((sb >> 9) & 1) << 5); R = (st >> 1) * 16 + swz / 64; C = (st & 1) * 32 + (swz % 64) / 2; }
__host__ __device__ __forceinline__ int perm32(int rho) { const int n = rho >> 4, i = rho & 15; return 8 * (i >> 2) + 4 * n + (i & 3); }

struct Unit { int pm, pn; unsigned boff; int e; };
struct Gemm { const bf16_t* A; const bf16_t* Bt; int M, N, K; const int* gsrc; };

struct StaticOrder {
    int nM, nN, nwg, G, c;
    __host__ __device__ void init(int M, int N, int G_, int c_) { nM = M / BM; nN = N / BM; nwg = nM * nN; G = G_; c = c_; }
    __host__ __device__ bool next(int i, Unit& u) const {
        const int L = i * G + c; if (L >= nwg) return false;
        int wgid = L; { const int q = nwg / NXCD, r = nwg % NXCD, xcd = wgid % NXCD, off = wgid / NXCD; wgid = (xcd < r ? xcd * (q + 1) : r * (q + 1) + (xcd - r) * q) + off; }
        const int nig = WGM * nN, gid = wgid / nig, fm = gid * WGM, gsz = (nM - fm) < WGM ? (nM - fm) : WGM;
        u.pm = fm + ((wgid % nig) % gsz); u.pn = (wgid % nig) / gsz; u.boff = 0; u.e = 0; return true;
    }
};
struct FfnOrder {
    StaticOrder so; const PG8_LAS int* tend; unsigned estride;
    __device__ bool next(int i, Unit& u) const {
        if (!so.next(i, u)) return false;
        const int ta = u.pm; int e = 0;
#pragma unroll
        for (int k = 0; k < 7; ++k) e += (ta >= tend[k]) ? 1 : 0;
        u.boff = (unsigned)e * estride; u.e = e; return true;
    }
};

__device__ __forceinline__ unsigned cvt_pk_bf16(float lo, float hi) { unsigned r; asm volatile("v_cvt_pk_bf16_f32 %0, %1, %2" : "=v"(r) : "v"(lo), "v"(hi)); return r; }
__device__ __forceinline__ float bflo(unsigned w) { return __builtin_bit_cast(float, w << 16); }
__device__ __forceinline__ float bfhi(unsigned w) { return __builtin_bit_cast(float, w & 0xffff0000u); }
__device__ __forceinline__ float sigm(float x) { return __builtin_amdgcn_rcpf(1.0f + __expf(-x)); }

struct EpiBf16 {
    static constexpr bool PERM = true; static constexpr int NVM = 16;
    bf16_t* O; int ldc;
    __device__ __forceinline__ void operator()(const f32x4 (&acc)[2][2][4][2], const Unit& u, int wr, int wc, int fr, int fq) const {
        const int row0 = u.pm * BM + wr * 64 + fr; const int col0 = u.pn * BM + wc * 32 + 8 * fq;
#pragma unroll
        for (int ai = 0; ai < 2; ++ai)
#pragma unroll
            for (int m = 0; m < 4; ++m) { bf16_t* rowp = O + (size_t)(row0 + ai * HALF + m * 16) * ldc + col0;
#pragma unroll
                for (int bj = 0; bj < 2; ++bj) { const f32x4 v0 = acc[ai][bj][m][0], v1 = acc[ai][bj][m][1];
                    u32x4 w; w.x = cvt_pk_bf16(v0[0], v0[1]); w.y = cvt_pk_bf16(v0[2], v0[3]); w.z = cvt_pk_bf16(v1[0], v1[1]); w.w = cvt_pk_bf16(v1[2], v1[3]);
                    *(PG8_GAS u32x4*)(rowp + bj * HALF) = w; } }
    }
};
constexpr int SC_OFF = 131072 + 320 + 1024;
__device__ __forceinline__ void stage_row_scales(PG8_LAS unsigned char* lds, const float* rs0, int wid) {
    int ln; asm volatile("v_mbcnt_lo_u32_b32 %0, -1, 0\n\tv_mbcnt_hi_u32_b32 %0, -1, %0" : "=v"(ln));
    const float* p = rs0 + (wid >> 2) * 64 + ln; PG8_LAS unsigned char* d = lds + SC_OFF + wid * 512;
    asm volatile("" ::: "memory");
    __builtin_amdgcn_global_load_lds((const unsigned*)p, (PG8_LAS unsigned*)d, 4, 0, 0);
    __builtin_amdgcn_global_load_lds((const unsigned*)(p + HALF), (PG8_LAS unsigned*)(d + 256), 4, 0, 0);
    asm volatile("" ::: "memory");
}
__device__ __forceinline__ void load_row_scales(PG8_LAS unsigned char* lds, int wid, int fr, float ws, float (&sc)[2][4]) {
    asm volatile("" ::: "memory");
    const PG8_LAS float* sl = (const PG8_LAS float*)(lds + SC_OFF + wid * 512) + fr;
#pragma unroll
    for (int ai = 0; ai < 2; ++ai)
#pragma unroll
        for (int m = 0; m < 4; ++m) sc[ai][m] = sl[ai * 64 + m * 16] * ws;
}
struct EpiI8 {
    static constexpr bool PERM = true, HAS_STAGE = true; static constexpr int NVM = 18;
    bf16_t* O; int ldc; const float* rs; float ws; unsigned char* G8; int ntb;
    static constexpr int GC8 = 2048;
    __device__ __forceinline__ void stage(PG8_LAS unsigned char* lds, const Unit& u, int wid) const { stage_row_scales(lds, rs + u.pm * BM, wid); }
    __device__ __forceinline__ void operator()(const f32x4 (&acc)[2][2][4][2], const Unit& u, int wr, int wc, int fr, int fq, PG8_LAS unsigned char* lds, int wid) const {
        const int row0 = u.pm * BM + wr * 64 + fr;
        float scv[2][4]; load_row_scales(lds, wid, fr, ws, scv);
        if (u.pn < ntb) {
            const int col0 = u.pn * BM + wc * 32 + 8 * fq;
#pragma unroll
            for (int ai = 0; ai < 2; ++ai)
#pragma unroll
                for (int m = 0; m < 4; ++m) { const int row = row0 + ai * HALF + m * 16; const float sc = scv[ai][m]; bf16_t* rowp = O + (size_t)row * ldc + col0;
#pragma unroll
                    for (int bj = 0; bj < 2; ++bj) { const v4i32 a0 = __builtin_bit_cast(v4i32, acc[ai][bj][m][0]), a1 = __builtin_bit_cast(v4i32, acc[ai][bj][m][1]);
                        u32x4 w; w.x = cvt_pk_bf16((float)a0[0] * sc, (float)a0[1] * sc); w.y = cvt_pk_bf16((float)a0[2] * sc, (float)a0[3] * sc); w.z = cvt_pk_bf16((float)a1[0] * sc, (float)a1[1] * sc); w.w = cvt_pk_bf16((float)a1[2] * sc, (float)a1[3] * sc);
                        *(PG8_GAS u32x4*)(rowp + bj * HALF) = w; } }
        } else {
            const int col0 = (u.pn - ntb) * BM + wc * 32 + 8 * fq;
            typedef int i32x2 __attribute__((ext_vector_type(2)));
#pragma unroll
            for (int ai = 0; ai < 2; ++ai)
#pragma unroll
                for (int m = 0; m < 4; ++m) { const int row = row0 + ai * HALF + m * 16; const float sc = scv[ai][m]; unsigned char* rowp = G8 + (size_t)row * GC8 + col0;
#pragma unroll
                    for (int bj = 0; bj < 2; ++bj) { const v4i32 a0 = __builtin_bit_cast(v4i32, acc[ai][bj][m][0]), a1 = __builtin_bit_cast(v4i32, acc[ai][bj][m][1]);
                        int w0 = 0, w1 = 0;
                        w0 = __builtin_amdgcn_cvt_pk_fp8_f32((float)a0[0] * sc, (float)a0[1] * sc, w0, false); w0 = __builtin_amdgcn_cvt_pk_fp8_f32((float)a0[2] * sc, (float)a0[3] * sc, w0, true);
                        w1 = __builtin_amdgcn_cvt_pk_fp8_f32((float)a1[0] * sc, (float)a1[1] * sc, w1, false); w1 = __builtin_amdgcn_cvt_pk_fp8_f32((float)a1[2] * sc, (float)a1[3] * sc, w1, true);
                        *(PG8_GAS i32x2*)(rowp + bj * HALF) = (i32x2){w0, w1}; } }
        }
    }
};
template <int ADD> struct EpiGate {
    static constexpr bool PERM = true; static constexpr int NVM = 16;
    const unsigned char* Gt; int ldg; bf16_t* O; int ldc;
    typedef int i32x2 __attribute__((ext_vector_type(2))); typedef float f32x2v __attribute__((ext_vector_type(2)));
    __device__ __forceinline__ void one(const f32x4 v0, const f32x4 v1, const i32x2 g, const u32x4 t, bf16_t* p) const {
        const f32x2v g01 = __builtin_amdgcn_cvt_pk_f32_fp8(g.x, false), g23 = __builtin_amdgcn_cvt_pk_f32_fp8(g.x, true), g45 = __builtin_amdgcn_cvt_pk_f32_fp8(g.y, false), g67 = __builtin_amdgcn_cvt_pk_f32_fp8(g.y, true);
        float o[8];
        o[0] = sigm(g01.x) * v0[0]; o[1] = sigm(g01.y) * v0[1]; o[2] = sigm(g23.x) * v0[2]; o[3] = sigm(g23.y) * v0[3];
        o[4] = sigm(g45.x) * v1[0]; o[5] = sigm(g45.y) * v1[1]; o[6] = sigm(g67.x) * v1[2]; o[7] = sigm(g67.y) * v1[3];
        if (ADD) { o[0] += bflo(t.x); o[1] += bfhi(t.x); o[2] += bflo(t.y); o[3] += bfhi(t.y); o[4] += bflo(t.z); o[5] += bfhi(t.z); o[6] += bflo(t.w); o[7] += bfhi(t.w); }
        u32x4 w; w.x = cvt_pk_bf16(o[0], o[1]); w.y = cvt_pk_bf16(o[2], o[3]); w.z = cvt_pk_bf16(o[4], o[5]); w.w = cvt_pk_bf16(o[6], o[7]);
        *(PG8_GAS u32x4*)p = w;
    }
    __device__ __forceinline__ void operator()(const f32x4 (&acc)[2][2][4][2], const Unit& u, int wr, int wc, int fr, int fq) const {
        const int row0 = u.pm * BM + wr * 64 + fr; const int col0 = u.pn * BM + wc * 32 + 8 * fq;
        i32x2 gt[2][4][2]; u32x4 t0[4][2], t1[4][2];
#pragma unroll
        for (int ai = 0; ai < 2; ++ai)
#pragma unroll
            for (int m = 0; m < 4; ++m)
#pragma unroll
                for (int bj = 0; bj < 2; ++bj) { const size_t row = (size_t)(row0 + ai * HALF + m * 16);
                    gt[ai][m][bj] = *(const PG8_GAS i32x2*)(Gt + row * ldg + col0 + bj * HALF);
                    if (ai == 0) { t0[m][bj] = (u32x4){0u, 0u, 0u, 0u}; if (ADD) t0[m][bj] = *(const PG8_GAS u32x4*)(O + row * ldc + col0 + bj * HALF); } }
#pragma unroll
        for (int m = 0; m < 4; ++m) {
#pragma unroll
            for (int bj = 0; bj < 2; ++bj) { const size_t row = (size_t)(row0 + m * 16); one(acc[0][bj][m][0], acc[0][bj][m][1], gt[0][m][bj], t0[m][bj], O + row * ldc + col0 + bj * HALF); }
#pragma unroll
            for (int bj = 0; bj < 2; ++bj) { const size_t row = (size_t)(row0 + HALF + m * 16); t1[m][bj] = (u32x4){0u, 0u, 0u, 0u}; if (ADD) t1[m][bj] = *(const PG8_GAS u32x4*)(O + row * ldc + col0 + bj * HALF); }
            __builtin_amdgcn_sched_barrier(0);
        }
#pragma unroll
        for (int m = 0; m < 4; ++m)
#pragma unroll
            for (int bj = 0; bj < 2; ++bj) { const size_t row = (size_t)(row0 + HALF + m * 16); one(acc[1][bj][m][0], acc[1][bj][m][1], gt[1][m][bj], t1[m][bj], O + row * ldc + col0 + bj * HALF); }
    }
};
struct EpiSwiglu {
    static constexpr bool PERM = true; static constexpr int NVM = 8;
    unsigned char* O; int ldc;
    __device__ __forceinline__ void operator()(const f32x4 (&acc)[2][2][4][2], const Unit& u, int wr, int wc, int fr, int fq) const {
        const int row0 = u.pm * BM + wr * 64 + fr; const int col0 = u.pn * HALF + wc * 32 + 8 * fq;
#pragma unroll
        for (int ai = 0; ai < 2; ++ai)
#pragma unroll
            for (int m = 0; m < 4; ++m) { unsigned char* rowp = O + (size_t)(row0 + ai * HALF + m * 16) * ldc + col0;
                float o[8];
#pragma unroll
                for (int n = 0; n < 2; ++n)
#pragma unroll
                    for (int k = 0; k < 4; ++k) { const float g = acc[ai][0][m][n][k], up = acc[ai][1][m][n][k]; o[n * 4 + k] = g * sigm(g) * up; }
                int w0 = 0, w1 = 0;
                w0 = __builtin_amdgcn_cvt_pk_fp8_f32(o[0], o[1], w0, false); w0 = __builtin_amdgcn_cvt_pk_fp8_f32(o[2], o[3], w0, true);
                w1 = __builtin_amdgcn_cvt_pk_fp8_f32(o[4], o[5], w1, false); w1 = __builtin_amdgcn_cvt_pk_fp8_f32(o[6], o[7], w1, true);
                typedef int i32x2 __attribute__((ext_vector_type(2)));
                *(PG8_GAS i32x2*)rowp = (i32x2){w0, w1}; }
    }
};

__device__ __forceinline__ v8i32 cat8(bf16x8 a, bf16x8 b) { return __builtin_shufflevector(__builtin_bit_cast(v4i32, a), __builtin_bit_cast(v4i32, b), 0, 1, 2, 3, 4, 5, 6, 7); }
constexpr int W8_SHIFT = 8;
constexpr int W8_SCALE = (127 - W8_SHIFT / 2) * 0x01010101, ONE_SCALE = W8_SCALE;
template <class E, class = void> struct EpiStage {
    static __device__ __forceinline__ void stage(const E&, PG8_LAS unsigned char*, const Unit&, int) {}
    template <class A> static __device__ __forceinline__ void run(const E& e, const A& acc, const Unit& u, int wr, int wc, int fr, int fq, PG8_LAS unsigned char*, int) { e(acc, u, wr, wc, fr, fq); } };
template <class E> struct EpiStage<E, decltype((void)E::HAS_STAGE)> {
    static __device__ __forceinline__ void stage(const E& e, PG8_LAS unsigned char* lds, const Unit& u, int wid) { e.stage(lds, u, wid); }
    template <class A> static __device__ __forceinline__ void run(const E& e, const A& acc, const Unit& u, int wr, int wc, int fr, int fq, PG8_LAS unsigned char* lds, int wid) { e(acc, u, wr, wc, fr, fq, lds, wid); } };
struct EpiSwigluI8 {
    static constexpr bool PERM = true, HAS_STAGE = true; static constexpr int NVM = 10;
    unsigned char* O; int ldc; const float* rs; const PG8_LAS float* wscL;
    __device__ __forceinline__ void stage(PG8_LAS unsigned char* lds, const Unit& u, int wid) const { stage_row_scales(lds, rs + u.pm * BM, wid); }
    __device__ __forceinline__ void operator()(const f32x4 (&acc)[2][2][4][2], const Unit& u, int wr, int wc, int fr, int fq, PG8_LAS unsigned char* lds, int wid) const {
        const int row0 = u.pm * BM + wr * 64 + fr; const int col0 = u.pn * HALF + wc * 32 + 8 * fq;
        float scv[2][4]; load_row_scales(lds, wid, fr, wscL[u.e], scv);
#pragma unroll
        for (int ai = 0; ai < 2; ++ai)
#pragma unroll
            for (int m = 0; m < 4; ++m) { const int row = row0 + ai * HALF + m * 16; const float sc = scv[ai][m]; unsigned char* rowp = O + (size_t)row * ldc + col0;
                typedef float f32x2v __attribute__((ext_vector_type(2))); typedef int i32x2 __attribute__((ext_vector_type(2)));
                const f32x2v sc2 = (f32x2v){sc, sc}, nl2 = (f32x2v){-1.44269504f, -1.44269504f}, one2 = (f32x2v){1.0f, 1.0f};
                f32x2v o[4];
#pragma unroll
                for (int n = 0; n < 2; ++n) { const v4i32 gi = __builtin_bit_cast(v4i32, acc[ai][0][m][n]), ui = __builtin_bit_cast(v4i32, acc[ai][1][m][n]);
#pragma unroll
                    for (int k = 0; k < 2; ++k) { const f32x2v g = (f32x2v){(float)gi[2 * k], (float)gi[2 * k + 1]} * sc2, up = (f32x2v){(float)ui[2 * k], (float)ui[2 * k + 1]} * sc2;
                        const f32x2v t = g * nl2; const f32x2v d = (f32x2v){__builtin_amdgcn_exp2f(t.x), __builtin_amdgcn_exp2f(t.y)} + one2;
                        o[n * 2 + k] = (g * (f32x2v){__builtin_amdgcn_rcpf(d.x), __builtin_amdgcn_rcpf(d.y)}) * up; } }
                int w0 = 0, w1 = 0;
                w0 = __builtin_amdgcn_cvt_pk_fp8_f32(o[0].x, o[0].y, w0, false); w0 = __builtin_amdgcn_cvt_pk_fp8_f32(o[1].x, o[1].y, w0, true);
                w1 = __builtin_amdgcn_cvt_pk_fp8_f32(o[2].x, o[2].y, w1, false); w1 = __builtin_amdgcn_cvt_pk_fp8_f32(o[3].x, o[3].y, w1, true);
                *(PG8_GAS i32x2*)rowp = (i32x2){w0, w1}; }
    }
};
constexpr int GI_OFF = SC_OFF + 4096;
template <class Epi, class Sched, bool ALIGN_EPI = false, bool SP2 = false, int MODE = 0, bool GATHER = false>
__device__ __forceinline__ void gemm_phase(PG8_LAS unsigned char* lds, const int wv, const Gemm g, const Sched& S, const Epi& E) {
    int tid_ = wv * 64 + lane_id(); asm volatile("" : "+v"(tid_));
    const int tid = tid_, wid = __builtin_amdgcn_readfirstlane(tid >> 6), lane = tid & 63, wr = wid >> 2, wc = wid & 3, fr = lane & 15, fq = lane >> 4;
    constexpr bool FP8 = (MODE == 1), I8 = (MODE == 2);
    int K_ = g.K; asm volatile("" : "+s"(K_)); const int K = K_, nt = K / BK;
    unsigned voffA, voffB;
    { int R, C; stage_rc(tid * 16, R, C); const int Rb = Epi::PERM ? ((R & ~31) + perm32(R & 31)) : R;
        voffA = (unsigned)(R * K + C) * 2u; voffB = (unsigned)(Rb * K + C) * 2u; }
    int gR_, gC_; stage_rc(tid * 16, gR_, gC_); const int gR = gR_; const unsigned gcol = (unsigned)gC_ * 2u, growb = (unsigned)K * 2u;
    unsigned gA0 = 0u, gA1 = 0u, gA2 = 0u, gA3 = 0u;
    const unsigned pstep = 64u * (unsigned)K * 2u;
    const unsigned kstep = (unsigned)(BK * 2);
    const unsigned hstep = (unsigned)HALF * (unsigned)K * 2u;
    const unsigned tstep = 2u * hstep;
    const unsigned ldsw = (unsigned)wid * 1024u;
    const char* const Ab = (const char*)g.A; const char* const Bb = (const char*)g.Bt;
    const int aoff = lds_byte(wr * 64 + fr, fq * 8), boff = lds_byte(wc * 32 + fr, fq * 8);
#define PG8_SA(b, h) (((b) * 2 + (h)) * HTB)
#define PG8_SB(b, h) ((4 + (b) * 2 + (h)) * HTB)
#define PG8_STAGE(bufoff, gbase, uoff, voff) do { _Pragma("unroll") for (int _i = 0; _i < 2; ++_i) \
        __builtin_amdgcn_global_load_lds((const unsigned*)((gbase) + (size_t)(unsigned)(((uoff) + _i * pstep) + (voff))), (PG8_LAS unsigned*)(lds + (bufoff) + ldsw + _i * 8192), 16, 0, 0); } while (0)
#define PG8_STA(bufoff, uoff, h) do { if constexpr (GATHER) { \
        __builtin_amdgcn_global_load_lds((const unsigned*)(Ab + (size_t)(unsigned)((uoff) + ((h) ? gA2 : gA0))), (PG8_LAS unsigned*)(lds + (bufoff) + ldsw), 16, 0, 0); \
        __builtin_amdgcn_global_load_lds((const unsigned*)(Ab + (size_t)(unsigned)((uoff) + ((h) ? gA3 : gA1))), (PG8_LAS unsigned*)(lds + (bufoff) + ldsw + 8192), 16, 0, 0); \
    } else PG8_STAGE(bufoff, Ab, (uoff) + ((h) ? hstep : 0u), voffA); } while (0)
#define PG8_LDA(dst, b, h) do { _Pragma("unroll") for (int m = 0; m < 4; ++m) { if constexpr (FP8) { dst##8[m] = __builtin_shufflevector(*(const PG8_LAS v4i32*)(lds + PG8_SA(b, h) + aoff + m * 2048), *(const PG8_LAS v4i32*)(lds + PG8_SA(b, h) + aoff + m * 2048 + 1024), 0, 1, 2, 3, 4, 5, 6, 7); } else { \
        _Pragma("unroll") for (int k = 0; k < 2; ++k) dst[m][k] = *(const PG8_LAS bf16x8*)(lds + PG8_SA(b, h) + aoff + m * 2048 + k * 1024); } } } while (0)
#define PG8_LDB(dst, b, h) do { _Pragma("unroll") for (int n = 0; n < 2; ++n) { if constexpr (FP8) { dst##8[n] = __builtin_shufflevector(*(const PG8_LAS v4i32*)(lds + PG8_SB(b, h) + boff + n * 2048), *(const PG8_LAS v4i32*)(lds + PG8_SB(b, h) + boff + n * 2048 + 1024), 0, 1, 2, 3, 4, 5, 6, 7); } else { \
        _Pragma("unroll") for (int k = 0; k < 2; ++k) dst[n][k] = *(const PG8_LAS bf16x8*)(lds + PG8_SB(b, h) + boff + n * 2048 + k * 1024); } } } while (0)
#define PG8_MMA(ai, bj, At, Bt) do { __builtin_amdgcn_s_setprio(1); if constexpr (FP8) { _Pragma("unroll") for (int m = 0; m < 4; ++m) _Pragma("unroll") for (int n = 0; n < 2; ++n) \
        asm volatile("v_mfma_scale_f32_16x16x128_f8f6f4 %0, %1, %2, %0, %3, %3 op_sel_hi:[0,0,0]" : "+v"(acc[ai][bj][m][n]) : "v"(Bt##8[n]), "v"(At##8[m]), "v"(scl8)); } else { \
        _Pragma("unroll") for (int m = 0; m < 4; ++m) _Pragma("unroll") for (int n = 0; n < 2; ++n) _Pragma("unroll") for (int k = 0; k < 2; ++k) { if constexpr (I8) \
        acc[ai][bj][m][n] = __builtin_bit_cast(f32x4, __builtin_amdgcn_mfma_i32_16x16x64_i8(__builtin_bit_cast(v4i32, Bt[n][k]), __builtin_bit_cast(v4i32, At[m][k]), __builtin_bit_cast(v4i32, acc[ai][bj][m][n]), 0, 0, 0)); else \
        acc[ai][bj][m][n] = __builtin_amdgcn_mfma_f32_16x16x32_bf16(Bt[n][k], At[m][k], acc[ai][bj][m][n], 0, 0, 0); } } __builtin_amdgcn_s_setprio(0); } while (0)
#define PG8_WAIT_V(n) asm volatile("s_waitcnt vmcnt(" #n ")" ::: "memory")
#define PG8_WAIT_L(n) asm volatile("s_waitcnt lgkmcnt(" #n ")" ::: "memory")
#define PG8_WAIT_VR(rlx) asm volatile("s_cmp_lg_u32 %0, 0\n\ts_cbranch_scc1 1f\n\ts_waitcnt vmcnt(8)\n1:\n\ts_waitcnt vmcnt(%1)" :: "s"(rlx), "n"(8 + Epi::NVM) : "scc", "memory")
#define PG8_BAR __builtin_amdgcn_s_barrier()
#define PG8_SCHED __builtin_amdgcn_sched_barrier(0)
    Unit cur, nxt; int ui = 0;
    if (!S.next(0, cur)) return;
    EpiStage<Epi>::stage(E, lds, cur, wid);
    f32x4 acc[2][2][4][2];
#pragma unroll
    for (int a = 0; a < 2; ++a)
#pragma unroll
        for (int b = 0; b < 2; ++b)
#pragma unroll
            for (int m = 0; m < 4; ++m)
#pragma unroll
                for (int n = 0; n < 2; ++n) acc[a][b][m][n] = (f32x4){0.f, 0.f, 0.f, 0.f};
    int scl8 = W8_SCALE; asm volatile("" : "+v"(scl8));
    bf16x8 At[4][2], B0[2][2], B1[2][2]; v8i32 At8[4], B08[2], B18[2];
    unsigned cA = GATHER ? 0u : (unsigned)cur.pm * tstep, cB = (unsigned)cur.pn * tstep + cur.boff;
    if constexpr (GATHER) { const int* gp = g.gsrc + cur.pm * BM + gR;
        gA0 = (unsigned)gp[0] * growb + gcol; gA1 = (unsigned)gp[64] * growb + gcol; gA2 = (unsigned)gp[128] * growb + gcol; gA3 = (unsigned)gp[192] * growb + gcol; }
    if constexpr (SP2) {
        PG8_STAGE(PG8_SB(0, 0), Bb, cB, voffB); PG8_STAGE(PG8_SB(0, 1), Bb, cB + hstep, voffB); PG8_STA(PG8_SA(0, 0), cA, 0); PG8_STA(PG8_SA(0, 1), cA, 1);
        if (wr == 1) PG8_BAR;
        PG8_WAIT_V(2); PG8_BAR;
        PG8_STAGE(PG8_SB(1, 0), Bb, cB + kstep, voffB); PG8_STA(PG8_SA(1, 0), cA + kstep, 0); PG8_STAGE(PG8_SB(1, 1), Bb, cB + hstep + kstep, voffB);
        PG8_WAIT_V(6); PG8_BAR;
    } else {
        PG8_STAGE(PG8_SB(0, 0), Bb, cB, voffB); PG8_STA(PG8_SA(0, 0), cA, 0); PG8_STAGE(PG8_SB(0, 1), Bb, cB + hstep, voffB); PG8_STA(PG8_SA(0, 1), cA, 1);
        if (wr == 1) PG8_BAR;
        PG8_WAIT_V(4); PG8_BAR;
        PG8_STAGE(PG8_SB(1, 0), Bb, cB + kstep, voffB); PG8_STA(PG8_SA(1, 0), cA + kstep, 0); PG8_STAGE(PG8_SB(1, 1), Bb, cB + hstep + kstep, voffB);
        PG8_WAIT_V(6); PG8_BAR;
    }
    for (;;) {
        const bool has_next = S.next(ui + 1, nxt);
        const unsigned nA = GATHER ? 0u : (has_next ? (unsigned)nxt.pm * tstep : cA), nB = has_next ? (unsigned)nxt.pn * tstep + nxt.boff : cB;
        if constexpr (GATHER) { if (has_next) {
            const int* gp = g.gsrc + nxt.pm * BM + gR; PG8_LAS unsigned char* d = lds + GI_OFF + wid * 1024;
            asm volatile("" ::: "memory");
            __builtin_amdgcn_global_load_lds((const unsigned*)gp, (PG8_LAS unsigned*)d, 4, 0, 0); __builtin_amdgcn_global_load_lds((const unsigned*)(gp + 64), (PG8_LAS unsigned*)(d + 256), 4, 0, 0);
            __builtin_amdgcn_global_load_lds((const unsigned*)(gp + 128), (PG8_LAS unsigned*)(d + 512), 4, 0, 0); __builtin_amdgcn_global_load_lds((const unsigned*)(gp + 192), (PG8_LAS unsigned*)(d + 768), 4, 0, 0);
            asm volatile("" ::: "memory"); } }
        int t = 0;
        do {
            const bool last = (t == nt - 2);
            const unsigned a1 = cA + (unsigned)(t + 1) * kstep;
            const unsigned a2 = last ? nA : cA + (unsigned)(t + 2) * kstep, b2 = last ? nB : cB + (unsigned)(t + 2) * kstep;
            const unsigned a3 = a2 + kstep, b3 = b2 + kstep;
            if constexpr (SP2) {
            const int rlx = __builtin_amdgcn_readfirstlane(((t == 0) && (ui > 0)) ? 1 : 0);
            PG8_LDB(B0, 0, 0); PG8_LDB(B1, 0, 1); PG8_SCHED; PG8_LDA(At, 0, 0); PG8_STA(PG8_SA(1, 1), a1, 1);
            PG8_WAIT_VR(rlx); PG8_WAIT_L(0); PG8_BAR; PG8_MMA(0, 0, At, B0); PG8_MMA(0, 1, At, B1); PG8_BAR; PG8_SCHED;
            if constexpr (GATHER) { if (last && has_next) {
                const PG8_LAS unsigned* sl = (const PG8_LAS unsigned*)(lds + GI_OFF + wid * 1024) + lane;
                gA0 = sl[0] * growb + gcol; gA1 = sl[64] * growb + gcol; gA2 = sl[128] * growb + gcol; gA3 = sl[192] * growb + gcol; } }
            PG8_LDA(At, 0, 1); PG8_STAGE(PG8_SB(0, 0), Bb, b2, voffB); PG8_STAGE(PG8_SB(0, 1), Bb, b2 + hstep, voffB); PG8_STA(PG8_SA(0, 0), a2, 0);
            PG8_WAIT_VR(rlx); PG8_WAIT_L(0); PG8_BAR; PG8_MMA(1, 0, At, B0); PG8_MMA(1, 1, At, B1); PG8_BAR; PG8_SCHED;
            PG8_LDB(B0, 1, 0); PG8_LDB(B1, 1, 1); PG8_SCHED; PG8_LDA(At, 1, 0); PG8_STA(PG8_SA(0, 1), a2, 1);
            PG8_WAIT_V(8); PG8_WAIT_L(0); PG8_BAR; PG8_MMA(0, 0, At, B0); PG8_MMA(0, 1, At, B1); PG8_BAR; PG8_SCHED;
            PG8_LDA(At, 1, 1); PG8_STAGE(PG8_SB(1, 0), Bb, b3, voffB); PG8_STAGE(PG8_SB(1, 1), Bb, b3 + hstep, voffB); PG8_STA(PG8_SA(1, 0), a3, 0);
            PG8_WAIT_V(8); PG8_WAIT_L(0); PG8_BAR; PG8_MMA(1, 0, At, B0); PG8_MMA(1, 1, At, B1); PG8_BAR; PG8_SCHED;
            } else {
            PG8_LDB(B0, 0, 0); PG8_SCHED; PG8_LDA(At, 0, 0); PG8_STA(PG8_SA(1, 1), a1, 1);
            PG8_WAIT_L(8); PG8_BAR; PG8_WAIT_L(0); PG8_MMA(0, 0, At, B0); PG8_BAR; PG8_SCHED;
            PG8_LDB(B1, 0, 1); PG8_STAGE(PG8_SB(0, 0), Bb, b2, voffB);
            PG8_BAR; PG8_WAIT_L(0); PG8_MMA(0, 1, At, B1); PG8_BAR;
            PG8_LDA(At, 0, 1); PG8_STA(PG8_SA(0, 0), a2, 0);
            PG8_BAR; PG8_WAIT_L(0); PG8_MMA(1, 0, At, B0); PG8_BAR; PG8_SCHED;
            PG8_STAGE(PG8_SB(0, 1), Bb, b2 + hstep, voffB);
            PG8_WAIT_V(6); PG8_BAR; PG8_MMA(1, 1, At, B1); PG8_BAR;
            PG8_LDB(B0, 1, 0); PG8_SCHED; PG8_LDA(At, 1, 0); PG8_STA(PG8_SA(0, 1), a2, 1);
            PG8_WAIT_L(8); PG8_BAR; PG8_WAIT_L(0); PG8_MMA(0, 0, At, B0); PG8_BAR; PG8_SCHED;
            PG8_LDB(B1, 1, 1); PG8_STAGE(PG8_SB(1, 0), Bb, b3, voffB);
            PG8_BAR; PG8_WAIT_L(0); PG8_MMA(0, 1, At, B1); PG8_BAR;
            PG8_LDA(At, 1, 1); PG8_STA(PG8_SA(1, 0), a3, 0);
            PG8_BAR; PG8_WAIT_L(0); PG8_MMA(1, 0, At, B0); PG8_BAR; PG8_SCHED;
            PG8_STAGE(PG8_SB(1, 1), Bb, b3 + hstep, voffB);
            PG8_WAIT_V(6); PG8_BAR; PG8_MMA(1, 1, At, B1); PG8_BAR;
            }
            t += 2;
        } while (t < nt);
        if constexpr (FP8) asm volatile("s_nop 15\n\ts_nop 15" ::: "memory");
        if constexpr (ALIGN_EPI) { if (wr == 0) PG8_BAR; }
        { int l2 = lane; asm volatile("" : "+v"(l2)); EpiStage<Epi>::run(E, acc, cur, wr, wc, l2 & 15, l2 >> 4, lds, wid); }
        if (!has_next) break;
#pragma unroll
        for (int a = 0; a < 2; ++a)
#pragma unroll
            for (int b = 0; b < 2; ++b)
#pragma unroll
                for (int m = 0; m < 4; ++m)
#pragma unroll
                    for (int n = 0; n < 2; ++n) acc[a][b][m][n] = (f32x4){0.f, 0.f, 0.f, 0.f};
        cur = nxt; cA = nA; cB = nB; ++ui; EpiStage<Epi>::stage(E, lds, cur, wid);
        if constexpr (ALIGN_EPI) { if (wr == 1) PG8_BAR; }
    }
    PG8_WAIT_V(0);
    if constexpr (!ALIGN_EPI) { if (wr == 0) PG8_BAR; }
    PG8_BAR;
#undef PG8_SA
#undef PG8_SB
#undef PG8_STAGE
#undef PG8_LDA
#undef PG8_LDB
#undef PG8_MMA
#undef PG8_WAIT_V
#undef PG8_WAIT_L
#undef PG8_WAIT_VR
#undef PG8_BAR
#undef PG8_SCHED
}
}

constexpr int BATCH = 16, SEQ = 2048, DM = 1024, T = BATCH * SEQ, DEPTH = 2;
constexpr int NCOL = 7424, FF = 2816, NEXP = 8;
constexpr int OFF_QA = 0, OFF_KA = 768, OFF_VA = 1536, OFF_QR = 2304, OFF_KR = 2816, OFF_VR = 3328, OFF_GR = 4352, OFF_GA = 5376, OFF_GT = 6400;
constexpr int PCOL = 5376, GCOL = 2048;
constexpr int CB = 8, TC = CB * SEQ, NCH = BATCH / CB;
constexpr float EPS = 1e-6f;
constexpr int NWAVES = 8;

constexpr size_t MiB = 1u << 20;
constexpr size_t WS_CTL = 0, CTL_ZERO_BYTES = 1 * MiB;
constexpr size_t WS_MOD = 1 * MiB;
constexpr size_t WS_ROPE = 2 * MiB;
constexpr size_t WS_ROUTEA = 3 * MiB;
constexpr size_t WS_SRC = 3 * MiB + 512 * 1024;
constexpr size_t WS_ROUTEB = 4 * MiB;
constexpr size_t WS_ROUTEP = 4 * MiB + 512 * 1024;
constexpr size_t WS_WSCF = 5 * MiB + 160 * 1024;
constexpr size_t WS_RSS = 5 * MiB + 512 * 1024;
constexpr size_t WS_WSC = 5 * MiB + 128 * 1024;
constexpr size_t WS_RS = 5 * MiB + 256 * 1024;
constexpr size_t WS_BBASE = 5 * MiB;
constexpr size_t WS_WM = 6 * MiB;
constexpr size_t WM_WIN = 0, WM_WA = (size_t)NCOL * DM, WM_WR = WM_WA + (size_t)DM * 256 * 2, WM_WMIX = WM_WR + (size_t)DM * DM * 2, WM_END = WM_WMIX + (size_t)DM * DM * 2;
static_assert(WM_END <= 12 * MiB, "mixer weights");
constexpr size_t WS_WF = 18 * MiB;
constexpr size_t WF_GU = (size_t)2 * FF * DM, WF_D = (size_t)DM * FF, WF_E = WF_GU + WF_D;
static_assert(NEXP * WF_E <= 66 * MiB, "ffn weights");
constexpr size_t WS_H = 84 * MiB;
constexpr size_t WS_BIG = 116 * MiB;
constexpr size_t WS_XB = WS_BIG;
constexpr size_t WS_Y = WS_BIG + 64 * MiB;
constexpr size_t WS_RET = WS_Y;
constexpr size_t WS_PROJ = WS_BIG + 128 * MiB;
constexpr size_t WS_MRG = WS_PROJ;
constexpr size_t WS_G8 = WS_BIG + 296 * MiB;
constexpr size_t WS_OG = WS_BIG + 360 * MiB;
constexpr size_t OGR_B = 5 * MiB / 2;
constexpr size_t RPT_OFF = 3 * MiB / 2;
constexpr size_t WS_LSE = WS_BIG + 400 * MiB;
constexpr size_t WS_ATT = WS_BIG + 401 * MiB;
constexpr size_t WS_YS = WS_BIG + 64 * MiB;
constexpr size_t WS_SORT = WS_BIG + 64 * MiB;
constexpr size_t WS_U = WS_BIG + 196 * MiB;
constexpr size_t WS_END = WS_BIG + 417 * MiB;
static_assert((size_t)TC * PCOL * 2 <= 168 * MiB && (size_t)T * GCOL <= 64 * MiB && (size_t)264 * 256 * 1024 * 2 <= 132 * MiB && (size_t)264 * 256 * FF <= 182 * MiB && (size_t)3 * TC * 256 * 2 <= 24 * MiB && (size_t)CB * 8 * 16 * 8192 * 2 <= 16 * MiB && (size_t)T * DM * 2 <= 168 * MiB && (size_t)T * 256 * 2 <= 16 * MiB, "big map");

constexpr int CW_TMO = 0;
constexpr int CW_FMAX = 96;
constexpr int CW_WMAX = 80;
constexpr int CW_ECNT = 64;
constexpr int CW_RANK = 1024;
constexpr int CW_LBAR = 2048;
constexpr int CW_BAR = 4096;

constexpr int RING_BYTES = 131072;
constexpr int LDSCTL_OFF = RING_BYTES, MISC_OFF = LDSCTL_OFF + 320;
constexpr int LDS_BYTES = 147456;

#define GAS __attribute__((address_space(1)))
#define LAS __attribute__((address_space(3)))
typedef unsigned short bf16;
typedef unsigned v4u __attribute__((ext_vector_type(4)));
typedef unsigned v2u __attribute__((ext_vector_type(2)));
typedef int v4i __attribute__((ext_vector_type(4)));
typedef int v2i __attribute__((ext_vector_type(2)));
typedef float f32x4 __attribute__((ext_vector_type(4)));
typedef float f32x2 __attribute__((ext_vector_type(2)));
typedef short bf16x8 __attribute__((ext_vector_type(8)));
typedef short bf16x4 __attribute__((ext_vector_type(4)));
typedef GAS unsigned gu32;
#define RLX_AGENT __ATOMIC_RELAXED, __HIP_MEMORY_SCOPE_AGENT
#define LDS_WAIT() asm volatile("s_waitcnt lgkmcnt(0)" ::: "memory")
__device__ __forceinline__ unsigned f2bf(float f) { unsigned u = __builtin_bit_cast(unsigned, f); return (u + 0x7fffu + ((u >> 16) & 1u)) >> 16; }
__device__ __forceinline__ unsigned pk2(float lo, float hi) { return f2bf(lo) | (f2bf(hi) << 16); }
__device__ __forceinline__ float bflo(unsigned w) { return __builtin_bit_cast(float, w << 16); }
__device__ __forceinline__ float bfhi(unsigned w) { return __builtin_bit_cast(float, w & 0xffff0000u); }
__device__ __forceinline__ float bf2f(bf16 b) { return __builtin_bit_cast(float, (unsigned)b << 16); }

#define XB_TMO      128
#define XB_XCNT(j)  (256  + 64 * (j))
#define XB_XSUB(j)  (1280 + 64 * (j))
#define XB_XGEN(j)  (2304 + 64 * (j))
#define XB_TOP      3328
#define XB_TOPGEN   3392
#define XCD_BAR_WORDS 3456
#define XB_SPIN_CAP (1u << 22)

__device__ __forceinline__ unsigned xb_ld(unsigned* p)              { return __hip_atomic_load(p, __ATOMIC_RELAXED, __HIP_MEMORY_SCOPE_AGENT); }
__device__ __forceinline__ unsigned xb_add(unsigned* p, unsigned v) { return __hip_atomic_fetch_add(p, v, __ATOMIC_RELAXED, __HIP_MEMORY_SCOPE_AGENT); }
__device__ __forceinline__ unsigned xb_xcc_id() { return (unsigned)__builtin_amdgcn_s_getreg((3 << 11) | 20) & 0xFu; }
#define XB_SPIN(cond, bar) do { unsigned _sp = 0; while (cond) { __builtin_amdgcn_s_sleep(1); \
    if ((++_sp & 255u) == 0u) { if (xb_ld(&(bar)[XB_TMO])) break; if (_sp > XB_SPIN_CAP) { atomicAdd(&(bar)[XB_TMO], 1u); break; } } } } while (0)

struct XcdBarrier { unsigned* bar; unsigned x; volatile LAS unsigned* st; int wv; };

__device__ __forceinline__ XcdBarrier xcd_barrier_post(unsigned* bar, volatile LAS unsigned* st, int wv) {
    XcdBarrier b; b.bar = bar; b.x = xb_xcc_id(); b.st = st; b.wv = wv;
    if (wv == 0 && lane_id() == 0) (void)xb_add(&bar[XB_XCNT(b.x)], 1u);
    return b;
}
__device__ __forceinline__ void xcd_barrier_complete(unsigned* bar, unsigned x, unsigned& nloc, unsigned& nx) {
    const unsigned G = gridDim.x * gridDim.y * gridDim.z;
    unsigned sum, cnt, mine, sp = 0u;
    for (;;) {
        sum = 0u; cnt = 0u; mine = 0u;
#pragma unroll
        for (unsigned j = 0; j < 16; ++j) { const unsigned c = xb_ld(&bar[XB_XCNT(j)]); sum += c; cnt += (c > 0u) ? 1u : 0u; mine = (j == x) ? c : mine; }
        if (sum == G) break;
        __builtin_amdgcn_s_sleep(1);
        if ((++sp & 255u) == 0u) { if (xb_ld(&bar[XB_TMO])) break; if (sp > XB_SPIN_CAP) { atomicAdd(&bar[XB_TMO], 1u); break; } }
    }
    nloc = mine > 0u ? mine : 1u; nx = cnt > 0u ? cnt : 1u;
}
__device__ __forceinline__ void xcd_barrier(const XcdBarrier& b) {
    asm volatile("s_waitcnt vmcnt(0)" ::: "memory");
    __syncthreads();
    if (b.wv == 0 && lane_id() == 0) {
        unsigned* bar = b.bar;
        __builtin_amdgcn_s_waitcnt(0);
        unsigned nloc = b.st[0], nx = b.st[1];
        if (nloc == 0u) { xcd_barrier_complete(bar, b.x, nloc, nx); b.st[0] = nloc; b.st[1] = nx; }
        const unsigned old = xb_add(&bar[XB_XSUB(b.x)], 1u);
        const unsigned gen = old / nloc;
        if (old + 1u == (gen + 1u) * nloc) {
            __builtin_amdgcn_fence(__ATOMIC_RELEASE, "agent");
            asm volatile("s_waitcnt vmcnt(0)" ::: "memory");
            const unsigned og = xb_add(&bar[XB_TOP], 1u);
            const unsigned tg = og / nx;
            if (og + 1u == (tg + 1u) * nx) xb_add(&bar[XB_TOPGEN], 1u);
            else XB_SPIN(xb_ld(&bar[XB_TOPGEN]) == tg, bar);
            __builtin_amdgcn_fence(__ATOMIC_ACQUIRE, "agent");
            xb_add(&bar[XB_XGEN(b.x)], 1u);
            asm volatile("s_waitcnt vmcnt(0)" ::: "memory");
        } else {
            XB_SPIN(xb_ld(&bar[XB_XGEN(b.x)]) == gen, bar);
            __builtin_amdgcn_fence(__ATOMIC_ACQUIRE, "agent");
            asm volatile("s_waitcnt vmcnt(0)" ::: "memory");
        }
    }
    __syncthreads();
}

__device__ __forceinline__ void xl_barrier(gu32* ctl, unsigned* bar, int xi, int NR, int& gen, int wv) {
    asm volatile("s_waitcnt vmcnt(0)" ::: "memory");
    __syncthreads();
    if (wv == 0 && lane_id() == 0) {
        unsigned* c = (unsigned*)(ctl + CW_LBAR + 64 * xi);
        (void)xb_add(c, 1u);
        const unsigned target = (unsigned)NR * (unsigned)(gen + 1);
        XB_SPIN(xb_ld(c) < target, bar);
        __builtin_amdgcn_fence(__ATOMIC_ACQUIRE, "agent");
        asm volatile("s_waitcnt vmcnt(0)" ::: "memory");
    }
    __syncthreads();
    ++gen;
}

#define DPP_REDUCE(v, OP, IDENT) do { \
        v = OP(v, __builtin_bit_cast(float, __builtin_amdgcn_update_dpp(__builtin_bit_cast(int, v), __builtin_bit_cast(int, v), 0xB1, 0xF, 0xF, false)));    \
        v = OP(v, __builtin_bit_cast(float, __builtin_amdgcn_update_dpp(__builtin_bit_cast(int, v), __builtin_bit_cast(int, v), 0x4E, 0xF, 0xF, false)));    \
        v = OP(v, __builtin_bit_cast(float, __builtin_amdgcn_update_dpp(__builtin_bit_cast(int, v), __builtin_bit_cast(int, v), 0x141, 0xF, 0xF, false)));   \
        v = OP(v, __builtin_bit_cast(float, __builtin_amdgcn_update_dpp(__builtin_bit_cast(int, v), __builtin_bit_cast(int, v), 0x140, 0xF, 0xF, false)));   \
        v = OP(v, __builtin_bit_cast(float, __builtin_amdgcn_update_dpp(__builtin_bit_cast(int, (float)(IDENT)), __builtin_bit_cast(int, v), 0x142, 0xA, 0xF, false)));   \
        v = OP(v, __builtin_bit_cast(float, __builtin_amdgcn_update_dpp(__builtin_bit_cast(int, (float)(IDENT)), __builtin_bit_cast(int, v), 0x143, 0xC, 0xF, false)));   \
    } while (0)
__device__ __forceinline__ float dpp_add(float a, float b) { return a + b; }
__device__ __forceinline__ float wave_sum(float v) {
    DPP_REDUCE(v, dpp_add, 0.0f);
    return __builtin_bit_cast(float, __builtin_amdgcn_readlane(__builtin_bit_cast(int, v), 63));
}
__device__ __forceinline__ float wave_max_nonneg(float v) {
    DPP_REDUCE(v, fmaxf, 0.0f);
    return __builtin_bit_cast(float, __builtin_amdgcn_readlane(__builtin_bit_cast(int, v), 63));
}
__device__ __forceinline__ float sq4(f32x4 v) { return (v.x * v.x + v.y * v.y) + (v.z * v.z + v.w * v.w); }
__device__ __forceinline__ float log2_gamma(int h) { return log2f(1.0f - exp2f(-5.0f - (float)h)); }

__device__ __forceinline__ void cvt_item(const float* W, int N, int k0, int n0, bf16* WT, int K, int drow0, LAS float* scr, int lane) {
    float wv[32];
#pragma unroll
    for (int i = 0; i < 32; ++i) { const int kk = 2 * i + (lane >> 5); wv[i] = W[(size_t)(k0 + kk) * N + n0 + (lane & 31)]; }
#pragma unroll
    for (int i = 0; i < 32; ++i) { const int kk = 2 * i + (lane >> 5); scr[kk * 33 + (lane & 31)] = wv[i]; }
    LDS_WAIT(); asm volatile("" ::: "memory");
    const int c = lane & 7;
#pragma unroll
    for (int j = 0; j < 4; ++j) { const int n = (lane >> 3) + 8 * j; const LAS float* s = scr + (8 * c) * 33 + n;
        v4u o; o.x = pk2(s[0 * 33], s[1 * 33]); o.y = pk2(s[2 * 33], s[3 * 33]); o.z = pk2(s[4 * 33], s[5 * 33]); o.w = pk2(s[6 * 33], s[7 * 33]);
        *(GAS v4u*)(WT + (size_t)(drow0 + n) * K + k0 + 8 * c) = o; }
    LDS_WAIT(); asm volatile("" ::: "memory");
}

__device__ __forceinline__ void cvt_item8(const float* W, int N, int k0, int n0, unsigned char* WT, int K, int drow0, LAS float* scr, int lane) {
    float wv[32];
#pragma unroll
    for (int i = 0; i < 32; ++i) { const int kk = 2 * i + (lane >> 5); wv[i] = W[(size_t)(k0 + kk) * N + n0 + (lane & 31)]; }
#pragma unroll
    for (int i = 0; i < 32; ++i) { const int kk = 2 * i + (lane >> 5); scr[kk * 33 + (lane & 31)] = wv[i]; }
    LDS_WAIT(); asm volatile("" ::: "memory");
    const int c = lane & 3; const float sc = (float)(1 << pg8::W8_SHIFT);
#pragma unroll
    for (int j = 0; j < 2; ++j) { const int n = (lane >> 2) + 16 * j; const LAS float* sp = scr + (16 * c) * 33 + n;
        int w[4];
#pragma unroll
        for (int q = 0; q < 4; ++q) { int t = 0; t = __builtin_amdgcn_cvt_pk_fp8_f32(sp[(4 * q + 0) * 33] * sc, sp[(4 * q + 1) * 33] * sc, t, false); t = __builtin_amdgcn_cvt_pk_fp8_f32(sp[(4 * q + 2) * 33] * sc, sp[(4 * q + 3) * 33] * sc, t, true); w[q] = t; }
        *(GAS v4i*)(WT + (size_t)(drow0 + n) * K + k0 + 16 * c) = (v4i){w[0], w[1], w[2], w[3]}; }
    LDS_WAIT(); asm volatile("" ::: "memory");
}

__device__ __forceinline__ void cvt_item_i8(const float* W, int N, int k0, int n0, signed char* WT, int K, int drow0, float q, LAS float* scr, int lane) {
    float wv[32];
#pragma unroll
    for (int i = 0; i < 32; ++i) { const int kk = 2 * i + (lane >> 5); wv[i] = W[(size_t)(k0 + kk) * N + n0 + (lane & 31)]; }
#pragma unroll
    for (int i = 0; i < 32; ++i) { const int kk = 2 * i + (lane >> 5); scr[kk * 33 + (lane & 31)] = wv[i]; }
    LDS_WAIT(); asm volatile("" ::: "memory");
    const int c = lane & 3;
#pragma unroll
    for (int j = 0; j < 2; ++j) { const int n = (lane >> 2) + 16 * j; const LAS float* sp = scr + (16 * c) * 33 + n;
        int w[4];
#pragma unroll
        for (int t = 0; t < 4; ++t) { const int a = __float2int_rn(__builtin_amdgcn_fmed3f(sp[(4 * t + 0) * 33] * q, -127.f, 127.f)), b = __float2int_rn(__builtin_amdgcn_fmed3f(sp[(4 * t + 1) * 33] * q, -127.f, 127.f)), cc = __float2int_rn(__builtin_amdgcn_fmed3f(sp[(4 * t + 2) * 33] * q, -127.f, 127.f)), d = __float2int_rn(__builtin_amdgcn_fmed3f(sp[(4 * t + 3) * 33] * q, -127.f, 127.f));
            w[t] = (int)((unsigned)(a & 255) | ((unsigned)(b & 255) << 8) | ((unsigned)(cc & 255) << 16) | ((unsigned)(d & 255) << 24)); }
        *(GAS v4i*)(WT + (size_t)(drow0 + n) * K + k0 + 16 * c) = (v4i){w[0], w[1], w[2], w[3]}; }
    LDS_WAIT(); asm volatile("" ::: "memory");
}

struct Args { const float* in[20]; float* out; unsigned char* ws; int lo, hi; };
struct Frame {
    LAS unsigned char* lds;
    gu32* ctl;
    int G, wv;
    int xi, rank;
    int crow;
    __device__ __forceinline__ int NR_() const { return G >> 3; }
    __device__ __forceinline__ int vb_() const { return rank * 8 + xi; }
    __device__ __forceinline__ int vid_() const { return xi * (G >> 3) + rank; }
    float* out; unsigned char* ws;
};
__device__ __forceinline__ void fresh_ids(Frame& F) { int a = __builtin_amdgcn_readfirstlane(F.xi), b = __builtin_amdgcn_readfirstlane(F.rank); asm volatile("" : "+s"(a), "+s"(b)); F.xi = a; F.rank = b; }
enum { I_X = 0, I_C, I_WADA, I_BADA, I_NPM, I_WIN, I_WATT, I_WRET, I_WMIX, I_NPOM, I_NPF, I_WFG, I_WFU, I_WFD, I_WROUT, I_BROUT, I_WEG, I_WEU, I_WED, I_NPOF };

__device__ __forceinline__ void convert_mixer_weights(Frame& F, const Args& A_, int l) {
    int tid_ = F.wv * 64 + lane_id(); asm volatile("" : "+v"(tid_)); const int tid = tid_, lane = tid & 63, wave = __builtin_amdgcn_readfirstlane(tid >> 6), gw = blockIdx.x * NWAVES + wave, NGW = F.G * NWAVES;
    LAS float* scr = (LAS float*)(F.lds + wave * 16384);
    bf16* wm = (bf16*)(F.ws + WS_WM);
    constexpr int I_A = (256 / 64) * (DM / 32), I_R = (DM / 64) * (DM / 32), NIT = I_A + 2 * I_R;
    for (int it = gw; it < NIT; it += NGW) {
        int r = it;
        if (r < I_A) { const int nb = DM / 32, kb = r / nb, n0 = (r % nb) * 32; cvt_item(A_.in[I_WATT] + (size_t)l * 256 * DM, DM, kb * 64, n0, (bf16*)((char*)wm + WM_WA), 256, n0, scr, lane); continue; } r -= I_A;
        if (r < I_R) { const int nb = DM / 32, kb = r / nb, n0 = (r % nb) * 32; cvt_item(A_.in[I_WRET] + (size_t)l * DM * DM, DM, kb * 64, n0, (bf16*)((char*)wm + WM_WR), DM, n0, scr, lane); continue; } r -= I_R;
        { const int nb = DM / 32, kb = r / nb, n0 = (r % nb) * 32; cvt_item(A_.in[I_WMIX] + (size_t)l * DM * DM, DM, kb * 64, n0, (bf16*)((char*)wm + WM_WMIX), DM, n0, scr, lane); }
    }
}
__device__ __forceinline__ float max4(f32x4 v) { return fmaxf(fmaxf(fabsf(v.x), fabsf(v.y)), fmaxf(fabsf(v.z), fabsf(v.w))); }
__device__ __forceinline__ void absmax_phase(Frame& F, const Args& A_) {
    int tid_ = F.wv * 64 + lane_id(); asm volatile("" : "+v"(tid_)); const int tid = tid_, lane = tid & 63; const int b = blockIdx.x;
    if (F.G >= 256) {
        { constexpr int N4 = DM * NCOL / 4, SL = (N4 + 127) / 128; const int l = b & 1, sl = (b >> 1) & 127;
          if (b < 256) { const f32x4* W = (const f32x4*)(A_.in[I_WIN] + (size_t)l * DM * NCOL); const int end = (sl + 1) * SL < N4 ? (sl + 1) * SL : N4; float mx = 0.f;
            for (int i = sl * SL + tid; i < end; i += 8 * 512) { f32x4 v[8];
#pragma unroll
                for (int u = 0; u < 8; ++u) { const int ii = i + u * 512; v[u] = W[ii < end ? ii : i]; }
#pragma unroll
                for (int u = 0; u < 8; ++u) mx = fmaxf(mx, max4(v[u])); }
            mx = wave_max_nonneg(mx);
            if (lane == 0) __hip_atomic_fetch_max((unsigned*)(F.ctl + CW_WMAX + l), __builtin_bit_cast(unsigned, mx), RLX_AGENT); } }
        { constexpr int NH = 128 * FF / 4, N4 = 2 * NH, NS = 28, SL = (N4 + NS - 1) / NS; const int t = b % 9, sl = b / 9;
          if (sl < NS) { const f32x4* Wg = (const f32x4*)(t == 0 ? A_.in[I_WFG] : A_.in[I_WEG] + (size_t)(t - 1) * DM * FF); const f32x4* Wu = (const f32x4*)(t == 0 ? A_.in[I_WFU] : A_.in[I_WEU] + (size_t)(t - 1) * DM * FF);
            const int end = (sl + 1) * SL < N4 ? (sl + 1) * SL : N4; float mx = 0.f;
            for (int i = sl * SL + tid; i < end; i += 4 * 512) { f32x4 v[4];
#pragma unroll
                for (int u = 0; u < 4; ++u) { int ii = i + u * 512; if (ii >= end) ii = i; v[u] = ii < NH ? Wg[ii] : Wu[ii - NH]; }
#pragma unroll
                for (int u = 0; u < 4; ++u) mx = fmaxf(mx, max4(v[u])); }
            mx = wave_max_nonneg(mx);
            if (lane == 0) __hip_atomic_fetch_max((unsigned*)(F.ctl + CW_FMAX + t), __builtin_bit_cast(unsigned, mx), RLX_AGENT); } }
    } else {
        for (int l = 0; l < DEPTH; ++l) { constexpr int N4 = DM * NCOL / 4; const f32x4* W = (const f32x4*)(A_.in[I_WIN] + (size_t)l * DM * NCOL); float mx = 0.f;
            for (int i = b * 512 + tid; i < N4; i += F.G * 512) mx = fmaxf(mx, max4(W[i]));
            mx = wave_max_nonneg(mx);
            if (lane == 0) __hip_atomic_fetch_max((unsigned*)(F.ctl + CW_WMAX + l), __builtin_bit_cast(unsigned, mx), RLX_AGENT); }
        for (int t = 0; t < 9; ++t) { constexpr int NH = 128 * FF / 4; const f32x4* Wg = (const f32x4*)(t == 0 ? A_.in[I_WFG] : A_.in[I_WEG] + (size_t)(t - 1) * DM * FF); const f32x4* Wu = (const f32x4*)(t == 0 ? A_.in[I_WFU] : A_.in[I_WEU] + (size_t)(t - 1) * DM * FF); float mx = 0.f;
            for (int i = b * 512 + tid; i < NH; i += F.G * 512) mx = fmaxf(mx, fmaxf(max4(Wg[i]), max4(Wu[i])));
            mx = wave_max_nonneg(mx);
            if (lane == 0) __hip_atomic_fetch_max((unsigned*)(F.ctl + CW_FMAX + t), __builtin_bit_cast(unsigned, mx), RLX_AGENT); }
    }
}
__device__ __forceinline__ void convert_win(Frame& F, const Args& A_, int l) {
    int tid_ = F.wv * 64 + lane_id(); asm volatile("" : "+v"(tid_)); const int tid = tid_, lane = tid & 63, wave = __builtin_amdgcn_readfirstlane(tid >> 6), gw = blockIdx.x * NWAVES + wave, NGW = F.G * NWAVES;
    LAS float* scr = (LAS float*)(F.lds + wave * 16384);
    const float mx = fmaxf(__builtin_bit_cast(float, __hip_atomic_load((unsigned*)(F.ctl + CW_WMAX + l), RLX_AGENT)), 1e-30f);
    const float q = 127.0f / mx;
    if (blockIdx.x == 0 && tid == 0) ((float*)(F.ws + WS_WSC))[l] = mx * (1.0f / 127.0f);
    constexpr int I_IN = (DM / 64) * (NCOL / 32);
    for (int it = gw; it < I_IN; it += NGW) { const int nb = NCOL / 32, kb = it / nb, n0 = (it % nb) * 32;
        cvt_item_i8(A_.in[I_WIN] + (size_t)l * DM * NCOL, NCOL, kb * 64, n0, (signed char*)(F.ws + WS_WM + WM_WIN), DM, n0, q, scr, lane); }
}
__device__ __forceinline__ void convert_ffn_weights(Frame& F, const float* wg, const float* wu, const float* wd, int tmax0, int it_lo, int it_hi, int gwi, int ngw) {
    int tid_ = F.wv * 64 + lane_id(); asm volatile("" : "+v"(tid_)); const int tid = tid_, lane = tid & 63, wave = __builtin_amdgcn_readfirstlane(tid >> 6);
    LAS float* scr = (LAS float*)(F.lds + wave * 16384);
    constexpr int I_G = (DM / 64) * (FF / 32), I_D = (FF / 64) * (DM / 32), PER = 2 * I_G + I_D;
    for (int it = it_lo + gwi; it < it_hi; it += ngw) {
        const int e = it / PER; int r = it % PER;
        unsigned char* wgu_t = F.ws + WS_WF + (size_t)e * WF_E; unsigned char* wd_t = wgu_t + WF_GU;
        if (r < 2 * I_G) { const int up = r >= I_G; if (up) r -= I_G; const int nb = FF / 32, kb = r / nb, n0 = (r % nb) * 32;
            const float mx = 1.25f * fmaxf(__builtin_bit_cast(float, __hip_atomic_load((unsigned*)(F.ctl + CW_FMAX + tmax0 + e), RLX_AGENT)), 1e-30f);
            if (r == 0 && !up && lane == 0) ((float*)(F.ws + WS_WSCF))[e] = mx * (1.0f / 127.0f);
            cvt_item_i8((up ? wu : wg) + (size_t)e * DM * FF, FF, kb * 64, n0, (signed char*)wgu_t, DM, (n0 >> 7) * 256 + (n0 & 127) + (up ? 128 : 0), 127.0f / mx, scr, lane); continue; }
        r -= 2 * I_G;
        { const int nb = DM / 32, kb = r / nb, n0 = (r % nb) * 32; cvt_item8(wd + (size_t)e * FF * DM, DM, kb * 64, n0, wd_t, FF, n0, scr, lane); }
    }
}
constexpr int FFN_ITEMS = 2 * (DM / 64) * (FF / 32) + (FF / 64) * (DM / 32);

__device__ __forceinline__ void adaln_phase(Frame& F, const Args& A_) {
    int tid_ = F.wv * 64 + lane_id(); asm volatile("" : "+v"(tid_)); const int tid = tid_, lane = tid & 63, wave = __builtin_amdgcn_readfirstlane(tid >> 6), gw = blockIdx.x * NWAVES + wave, NGW = F.G * NWAVES; (void)lane; (void)gw; (void)NGW; (void)tid;
    LAS float* cact = (LAS float*)F.lds;
    LAS float* part = (LAS float*)(F.lds + 65536);
    const float* c = A_.in[I_C];
    for (int i = tid; i < BATCH * DM; i += 512) { const float v = c[i]; cact[i] = v / (1.0f + __expf(-v)); }
    __syncthreads();
    float* mod = (float*)(F.ws + WS_MOD);
    for (int item = blockIdx.x; item < DEPTH * 96; item += F.G) {
        const int l = item / 96, n0 = (item % 96) * 64, n = n0 + lane;
        const float* W = A_.in[I_WADA] + (size_t)l * DM * 6 * DM;
        float acc[16];
#pragma unroll
        for (int b = 0; b < 16; ++b) acc[b] = 0.f;
        const int kb = wave * 128;
        float wn[16];
#pragma unroll
        for (int i = 0; i < 16; ++i) wn[i] = W[(size_t)(kb + i) * 6144 + n];
#pragma nounroll
        for (int k = kb; k < kb + 128; k += 16) {
            float wv[16];
#pragma unroll
            for (int i = 0; i < 16; ++i) wv[i] = wn[i];
            if (k + 16 < kb + 128) {
#pragma unroll
                for (int i = 0; i < 16; ++i) wn[i] = W[(size_t)(k + 16 + i) * 6144 + n];
            }
#pragma unroll
            for (int q = 0; q < 4; ++q)
#pragma unroll
                for (int b = 0; b < 16; ++b) { const f32x4 cv = *(const LAS f32x4*)(cact + b * DM + k + 4 * q); acc[b] += (cv.x * wv[4 * q] + cv.y * wv[4 * q + 1]) + (cv.z * wv[4 * q + 2] + cv.w * wv[4 * q + 3]); }
        }
#pragma unroll
        for (int b = 0; b < 16; ++b) part[(wave * 16 + b) * 64 + lane] = acc[b];
        __syncthreads();
        for (int o = tid; o < 1024; o += 512) { const int b = o >> 6, nn = o & 63; float s = 0.f;
#pragma unroll
            for (int w = 0; w < 8; ++w) s += part[(w * 16 + b) * 64 + nn];
            mod[((size_t)l * 16 + b) * 6144 + n0 + nn] = s + A_.in[I_BADA][(size_t)l * 6144 + n0 + nn]; }
        __syncthreads();
    }
}
__device__ __forceinline__ void rope_phase(Frame& F) {
    int tid_ = F.wv * 64 + lane_id(); asm volatile("" : "+v"(tid_)); const int tid = tid_, lane = tid & 63, wave = __builtin_amdgcn_readfirstlane(tid >> 6), gw = blockIdx.x * NWAVES + wave, NGW = F.G * NWAVES; (void)lane; (void)gw; (void)NGW; (void)tid;
    float* rope = (float*)(F.ws + WS_ROPE);
    for (int i = blockIdx.x * 512 + tid; i < SEQ * 32; i += F.G * 512) {
        const int pos = i >> 5, k = i & 31;
        const float inv = 1.0f / powf(10000.0f, (float)k / 32.0f);
        const float ang = (float)pos * inv;
        float s, c; sincosf(ang, &s, &c);
        rope[pos * 64 + k] = c; rope[pos * 64 + 32 + k] = s;
    }
}

__device__ __forceinline__ void norm_mod_store(const f32x4 (&v)[4], const float* gain, const float* sc, const float* sh, signed char* orow, float* rsp, int lane) {
    float ss = 0.f;
#pragma unroll
    for (int j = 0; j < 4; ++j) ss += sq4(v[j]);
    const float r = rsqrtf(wave_sum(ss) * (1.0f / DM) + EPS);
    f32x4 o[4]; float mx = 0.f;
#pragma unroll
    for (int j = 0; j < 4; ++j) { const int k = 4 * lane + 256 * j;
        const f32x4 g = *(const f32x4*)(gain + k), s1 = *(const f32x4*)(sc + k), s0 = *(const f32x4*)(sh + k);
        o[j] = (v[j] * r) * g * (s1 + 1.0f) + s0;
        mx = fmaxf(mx, fmaxf(fmaxf(fabsf(o[j].x), fabsf(o[j].y)), fmaxf(fabsf(o[j].z), fabsf(o[j].w)))); }
    mx = wave_max_nonneg(mx);
    mx = fmaxf(mx, 1e-20f);
    const float q = 127.0f / mx;
#pragma unroll
    for (int j = 0; j < 4; ++j) { const int k = 4 * lane + 256 * j;
        const int a = __float2int_rn(o[j].x * q), b = __float2int_rn(o[j].y * q), c = __float2int_rn(o[j].z * q), d = __float2int_rn(o[j].w * q);
        *(unsigned*)(orow + k) = (unsigned)(a & 255) | ((unsigned)(b & 255) << 8) | ((unsigned)(c & 255) << 16) | ((unsigned)(d & 255) << 24); }
    if (lane == 0) *rsp = mx * (1.0f / 127.0f);
}
__device__ __forceinline__ void norm_mod_store_reg(const f32x4 (&v)[4], const f32x4 (&vn)[4], const f32x4 (&vs)[4], signed char* orow, float* rsp, int lane) {
    float ss = 0.f;
#pragma unroll
    for (int j = 0; j < 4; ++j) ss += sq4(v[j]);
    const float r = rsqrtf(wave_sum(ss) * (1.0f / DM) + EPS);
    f32x4 o[4]; float mx = 0.f;
#pragma unroll
    for (int j = 0; j < 4; ++j) { o[j] = (v[j] * r) * vn[j] + vs[j];
        mx = fmaxf(mx, fmaxf(fmaxf(fabsf(o[j].x), fabsf(o[j].y)), fmaxf(fabsf(o[j].z), fabsf(o[j].w)))); }
    mx = wave_max_nonneg(mx);
    mx = fmaxf(mx, 1e-20f);
    const float q = 127.0f / mx;
#pragma unroll
    for (int j = 0; j < 4; ++j) { const int k = 4 * lane + 256 * j;
        const int a = __float2int_rn(o[j].x * q), b = __float2int_rn(o[j].y * q), c = __float2int_rn(o[j].z * q), d = __float2int_rn(o[j].w * q);
        *(unsigned*)(orow + k) = (unsigned)(a & 255) | ((unsigned)(b & 255) << 8) | ((unsigned)(c & 255) << 16) | ((unsigned)(d & 255) << 24); }
    if (lane == 0) *rsp = mx * (1.0f / 127.0f);
}
__device__ __forceinline__ void load_row_bf16(const bf16* row, f32x4 (&v)[4], int lane) {
#pragma unroll
    for (int j = 0; j < 4; ++j) { const v2u w = *(const v2u*)(row + 4 * lane + 256 * j); v[j] = (f32x4){bflo(w.x), bfhi(w.x), bflo(w.y), bfhi(w.y)}; }
}

constexpr int RW = 2;
__device__ __forceinline__ void phase_a(Frame& F, const Args& A_) {
    int tid_ = F.wv * 64 + lane_id(); asm volatile("" : "+v"(tid_)); const int tid = tid_, lane = tid & 63, wave = __builtin_amdgcn_readfirstlane(tid >> 6), gw = blockIdx.x * NWAVES + wave, NGW = F.G * NWAVES;
    const float* mod = (const float*)(F.ws + WS_MOD); signed char* hb = (signed char*)(F.ws + WS_H);
    const int WPB = NGW / BATCH, blw = gw / WPB, wi = gw % WPB, mbase = blw * SEQ, mend = mbase + SEQ;
    if (blw >= BATCH) return;
    const float* mb = mod + (size_t)blw * 6144;
    f32x4 vn[4], vs[4];
#pragma unroll
    for (int j = 0; j < 4; ++j) { const int k = 4 * lane + 256 * j; vn[j] = *(const f32x4*)(A_.in[I_NPM] + k) * (*(const f32x4*)(mb + 1024 + k) + 1.0f); vs[j] = *(const f32x4*)(mb + k); }
    f32x4 nx[RW][4];
#define PA_ISSUE(mm0) do { _Pragma("unroll") for (int r = 0; r < RW; ++r) { const int m = (mm0) + r * WPB < mend ? (mm0) + r * WPB : (mm0); \
        _Pragma("unroll") for (int j = 0; j < 4; ++j) nx[r][j] = *(const f32x4*)(A_.in[I_X] + (size_t)m * DM + 4 * lane + 256 * j); } } while (0)
    if (mbase + wi < mend) PA_ISSUE(mbase + wi);
    for (int m0 = mbase + wi; m0 < mend; m0 += RW * WPB) {
        f32x4 v[RW][4];
#pragma unroll
        for (int r = 0; r < RW; ++r)
#pragma unroll
            for (int j = 0; j < 4; ++j) v[r][j] = nx[r][j];
        if (m0 + RW * WPB < mend) PA_ISSUE(m0 + RW * WPB);
#pragma unroll
        for (int r = 0; r < RW; ++r) { const int m = m0 + r * WPB; if (m < mend) norm_mod_store_reg(v[r], vn, vs, hb + (size_t)m * DM, (float*)(F.ws + WS_RS) + m, lane); }
    }
#undef PA_ISSUE
}

template <bool L0, bool MOE>
__device__ __forceinline__ void phase_h_t(Frame& F, const Args& A_, int l, int ch, int bi, int nb, bool first) {
    constexpr bool moe = MOE;
    int tid_ = F.wv * 64 + lane_id(); asm volatile("" : "+v"(tid_)); const int tid = tid_, lane = tid & 63, wave = __builtin_amdgcn_readfirstlane(tid >> 6), gw = bi * NWAVES + wave, NGW = nb * NWAVES;
    const float* mod = (const float*)(F.ws + WS_MOD) + (size_t)l * 16 * 6144; unsigned char* h8 = F.ws + WS_H;
    const bf16* Y = (const bf16*)(F.ws + WS_Y);
    const float* xin = A_.in[I_X]; bf16* xb = (bf16*)(F.ws + WS_XB);
    LAS float* wr = (LAS float*)F.lds;
    LAS int* cntL = (LAS int*)(F.lds + MISC_OFF + 64);
    if (moe) {
        if (first) for (int i = tid; i < DM * NEXP; i += 512) wr[i] = A_.in[I_WROUT][i];
        if (tid < 8) cntL[tid] = 0;
        __syncthreads();
    }
    const float* gpost = A_.in[I_NPOM] + (size_t)l * DM; const float* gffn = A_.in[I_NPF] + (size_t)l * DM;
    const int WPB = NGW / CB, blw = gw / WPB, wi = gw % WPB, mbase = ch * TC + blw * SEQ, mend = mbase + SEQ;
    const float* mb = mod + (size_t)(ch * CB + blw) * 6144;
    f32x4 vg1[4], vgf[4];
#pragma unroll
    for (int j = 0; j < 4; ++j) { const int k = 4 * lane + 256 * j; vg1[j] = *(const f32x4*)(mb + 2048 + k) * *(const f32x4*)(gpost + k); vgf[j] = *(const f32x4*)(gffn + k) * (*(const f32x4*)(mb + 4096 + k) + 1.0f); }
    v2u ry[RW][4], rx[RW][4]; f32x4 rxf[RW][4];
#define PH_ISSUE(mm0) do { _Pragma("unroll") for (int r = 0; r < RW; ++r) { const int m = (mm0) + r * WPB < mend ? (mm0) + r * WPB : (mm0); \
        _Pragma("unroll") for (int j = 0; j < 4; ++j) { ry[r][j] = *(const v2u*)(Y + (size_t)m * DM + 4 * lane + 256 * j); \
            if (L0) rxf[r][j] = *(const f32x4*)(xin + (size_t)m * DM + 4 * lane + 256 * j); else rx[r][j] = *(const v2u*)(xb + (size_t)m * DM + 4 * lane + 256 * j); } } } while (0)
    constexpr bool PF = !MOE;
    if (PF && mbase + wi < mend) PH_ISSUE(mbase + wi);
    for (int m0 = mbase + wi; m0 < mend; m0 += RW * WPB) {
        const int NGWr = WPB;
        f32x4 y[RW][4], x[RW][4], h[RW][4]; float ss[RW], ss2[RW];
        f32x4 vsh[4];
#pragma unroll
        for (int j = 0; j < 4; ++j) vsh[j] = *(const f32x4*)(mb + 3072 + 4 * lane + 256 * j);
        if (!PF) PH_ISSUE(m0);
#pragma unroll
        for (int r = 0; r < RW; ++r)
#pragma unroll
            for (int j = 0; j < 4; ++j) { const v2u w = ry[r][j]; y[r][j] = (f32x4){bflo(w.x), bfhi(w.x), bflo(w.y), bfhi(w.y)};
                if (L0) x[r][j] = rxf[r][j]; else { const v2u u = rx[r][j]; x[r][j] = (f32x4){bflo(u.x), bfhi(u.x), bflo(u.y), bfhi(u.y)}; } }
        if (PF && m0 + RW * WPB < mend) PH_ISSUE(m0 + RW * WPB);
#pragma unroll
        for (int r = 0; r < RW; ++r) { ss[r] = 0.f;
#pragma unroll
            for (int j = 0; j < 4; ++j) ss[r] += sq4(y[r][j]); }
#pragma unroll
        for (int r = 0; r < RW; ++r) ss[r] = wave_sum(ss[r]);
#pragma unroll
        for (int r = 0; r < RW; ++r) { const int m = m0 + r * NGWr < mend ? m0 + r * NGWr : m0;
            const float rr = rsqrtf(ss[r] * (1.0f / DM) + EPS); ss2[r] = 0.f;
#pragma unroll
            for (int j = 0; j < 4; ++j) { const int k = 4 * lane + 256 * j;
                x[r][j] = x[r][j] + vg1[j] * (y[r][j] * rr);
                if (m0 + r * NGWr < mend) *(v2u*)(xb + (size_t)m * DM + k) = (v2u){pk2(x[r][j].x, x[r][j].y), pk2(x[r][j].z, x[r][j].w)};
                ss2[r] += sq4(x[r][j]); } }
#pragma unroll
        for (int r = 0; r < RW; ++r) ss2[r] = wave_sum(ss2[r]);
#pragma unroll
        for (int r = 0; r < RW; ++r) { const int m = m0 + r * NGWr < mend ? m0 + r * NGWr : m0;
            const float r2 = rsqrtf(ss2[r] * (1.0f / DM) + EPS); float mx = 0.f;
#pragma unroll
            for (int j = 0; j < 4; ++j) {
                h[r][j] = (x[r][j] * r2) * vgf[j] + vsh[j];
                mx = fmaxf(mx, fmaxf(fmaxf(fabsf(h[r][j].x), fabsf(h[r][j].y)), fmaxf(fabsf(h[r][j].z), fabsf(h[r][j].w)))); }
            mx = wave_max_nonneg(mx);
            mx = fmaxf(mx, 1e-20f); const float q = 127.0f / mx;
            if (m0 + r * NGWr < mend) {
#pragma unroll
                for (int j = 0; j < 4; ++j) { const int k = 4 * lane + 256 * j;
                    const int a = __float2int_rn(h[r][j].x * q), b = __float2int_rn(h[r][j].y * q), c = __float2int_rn(h[r][j].z * q), d = __float2int_rn(h[r][j].w * q);
                    *(unsigned*)(h8 + (size_t)m * DM + k) = (unsigned)(a & 255) | ((unsigned)(b & 255) << 8) | ((unsigned)(c & 255) << 16) | ((unsigned)(d & 255) << 24); }
                if (lane == 0) ((float*)(F.ws + WS_RS))[m] = mx * (1.0f / 127.0f); } }
        if (moe) {
            float lg[RW][8];
#pragma unroll
            for (int r = 0; r < RW; ++r) {
#pragma unroll
                for (int e = 0; e < 8; ++e) lg[r][e] = 0.f;
#pragma unroll
                for (int j = 0; j < 4; ++j)
#pragma unroll
                    for (int i = 0; i < 4; ++i) { const int k = 4 * lane + 256 * j + i; const f32x4 wa = *(const LAS f32x4*)(wr + k * 8), wb = *(const LAS f32x4*)(wr + k * 8 + 4); const float hv = h[r][j][i];
                        lg[r][0] += hv * wa.x; lg[r][1] += hv * wa.y; lg[r][2] += hv * wa.z; lg[r][3] += hv * wa.w; lg[r][4] += hv * wb.x; lg[r][5] += hv * wb.y; lg[r][6] += hv * wb.z; lg[r][7] += hv * wb.w; } }
#pragma unroll
            for (int e = 0; e < 8; ++e)
#pragma unroll
                for (int r = 0; r < RW; ++r) lg[r][e] = wave_sum(lg[r][e]) + A_.in[I_BROUT][e];
#pragma unroll
            for (int r = 0; r < RW; ++r) { const int m = m0 + r * NGWr;
                int e1 = 0; float v1 = lg[r][0];
#pragma unroll
                for (int e = 1; e < 8; ++e) if (lg[r][e] > v1) { v1 = lg[r][e]; e1 = e; }
                int e2 = -1; float v2 = -3.0e38f;
#pragma unroll
                for (int e = 0; e < 8; ++e) if (e != e1 && lg[r][e] > v2) { v2 = lg[r][e]; e2 = e; }
                const float p1 = 1.0f / (1.0f + __expf(v2 - v1)), p2 = 1.0f - p1;
                if (lane == 0 && m < mend) {
                    const int lr1 = __hip_atomic_fetch_add(cntL + e1, 1, __ATOMIC_RELAXED, __HIP_MEMORY_SCOPE_WORKGROUP);
                    const int lr2 = __hip_atomic_fetch_add(cntL + e2, 1, __ATOMIC_RELAXED, __HIP_MEMORY_SCOPE_WORKGROUP);
                    *(v4i*)(F.ws + WS_ROUTEA + (size_t)m * 16) = (v4i){e1, lr1, e2, lr2};
                    *(f32x2*)(F.ws + WS_ROUTEP + (size_t)m * 8) = (f32x2){p1, p2};
                } }
        }
    }
#undef PH_ISSUE
    if (moe) {
        __syncthreads();
        if (tid < 8) { const int c = cntL[tid]; const unsigned base = __hip_atomic_fetch_add((unsigned*)(F.ctl + CW_ECNT + tid), (unsigned)c, RLX_AGENT);
            ((int*)(F.ws + WS_BBASE))[(ch * 256 + bi) * 8 + tid] = (int)base; }
    }
}
__device__ __forceinline__ void phase_h(Frame& F, const Args& A_, int l, bool moe, int ch, int bi, int nb, bool first) {
    static_assert(DEPTH == 2, "layer 0 is the dense one and reads the f32 input, layer 1 the MoE one: only those two variants are instantiated");
    (void)moe;
    if (l == 0) phase_h_t<true, false>(F, A_, l, ch, bi, nb, first); else phase_h_t<false, true>(F, A_, l, ch, bi, nb, first);
}
__device__ __forceinline__ void phase_h2(Frame& F, int nb_first, int nb_last) {
    int tid_ = F.wv * 64 + lane_id(); asm volatile("" : "+v"(tid_)); const int tid = tid_;
    LAS int* offL = (LAS int*)(F.lds + MISC_OFF + 96);
    LAS int* bbL = (LAS int*)F.lds;
    for (int i = tid; i < NCH * 256 * 8; i += 512) bbL[i] = ((const int*)(F.ws + WS_BBASE))[i];
    if (tid == 0) { int off = 0;
        for (int e = 0; e < 8; ++e) { const int c = (int)__hip_atomic_load((unsigned*)(F.ctl + CW_ECNT + e), RLX_AGENT); offL[e] = off; off += ((c + 255) >> 8) << 8; } }
    __syncthreads();
    int* src = (int*)(F.ws + WS_SRC); float* rss = (float*)(F.ws + WS_RSS);
    if (blockIdx.x == F.G - 1) {
        for (int e = 0; e < 8; ++e) { const int c = (int)__hip_atomic_load((unsigned*)(F.ctl + CW_ECNT + e), RLX_AGENT), pe = ((c + 255) >> 8) << 8;
            for (int p = c + tid; p < pe; p += 512) { src[offL[e] + p] = 0; rss[offL[e] + p] = 0.f; } } }
    for (int m = (int)blockIdx.x * 512 + tid; m < T; m += F.G * 512) {
        const v4i a = *(const v4i*)(F.ws + WS_ROUTEA + (size_t)m * 16); const float rs = ((const float*)(F.ws + WS_RS))[m];
        const int ch = m / TC, r = m % TC, nb = (ch == NCH - 1) ? nb_last : nb_first, WPB = nb * NWAVES / CB, bi = ((r / SEQ) * WPB + (r % SEQ) % WPB) / NWAVES;
        const int pos1 = offL[a.x] + bbL[(ch * 256 + bi) * 8 + a.x] + a.y, pos2 = offL[a.z] + bbL[(ch * 256 + bi) * 8 + a.z] + a.w;
        *(v2i*)(F.ws + WS_ROUTEB + (size_t)m * 8) = (v2i){pos1, pos2}; rss[pos1] = rs; rss[pos2] = rs; src[pos1] = m; src[pos2] = m;
    }
    __syncthreads();
}
__device__ __forceinline__ void phase_k(Frame& F, const Args& A_, int l, bool moe, int kb) {
    int tid_ = F.wv * 64 + lane_id(); asm volatile("" : "+v"(tid_)); const int tid = tid_, lane = tid & 63, wave = __builtin_amdgcn_readfirstlane(tid >> 6), gw = kb * NWAVES + wave, NGW = F.G * NWAVES;
    const float* mod = (const float*)(F.ws + WS_MOD) + (size_t)l * 16 * 6144; signed char* hb = (signed char*)(F.ws + WS_H);
    const bf16* ys = (const bf16*)(F.ws + WS_YS);
    const float* gpost = A_.in[I_NPOF] + (size_t)l * DM;
    const int WPB = NGW / BATCH, blw = gw / WPB, wi = gw % WPB, mbase = blw * SEQ, mend = mbase + SEQ;
    if (blw >= BATCH) return;
    const float* mb = mod + (size_t)blw * 6144; const float* mb2 = mb + 16 * 6144;
    f32x4 vg2[4], vn[4], vs[4];
#pragma unroll
    for (int j = 0; j < 4; ++j) { const int k = 4 * lane + 256 * j; vg2[j] = *(const f32x4*)(mb + 5120 + k) * *(const f32x4*)(gpost + k);
        if (l + 1 < DEPTH) { vn[j] = *(const f32x4*)(A_.in[I_NPM] + (size_t)(l + 1) * DM + k) * (*(const f32x4*)(mb2 + 1024 + k) + 1.0f); vs[j] = *(const f32x4*)(mb2 + k); } else { vn[j] = vg2[j]; vs[j] = vg2[j]; } }
    v2u rya[RW][4], ryb[RW][4], rxx[RW][4]; v2i npos[RW]; f32x2 np[RW], cp[RW];
#pragma unroll
    for (int r = 0; r < RW; ++r) { npos[r] = (v2i){0, 0}; np[r] = (f32x2){0.f, 0.f}; cp[r] = np[r]; }
#define PK_POS(mm0) do { _Pragma("unroll") for (int r = 0; r < RW; ++r) { const int m = (mm0) + r * WPB < mend ? (mm0) + r * WPB : mbase + wi; \
        npos[r] = *(const v2i*)(F.ws + WS_ROUTEB + (size_t)m * 8); np[r] = *(const f32x2*)(F.ws + WS_ROUTEP + (size_t)m * 8); } } while (0)
#define PK_ROWS(mm0) do { _Pragma("unroll") for (int r = 0; r < RW; ++r) { const int m = (mm0) + r * WPB < mend ? (mm0) + r * WPB : (mm0); \
        _Pragma("unroll") for (int j = 0; j < 4; ++j) { \
            if (moe) { rya[r][j] = *(const v2u*)(ys + (size_t)npos[r].x * DM + 4 * lane + 256 * j); ryb[r][j] = *(const v2u*)(ys + (size_t)npos[r].y * DM + 4 * lane + 256 * j); } \
            else rya[r][j] = *(const v2u*)(ys + (size_t)m * DM + 4 * lane + 256 * j); \
            rxx[r][j] = *(const v2u*)((const bf16*)(F.ws + WS_XB) + (size_t)m * DM + 4 * lane + 256 * j); } cp[r] = np[r]; } } while (0)
    if (mbase + wi < mend) { if (moe) PK_POS(mbase + wi); PK_ROWS(mbase + wi); if (moe) PK_POS(mbase + wi + RW * WPB); }
    for (int m0 = mbase + wi; m0 < mend; m0 += RW * WPB) {
        f32x4 y[RW][4], x[RW][4]; float ss[RW];
#pragma unroll
        for (int r = 0; r < RW; ++r) { const f32x2 p = cp[r];
#pragma unroll
            for (int j = 0; j < 4; ++j) { const v2u a = rya[r][j], u = rxx[r][j];
                if (moe) { const v2u b = ryb[r][j]; y[r][j] = (f32x4){bflo(a.x) * p.x + bflo(b.x) * p.y, bfhi(a.x) * p.x + bfhi(b.x) * p.y, bflo(a.y) * p.x + bflo(b.y) * p.y, bfhi(a.y) * p.x + bfhi(b.y) * p.y}; }
                else y[r][j] = (f32x4){bflo(a.x), bfhi(a.x), bflo(a.y), bfhi(a.y)};
                x[r][j] = (f32x4){bflo(u.x), bfhi(u.x), bflo(u.y), bfhi(u.y)}; } }
        if (m0 + RW * WPB < mend) { PK_ROWS(m0 + RW * WPB); if (moe) PK_POS(m0 + 2 * RW * WPB); }
#pragma unroll
        for (int r = 0; r < RW; ++r) { ss[r] = 0.f;
#pragma unroll
            for (int j = 0; j < 4; ++j) ss[r] += sq4(y[r][j]); }
#pragma unroll
        for (int r = 0; r < RW; ++r) ss[r] = wave_sum(ss[r]);
#pragma unroll
        for (int r = 0; r < RW; ++r) { const int m = m0 + r * WPB; if (m < mend) {
            const float rr = rsqrtf(ss[r] * (1.0f / DM) + EPS);
#pragma unroll
            for (int j = 0; j < 4; ++j) { const int k = 4 * lane + 256 * j;
                x[r][j] = x[r][j] + vg2[j] * (y[r][j] * rr);
                if (l + 1 < DEPTH) *(v2u*)((bf16*)(F.ws + WS_XB) + (size_t)m * DM + k) = (v2u){pk2(x[r][j].x, x[r][j].y), pk2(x[r][j].z, x[r][j].w)};
                else *(f32x4*)(F.out + (size_t)m * DM + k) = x[r][j]; }
            if (l + 1 < DEPTH) norm_mod_store_reg(x[r], vn, vs, hb + (size_t)m * DM, (float*)(F.ws + WS_RS) + m, lane); } }
    }
#undef PK_POS
#undef PK_ROWS
}

typedef short v4s16 __attribute__((ext_vector_type(4)));
__device__ __forceinline__ v2u tr4(const LAS bf16* tile, int stride, int r0, int c0, int fr) {
    const LAS bf16* p = tile + (r0 + (fr >> 2)) * stride + c0 + 4 * (fr & 3);
    return __builtin_bit_cast(v2u, __builtin_amdgcn_ds_read_tr16_b64_v4i16((LAS v4s16*)p));
}
#define LDS_BARRIER() asm volatile("s_waitcnt lgkmcnt(0)\n\ts_barrier" ::: "memory")
struct AttnPre { v4u q[2], k[4], v[4]; };
struct AttnId { int bl, g, h4, dsh, r, nbk, head; };
__device__ __forceinline__ AttnId attn_decode(int uid) {
    AttnId a; a.bl = uid / 192; int rem = uid % 192; a.g = rem >> 6; rem &= 63; a.h4 = rem >> 4; const int blk = rem & 15;
    a.dsh = 2 * a.g; const int d = 1 << a.dsh; a.r = blk & (d - 1); a.nbk = blk >> a.dsh; a.head = a.g * 4 + a.h4; return a;
}
__device__ __forceinline__ void attn_load(Frame& F, int uid, int tid, AttnPre& P) {
    const AttnId a = attn_decode(uid);
    const bf16* proj = (const bf16*)(F.ws + WS_PROJ);
#pragma unroll
    for (int k = 0; k < 2; ++k) { const int it = tid + 512 * k, i = it >> 3, c = it & 7; const size_t row = (size_t)a.bl * SEQ + (((size_t)a.nbk * 128 + i) << a.dsh) + a.r;
        P.q[k] = *(const v4u*)(proj + row * PCOL + OFF_QA + a.head * 64 + c * 8); }
#pragma unroll
    for (int k = 0; k < 4; ++k) { const int it = tid + 512 * k, kj = it >> 3, c = it & 7; const int si = (a.nbk - 1) * 128 + kj;
        P.k[k] = (v4u){0u, 0u, 0u, 0u}; P.v[k] = (v4u){0u, 0u, 0u, 0u};
        if (si >= 0) { const size_t row = (size_t)a.bl * SEQ + ((size_t)si << a.dsh) + a.r; P.k[k] = *(const v4u*)(proj + row * PCOL + OFF_KA + a.head * 64 + c * 8); P.v[k] = *(const v4u*)(proj + row * PCOL + OFF_VA + a.head * 64 + c * 8); } }
}
__device__ __forceinline__ void attn_stage(Frame& F, int tid, const AttnPre& P, bool np) {
    LAS bf16* Qs = (LAS bf16*)F.lds; LAS bf16* Ks = Qs + 128 * 72; LAS bf16* Vs = Ks + 256 * 72;
#pragma unroll
    for (int k = 0; k < 2; ++k) { const int it = tid + 512 * k, i = it >> 3, c = it & 7; *(LAS v4u*)(Qs + i * 72 + c * 8) = P.q[k]; }
#pragma unroll
    for (int k = 0; k < 4; ++k) { const int it = tid + 512 * k, kj = it >> 3, c = it & 7; if (!(np && k < 2)) *(LAS v4u*)(Ks + kj * 72 + c * 8) = P.k[k]; *(LAS v4u*)(Vs + kj * 72 + c * 8) = P.v[k]; }
}
__device__ __forceinline__ void attn_compute(Frame& F, int uid, int tid) {
    const int lane = tid & 63, w = __builtin_amdgcn_readfirstlane(tid >> 6), fr = lane & 15, qq = lane >> 4;
    const AttnId a = attn_decode(uid);
    const float slope_d = exp2f(-8.0f * (float)(a.head + 1) / 12.0f) * (float)(1 << a.dsh);
    const LAS bf16* Qs = (const LAS bf16*)F.lds; const LAS bf16* Ks = Qs + 128 * 72; const LAS bf16* Vs = Ks + 256 * 72;
    bf16x8 qf[2];
#pragma unroll
    for (int ks = 0; ks < 2; ++ks) qf[ks] = *(const LAS bf16x8*)(Qs + (16 * w + fr) * 72 + 32 * ks + 8 * qq);
    const int t0 = (a.nbk == 0) ? 8 - w : 0;
    f32x4 sc[9];
#pragma unroll
    for (int tt = 0; tt < 9; ++tt) { f32x4 acc = (f32x4){0.f, 0.f, 0.f, 0.f};
        if (tt >= t0) {
#pragma unroll
            for (int ks = 0; ks < 2; ++ks) { const bf16x8 av = *(const LAS bf16x8*)(Ks + (16 * (w + tt) + fr) * 72 + 32 * ks + 8 * qq); acc = __builtin_amdgcn_mfma_f32_16x16x32_bf16(av, qf[ks], acc, 0, 0, 0); } }
        sc[tt] = acc; }
    const int iq = 16 * w + fr; float mx = -3.0e38f;
#pragma unroll
    for (int tt = 0; tt < 9; ++tt) if (tt >= t0) {
#pragma unroll
        for (int i = 0; i < 4; ++i) { const int kj = 16 * (w + tt) + 4 * qq + i; const int dist = 128 + iq - kj; const bool valid = (dist >= 0) && (dist <= 128) && (a.nbk > 0 || kj >= 128);
            const float sv = valid ? (sc[tt][i] * 0.125f - slope_d * (float)dist) : -1.0e30f; sc[tt][i] = sv; mx = fmaxf(mx, sv); } }
    mx = fmaxf(mx, __shfl_xor(mx, 16)); mx = fmaxf(mx, __shfl_xor(mx, 32));
    float sum = 0.f;
#pragma unroll
    for (int tt = 0; tt < 9; ++tt) {
        if (tt >= t0) {
#pragma unroll
            for (int i = 0; i < 4; ++i) { const float p = __expf(sc[tt][i] - mx); sc[tt][i] = p; sum += p; }
        } else sc[tt] = (f32x4){0.f, 0.f, 0.f, 0.f}; }
    sum += __shfl_xor(sum, 16); sum += __shfl_xor(sum, 32);
    const float inv = 1.0f / sum;
    f32x4 oacc[4];
#pragma unroll
    for (int dt = 0; dt < 4; ++dt) oacc[dt] = (f32x4){0.f, 0.f, 0.f, 0.f};
#pragma unroll
    for (int s = 0; s < 5; ++s) if (2 * s + 1 >= t0) {
        v4u pw; pw.x = pk2(sc[2 * s][0] * inv, sc[2 * s][1] * inv); pw.y = pk2(sc[2 * s][2] * inv, sc[2 * s][3] * inv);
        if (s < 4) { pw.z = pk2(sc[2 * s + 1][0] * inv, sc[2 * s + 1][1] * inv); pw.w = pk2(sc[2 * s + 1][2] * inv, sc[2 * s + 1][3] * inv); } else { pw.z = 0u; pw.w = 0u; }
        const bf16x8 pf = __builtin_bit_cast(bf16x8, pw);
        const int key0 = 16 * (w + 2 * s) + 4 * qq; int key1 = key0 + 16; if (key1 > 252) key1 = 252;
#pragma unroll
        for (int dt = 0; dt < 4; ++dt) { const v2u lo = tr4(Vs, 72, key0, 16 * dt, fr), hi = tr4(Vs, 72, key1, 16 * dt, fr);
            const bf16x8 av = __builtin_bit_cast(bf16x8, (v4u){lo.x, lo.y, hi.x, hi.y}); oacc[dt] = __builtin_amdgcn_mfma_f32_16x16x32_bf16(av, pf, oacc[dt], 0, 0, 0); }
    }
    const size_t lrow = (((size_t)a.nbk * 128 + iq) << a.dsh) + a.r, row = (size_t)a.bl * SEQ + lrow;
    bf16* og = (bf16*)(F.ws + WS_OG) + (size_t)a.bl * OGR_B + ((size_t)a.g * SEQ + lrow) * 256 + a.h4 * 64;
#pragma unroll
    for (int dt = 0; dt < 4; ++dt) { v2u o; o.x = pk2(oacc[dt][0], oacc[dt][1]); o.y = pk2(oacc[dt][2], oacc[dt][3]); *(v2u*)(og + 16 * dt + 4 * qq) = o; }
    if (qq == 0) ((float*)(F.ws + WS_LSE))[((size_t)a.g * TC + row) * 4 + a.h4] = mx + __logf(sum);
}

__device__ __forceinline__ void rot8(const bf16* p, const float* rope, int pos, int d0, float scl, float (&o1)[8], float (&o2)[8]) {
    const v4u a = *(const v4u*)(p + d0), b = *(const v4u*)(p + d0 + 32);
    const float t1[8] = {bflo(a.x), bfhi(a.x), bflo(a.y), bfhi(a.y), bflo(a.z), bfhi(a.z), bflo(a.w), bfhi(a.w)};
    const float t2[8] = {bflo(b.x), bfhi(b.x), bflo(b.y), bfhi(b.y), bflo(b.z), bfhi(b.z), bflo(b.w), bfhi(b.w)};
    const f32x4 c0 = *(const f32x4*)(rope + pos * 64 + d0), c1 = *(const f32x4*)(rope + pos * 64 + d0 + 4), s0 = *(const f32x4*)(rope + pos * 64 + 32 + d0), s1 = *(const f32x4*)(rope + pos * 64 + 32 + d0 + 4);
    const float cs[8] = {c0.x, c0.y, c0.z, c0.w, c1.x, c1.y, c1.z, c1.w}, sn[8] = {s0.x, s0.y, s0.z, s0.w, s1.x, s1.y, s1.z, s1.w};
#pragma unroll
    for (int j = 0; j < 8; ++j) { o1[j] = (t1[j] * cs[j] - t2[j] * sn[j]) * scl; o2[j] = (t1[j] * sn[j] + t2[j] * cs[j]) * scl; }
}

struct KvPre { v4u k1, k2, v[4]; f32x4 c0, c1, s0, s1; };
__device__ __forceinline__ void kvseq_load(Frame& F, int bl, int h, int c, int tid, KvPre& P) {
    const bf16* proj = (const bf16*)(F.ws + WS_PROJ); const float* rope = (const float*)(F.ws + WS_ROPE);
    { const int j = tid >> 2, d0 = (tid & 3) * 8; const size_t row = (size_t)bl * SEQ + c * 128 + j; const int pos = c * 128 + j;
      const bf16* kp = proj + row * PCOL + OFF_KR + h * 64;
      P.k1 = *(const v4u*)(kp + d0); P.k2 = *(const v4u*)(kp + d0 + 32);
      P.c0 = *(const f32x4*)(rope + pos * 64 + d0); P.c1 = *(const f32x4*)(rope + pos * 64 + d0 + 4); P.s0 = *(const f32x4*)(rope + pos * 64 + 32 + d0); P.s1 = *(const f32x4*)(rope + pos * 64 + 32 + d0 + 4); }
#pragma unroll
    for (int k = 0; k < 4; ++k) { const int it = tid + 512 * k, j = it >> 4, cc = it & 15; const size_t row = (size_t)bl * SEQ + c * 128 + j;
        P.v[k] = *(const v4u*)(proj + row * PCOL + OFF_VR + h * 128 + cc * 8); }
}
__device__ __forceinline__ void rot8r(const v4u a, const v4u b, const f32x4 c0, const f32x4 c1, const f32x4 s0, const f32x4 s1, float scl, v4u& o1, v4u& o2) {
    const float t1[8] = {bflo(a.x), bfhi(a.x), bflo(a.y), bfhi(a.y), bflo(a.z), bfhi(a.z), bflo(a.w), bfhi(a.w)};
    const float t2[8] = {bflo(b.x), bfhi(b.x), bflo(b.y), bfhi(b.y), bflo(b.z), bfhi(b.z), bflo(b.w), bfhi(b.w)};
    const float cs[8] = {c0.x, c0.y, c0.z, c0.w, c1.x, c1.y, c1.z, c1.w}, sn[8] = {s0.x, s0.y, s0.z, s0.w, s1.x, s1.y, s1.z, s1.w};
    float r1[8], r2[8];
#pragma unroll
    for (int j = 0; j < 8; ++j) { r1[j] = (t1[j] * cs[j] - t2[j] * sn[j]) * scl; r2[j] = (t1[j] * sn[j] + t2[j] * cs[j]) * scl; }
    o1 = (v4u){pk2(r1[0], r1[1]), pk2(r1[2], r1[3]), pk2(r1[4], r1[5]), pk2(r1[6], r1[7])};
    o2 = (v4u){pk2(r2[0], r2[1]), pk2(r2[2], r2[3]), pk2(r2[4], r2[5]), pk2(r2[6], r2[7])};
}
__device__ __forceinline__ void kvseq_unit(Frame& F, int bh) {
    int tid_ = F.wv * 64 + lane_id(); asm volatile("" : "+v"(tid_)); const int tid = tid_, lane = tid & 63, w = __builtin_amdgcn_readfirstlane(tid >> 6), fr = lane & 15, qq = lane >> 4;
    const int bl = bh >> 3, h = bh & 7;
    const float l2g = log2_gamma(h), gam = exp2f(l2g), g127 = exp2f(127.0f * l2g), g128 = exp2f(128.0f * l2g);
    constexpr int KVB = 128 * 72 + 128 * 136;
    f32x4 st[4];
#pragma unroll
    for (int mt = 0; mt < 4; ++mt) st[mt] = (f32x4){0.f, 0.f, 0.f, 0.f};
    KvPre P0, P1; kvseq_load(F, bl, h, 0, tid, P0); kvseq_load(F, bl, h, 1, tid, P1);
    const float kscl = 0.125f * exp2f(-(float)(tid >> 2) * l2g);
    bf16* rpt = (bf16*)(F.ws + WS_OG) + (size_t)bl * OGR_B + RPT_OFF + (size_t)(h * 16) * 8192 + (size_t)(16 * w + fr) * 64 + 4 * qq;
#define KVSEQ_STEP(P, c, bufi) do { LAS bf16* Ks = (LAS bf16*)F.lds + (bufi) * KVB; LAS bf16* Vs = Ks + 128 * 72; \
        { const int j = tid >> 2, d0 = (tid & 3) * 8; v4u o1, o2; rot8r(P.k1, P.k2, P.c0, P.c1, P.s0, P.s1, kscl, o1, o2); \
          *(LAS v4u*)(Ks + j * 72 + d0) = o1; *(LAS v4u*)(Ks + j * 72 + d0 + 32) = o2; } \
        _Pragma("unroll") for (int k = 0; k < 4; ++k) { const int it = tid + 512 * k, j = it >> 4, cc = it & 15; *(LAS v4u*)(Vs + j * 136 + cc * 8) = P.v[k]; } \
        _Pragma("unroll") for (int mt = 0; mt < 4; ++mt) *(v2u*)(rpt + (size_t)(c) * 8192 + 16 * mt) = (v2u){pk2(gam * st[mt][0], gam * st[mt][1]), pk2(gam * st[mt][2], gam * st[mt][3])}; \
        LDS_BARRIER(); \
        if ((c) + 2 < 16) kvseq_load(F, bl, h, (c) + 2, tid, P); \
        f32x4 acc[4]; \
        _Pragma("unroll") for (int mt = 0; mt < 4; ++mt) acc[mt] = (f32x4){0.f, 0.f, 0.f, 0.f}; \
        _Pragma("unroll") for (int ks = 0; ks < 4; ++ks) { \
            const v2u blo = tr4(Vs, 136, 32 * ks + 4 * qq, 16 * w, fr), bhi = tr4(Vs, 136, 32 * ks + 16 + 4 * qq, 16 * w, fr); \
            const bf16x8 bv = __builtin_bit_cast(bf16x8, (v4u){blo.x, blo.y, bhi.x, bhi.y}); \
            _Pragma("unroll") for (int mt = 0; mt < 4; ++mt) { \
                const v2u alo = tr4(Ks, 72, 32 * ks + 4 * qq, 16 * mt, fr), ahi = tr4(Ks, 72, 32 * ks + 16 + 4 * qq, 16 * mt, fr); \
                acc[mt] = __builtin_amdgcn_mfma_f32_16x16x32_bf16(__builtin_bit_cast(bf16x8, (v4u){alo.x, alo.y, ahi.x, ahi.y}), bv, acc[mt], 0, 0, 0); } } \
        _Pragma("unroll") for (int mt = 0; mt < 4; ++mt) st[mt] = st[mt] * g128 + acc[mt] * g127; } while (0)
    for (int c = 0; c < 16; c += 2) { KVSEQ_STEP(P0, c, 0); KVSEQ_STEP(P1, c + 1, 1); }
    LDS_BARRIER();
#undef KVSEQ_STEP
}
__device__ __forceinline__ void merge_items(Frame& F) {
    int tid_ = F.wv * 64 + lane_id(); asm volatile("" : "+v"(tid_)); const int tid = tid_;
    const bf16* og = (const bf16*)(F.ws + WS_OG) + (size_t)F.xi * OGR_B; const float* lse = (const float*)(F.ws + WS_LSE); bf16* att = (bf16*)(F.ws + WS_ATT) + (size_t)F.crow * 256;
    const int istr = F.NR_() * 512;
    for (int item0 = F.rank * 512 + tid; item0 < SEQ * 32; item0 += 4 * istr) {
        float l0[4], l1[4], l2[4]; v4u a[4], b[4], c[4];
#pragma unroll
        for (int q = 0; q < 4; ++q) { const int item = item0 + q * istr < SEQ * 32 ? item0 + q * istr : item0; const int row = F.xi * SEQ + (item >> 5), ch = item & 31, h4 = ch >> 3;
            l0[q] = lse[((size_t)0 * TC + row) * 4 + h4]; l1[q] = lse[((size_t)1 * TC + row) * 4 + h4]; l2[q] = lse[((size_t)2 * TC + row) * 4 + h4];
            const size_t lr = (size_t)(item >> 5) * 256 + ch * 8;
            a[q] = *(const v4u*)(og + lr); b[q] = *(const v4u*)(og + (size_t)SEQ * 256 + lr); c[q] = *(const v4u*)(og + (size_t)2 * SEQ * 256 + lr); }
#pragma unroll
        for (int q = 0; q < 4; ++q) { const int item = item0 + q * istr; if (item < SEQ * 32) { const int row = F.xi * SEQ + (item >> 5), ch = item & 31;
            const float mx = fmaxf(l0[q], fmaxf(l1[q], l2[q])); float w0 = __expf(l0[q] - mx), w1 = __expf(l1[q] - mx), w2 = __expf(l2[q] - mx); const float inv = 1.0f / (w0 + w1 + w2); w0 *= inv; w1 *= inv; w2 *= inv;
            v4u o;
            o.x = pk2(w0 * bflo(a[q].x) + w1 * bflo(b[q].x) + w2 * bflo(c[q].x), w0 * bfhi(a[q].x) + w1 * bfhi(b[q].x) + w2 * bfhi(c[q].x));
            o.y = pk2(w0 * bflo(a[q].y) + w1 * bflo(b[q].y) + w2 * bflo(c[q].y), w0 * bfhi(a[q].y) + w1 * bfhi(b[q].y) + w2 * bfhi(c[q].y));
            o.z = pk2(w0 * bflo(a[q].z) + w1 * bflo(b[q].z) + w2 * bflo(c[q].z), w0 * bfhi(a[q].z) + w1 * bfhi(b[q].z) + w2 * bfhi(c[q].z));
            o.w = pk2(w0 * bflo(a[q].w) + w1 * bflo(b[q].w) + w2 * bflo(c[q].w), w0 * bfhi(a[q].w) + w1 * bfhi(b[q].w) + w2 * bfhi(c[q].w));
            *(v4u*)(att + (size_t)row * 256 + ch * 8) = o; } }
    }
}
struct RetPre { v4u q1, q2, k1, k2, v[4], r[2]; f32x4 c0, c1, s0, s1; };
__device__ __forceinline__ void ret_load(Frame& F, int kid, int tid, RetPre& P) {
    const int bh = kid >> 4, c = kid & 15, bl = bh >> 3, h = bh & 7;
    const bf16* proj = (const bf16*)(F.ws + WS_PROJ); const float* rope = (const float*)(F.ws + WS_ROPE);
    { const int j = tid >> 2, d0 = (tid & 3) * 8; const size_t row = (size_t)bl * SEQ + c * 128 + j; const int pos = c * 128 + j;
      const bf16* qp = proj + row * PCOL + OFF_QR + h * 64; const bf16* kp = proj + row * PCOL + OFF_KR + h * 64;
      P.q1 = *(const v4u*)(qp + d0); P.q2 = *(const v4u*)(qp + d0 + 32); P.k1 = *(const v4u*)(kp + d0); P.k2 = *(const v4u*)(kp + d0 + 32);
      P.c0 = *(const f32x4*)(rope + pos * 64 + d0); P.c1 = *(const f32x4*)(rope + pos * 64 + d0 + 4); P.s0 = *(const f32x4*)(rope + pos * 64 + 32 + d0); P.s1 = *(const f32x4*)(rope + pos * 64 + 32 + d0 + 4); }
#pragma unroll
    for (int k = 0; k < 4; ++k) { const int it = tid + 512 * k, j = it >> 4, cc = it & 15; const size_t row = (size_t)bl * SEQ + c * 128 + j;
        P.v[k] = *(const v4u*)(proj + row * PCOL + OFF_VR + h * 128 + cc * 8); }
    { const bf16* rp = (const bf16*)(F.ws + WS_OG) + (size_t)bl * OGR_B + RPT_OFF + (size_t)(kid & 127) * 8192;
#pragma unroll
      for (int k = 0; k < 2; ++k) { const int it = tid + 512 * k, dv = it >> 3, cc = it & 7; P.r[k] = *(const v4u*)(rp + dv * 64 + cc * 8); } }
}
__device__ __forceinline__ void ret_stage(Frame& F, int kid, int tid, const RetPre& P) {
    const int h = (kid >> 4) & 7; const float l2g = log2_gamma(h);
    LAS bf16* Qs = (LAS bf16*)F.lds; LAS bf16* Ks = Qs + 128 * 72; LAS bf16* Rs = Ks + 128 * 72; LAS bf16* Vs = Rs + 128 * 72;
    { const int j = tid >> 2, d0 = (tid & 3) * 8; v4u o1, o2;
      rot8r(P.q1, P.q2, P.c0, P.c1, P.s0, P.s1, exp2f((float)j * l2g), o1, o2);
      *(LAS v4u*)(Qs + j * 72 + d0) = o1; *(LAS v4u*)(Qs + j * 72 + d0 + 32) = o2;
      rot8r(P.k1, P.k2, P.c0, P.c1, P.s0, P.s1, 0.125f * exp2f(-(float)j * l2g), o1, o2);
      *(LAS v4u*)(Ks + j * 72 + d0) = o1; *(LAS v4u*)(Ks + j * 72 + d0 + 32) = o2; }
#pragma unroll
    for (int k = 0; k < 4; ++k) { const int it = tid + 512 * k, j = it >> 4, cc = it & 15; *(LAS v4u*)(Vs + j * 136 + cc * 8) = P.v[k]; }
#pragma unroll
    for (int k = 0; k < 2; ++k) { const int it = tid + 512 * k, dv = it >> 3, cc = it & 7; *(LAS v4u*)(Rs + dv * 72 + cc * 8) = P.r[k]; }
}
constexpr int RET_GS_OFF = (128 * 72 * 3 + 128 * 136) * 2;
__device__ __forceinline__ void ret_gate_dma(Frame& F, int kid, int tid) {
    const int lane = tid & 63, w = __builtin_amdgcn_readfirstlane(tid >> 6);
    const int bh = kid >> 4, c = kid & 15, bl = bh >> 3, h = bh & 7;
    const bf16* gp = (const bf16*)(F.ws + WS_PROJ) + ((size_t)bl * SEQ + c * 128 + 16 * w) * PCOL + OFF_GR + h * 128;
    asm volatile("" ::: "memory");
#pragma unroll
    for (int k = 0; k < 4; ++k) { const int p = k * 64 + lane, r = p >> 4, cc = (p & 15) ^ r;
        __builtin_amdgcn_global_load_lds((const unsigned*)(gp + (size_t)r * PCOL + cc * 8), (LAS unsigned*)(F.lds + RET_GS_OFF + w * 4096 + k * 1024), 16, 0, 0); }
    asm volatile("" ::: "memory");
}
constexpr int RET_NLOADS = 14;
__device__ __forceinline__ void ret_compute(Frame& F, int kid, int tid, bool younger) {
    const int lane = tid & 63, w = __builtin_amdgcn_readfirstlane(tid >> 6), fr = lane & 15, qq = lane >> 4;
    const int bh = kid >> 4, c = kid & 15, bl = bh >> 3, h = bh & 7;
    const bf16* proj = (const bf16*)(F.ws + WS_PROJ);
    const LAS bf16* Qs = (const LAS bf16*)F.lds;
    const LAS bf16* Ks = Qs + 128 * 72;
    const LAS bf16* Rs = Ks + 128 * 72;
    const LAS bf16* Vs = Rs + 128 * 72;
    bf16x8 qf[2];
#pragma unroll
    for (int ks = 0; ks < 2; ++ks) qf[ks] = *(const LAS bf16x8*)(Qs + (16 * w + fr) * 72 + 32 * ks + 8 * qq);
    f32x4 oacc[8];
#pragma unroll
    for (int dt = 0; dt < 8; ++dt) oacc[dt] = (f32x4){0.f, 0.f, 0.f, 0.f};
    const int iq = 16 * w + fr;
#pragma unroll
    for (int s = 0; s < 4; ++s) {
        if (2 * s <= w) {
            f32x4 sa = (f32x4){0.f, 0.f, 0.f, 0.f}, sb = (f32x4){0.f, 0.f, 0.f, 0.f};
#pragma unroll
            for (int ks = 0; ks < 2; ++ks) { const bf16x8 av = *(const LAS bf16x8*)(Ks + (32 * s + fr) * 72 + 32 * ks + 8 * qq); sa = __builtin_amdgcn_mfma_f32_16x16x32_bf16(av, qf[ks], sa, 0, 0, 0); }
            if (2 * s + 1 <= w) {
#pragma unroll
                for (int ks = 0; ks < 2; ++ks) { const bf16x8 av = *(const LAS bf16x8*)(Ks + (32 * s + 16 + fr) * 72 + 32 * ks + 8 * qq); sb = __builtin_amdgcn_mfma_f32_16x16x32_bf16(av, qf[ks], sb, 0, 0, 0); }
            }
#pragma unroll
            for (int i = 0; i < 4; ++i) { const int ka = 32 * s + 4 * qq + i; if (ka > iq) sa[i] = 0.f; if (ka + 16 > iq) sb[i] = 0.f; }
            const bf16x8 pf = __builtin_bit_cast(bf16x8, (v4u){pk2(sa[0], sa[1]), pk2(sa[2], sa[3]), pk2(sb[0], sb[1]), pk2(sb[2], sb[3])});
#pragma unroll
            for (int dt = 0; dt < 8; ++dt) { const v2u lo = tr4(Vs, 136, 32 * s + 4 * qq, 16 * dt, fr), hi = tr4(Vs, 136, 32 * s + 16 + 4 * qq, 16 * dt, fr);
                const bf16x8 av = __builtin_bit_cast(bf16x8, (v4u){lo.x, lo.y, hi.x, hi.y}); oacc[dt] = __builtin_amdgcn_mfma_f32_16x16x32_bf16(av, pf, oacc[dt], 0, 0, 0); }
        }
    }
#pragma unroll
    for (int dt = 0; dt < 8; ++dt)
#pragma unroll
        for (int ks = 0; ks < 2; ++ks) { const bf16x8 av = *(const LAS bf16x8*)(Rs + (16 * dt + fr) * 72 + 32 * ks + 8 * qq); oacc[dt] = __builtin_amdgcn_mfma_f32_16x16x32_bf16(av, qf[ks], oacc[dt], 0, 0, 0); }
    float ss = 0.f;
#pragma unroll
    for (int dt = 0; dt < 8; ++dt) ss += sq4(oacc[dt]);
    ss += __shfl_xor(ss, 16); ss += __shfl_xor(ss, 32);
    const float rn = rsqrtf(ss * (1.0f / 128.0f) + EPS);
    const size_t row = (size_t)bl * SEQ + c * 128 + iq;
    bf16* rp = (bf16*)(F.ws + WS_RET) + (row + (size_t)F.crow) * DM + h * 128;
    if (younger) asm volatile("s_waitcnt vmcnt(%0)" :: "n"(RET_NLOADS) : "memory"); else asm volatile("s_waitcnt vmcnt(0)" ::: "memory");
    const LAS unsigned char* gs = F.lds + RET_GS_OFF + w * 4096 + fr * 256 + (qq & 1) * 8;
#pragma unroll
    for (int dt = 0; dt < 8; ++dt) { const v2u gw2 = *(const LAS v2u*)(gs + (((2 * dt + (qq >> 1)) ^ fr) << 4));
        const float g0 = bflo(gw2.x), g1 = bfhi(gw2.x), g2 = bflo(gw2.y), g3 = bfhi(gw2.y);
        v2u o; o.x = pk2(g0 * pg8::sigm(g0) * oacc[dt][0] * rn, g1 * pg8::sigm(g1) * oacc[dt][1] * rn); o.y = pk2(g2 * pg8::sigm(g2) * oacc[dt][2] * rn, g3 * pg8::sigm(g3) * oacc[dt][3] * rn);
        *(v2u*)(rp + 16 * dt + 4 * qq) = o; }
}

__device__ __forceinline__ void c2_phase(Frame& F) {
    fresh_ids(F);
    int tid_ = F.wv * 64 + lane_id(); asm volatile("" : "+v"(tid_)); const int tid = tid_;
    const int nu = (F.rank < 128) ? (128 - F.rank + F.NR_() - 1) / F.NR_() : 0, k0 = F.xi * 128 + F.rank;
    RetPre P;
    if (nu > 0) ret_load(F, k0, tid, P);
    merge_items(F);
    for (int k = 0; k < nu; ++k) {
        ret_stage(F, k0 + k * F.NR_(), tid, P);
        ret_gate_dma(F, k0 + k * F.NR_(), tid);
        LDS_BARRIER();
        if (k + 1 < nu) ret_load(F, k0 + (k + 1) * F.NR_(), tid, P);
        ret_compute(F, k0 + k * F.NR_(), tid, k + 1 < nu);
        LDS_BARRIER();
    }
}

__device__ __forceinline__ void c1_phase(Frame& F) {
    fresh_ids(F);
    int tid_ = F.wv * 64 + lane_id(); asm volatile("" : "+v"(tid_)); const int tid = tid_;
    const bool split = F.NR_() > 8;
    const int a0 = split ? F.rank - 8 : F.rank, astride = split ? F.NR_() - 8 : F.NR_();
    const int na = (split && F.rank < 8) ? 0 : (a0 < 192 ? (192 - a0 + astride - 1) / astride : 0), ab = F.xi * 192;
    for (int repa = 0; repa < REP_C1A; ++repa)
    if (na > 0) {
        AttnPre P; attn_load(F, ab + a0, tid, P);
        for (int k = 0; k < na; ++k) {
            attn_stage(F, tid, P, attn_decode(ab + a0 + k * astride).nbk == 0);
            LDS_BARRIER();
            if (k + 1 < na) attn_load(F, ab + a0 + (k + 1) * astride, tid, P);
            attn_compute(F, ab + a0 + k * astride, tid);
            LDS_BARRIER();
        }
    }
    for (int repk = 0; repk < REP_C1K; ++repk)
    if (split) { if (F.rank < 8) kvseq_unit(F, F.xi * 8 + F.rank); }
    else { for (int u = F.rank; u < 8; u += F.NR_()) kvseq_unit(F, F.xi * 8 + u); }
}

constexpr int STEPS_L0 = NCH * 5 + 1 + 2 + 1, STEPS_L1 = NCH * 5 + 1 + 1 + 2 + 1, NSTEPS = 2 + STEPS_L0 + STEPS_L1;

#ifndef NVG
#define NVG
#endif
#ifndef LBW
#define LBW 2
#endif
__global__ void __launch_bounds__(NWAVES * 64, LBW) NVG fwd(const Args args) {
    extern __shared__ __attribute__((aligned(16))) unsigned char lds_raw[];
    Frame F;
    F.lds = (LAS unsigned char*)lds_raw;
    F.G = gridDim.x; F.wv = __builtin_amdgcn_readfirstlane(threadIdx.x >> 6);
    F.ws = args.ws; F.out = args.out; F.ctl = (gu32*)(args.ws + WS_CTL);
    for (int u = threadIdx.x; u < (LDS_BYTES - LDSCTL_OFF) / 4; u += NWAVES * 64) ((LAS unsigned*)(F.lds + LDSCTL_OFF))[u] = 0u;
    __syncthreads();
    XcdBarrier bar; bar.bar = (unsigned*)(F.ctl + CW_BAR); bar.x = 0; bar.st = nullptr; bar.wv = F.wv;
    if (!MK_MULTI) bar = xcd_barrier_post((unsigned*)(F.ctl + CW_BAR), (volatile LAS unsigned*)(F.lds + MISC_OFF + 32), F.wv);
    const int lo = args.lo, hi = args.hi; int seq = 0;
    volatile LAS unsigned* misc = (volatile LAS unsigned*)(F.lds + MISC_OFF);
    const unsigned my_xcc = xb_xcc_id();
    if (!MK_MULTI && threadIdx.x == 0) misc[48] = xb_add((unsigned*)(F.ctl + CW_RANK + 64 * my_xcc), 1u);
    __syncthreads();
    const int hw_rank = __builtin_amdgcn_readfirstlane((int)misc[48]);
    F.xi = (int)(blockIdx.x & 7); F.rank = (int)(blockIdx.x >> 3);
    bool xl = false; int lgen = 0;
#define STEP_ON (seq >= lo && seq < hi)
#define FRESH_WS unsigned char* ws = args.ws; asm volatile("" : "+s"(ws))
#define STEP_END do { if (!MK_MULTI && STEP_ON && seq + 1 < hi) { for (int rb = 0; rb < REP_BAR; ++rb) xcd_barrier(bar); } ++seq; } while (0)
#define STEP_END_L do { if (!MK_MULTI && STEP_ON && seq + 1 < hi) { if (xl) xl_barrier(F.ctl, bar.bar, F.xi, F.NR_(), lgen, F.wv); else xcd_barrier(bar); } ++seq; } while (0)
    LAS unsigned char* ring = F.lds;

    const bool side = (F.G == 256);
    if (STEP_ON) {
#ifndef SKIP_PRO
        for (int rp = 0; rp < REP_PRO; ++rp) {
        adaln_phase(F, args);
        rope_phase(F);
        absmax_phase(F, args);
        convert_mixer_weights(F, args, 0);
        if (!side) convert_ffn_weights(F, args.in[I_WFG], args.in[I_WFU], args.in[I_WFD], 0, 0, FFN_ITEMS, (int)blockIdx.x * NWAVES + F.wv, F.G * NWAVES);
        __syncthreads(); }
#endif
    }
    STEP_END;
    if (!MK_MULTI && lo == 0 && hi > 1) {
        if (threadIdx.x == 0) { unsigned ok = (F.G % 8 == 0) ? 1u : 0u, idx = 0u, npop = 0u;
            for (unsigned j = 0; j < 16; ++j) { const unsigned c = xb_ld(&bar.bar[XB_XCNT(j)]); if (c) { if (c != (unsigned)F.NR_()) ok = 0u; if (j < my_xcc) ++idx; ++npop; } }
            if (npop != 8u) ok = 0u;
            misc[49] = ok; misc[50] = idx; }
        __syncthreads();
        xl = misc[49] != 0u;
        if (xl) { F.xi = __builtin_amdgcn_readfirstlane((int)misc[50]); F.rank = hw_rank; }
    }
    if (STEP_ON) { convert_win(F, args, 0); __syncthreads(); for (int rep = 0; rep < REP_A; ++rep) phase_a(F, args); }
    STEP_END;

    for (int l = 0; l < DEPTH; ++l) {
        const bool moe = (l & 1) != 0;
        for (int rmix = 0; rmix < (l == 0 ? REP_MIX : 1); ++rmix)
        for (int ch = 0; ch < NCH; ++ch) {
            F.crow = ch * TC; fresh_ids(F);
            if (STEP_ON && side && F.rank >= 8) {
                const int gwi = ((F.rank - 8) * 8 + F.xi) * NWAVES + F.wv, ngw = 192 * NWAVES;
                constexpr int FI = FFN_ITEMS;
                if (l == 0) { if (ch == 0) { convert_ffn_weights(F, args.in[I_WFG], args.in[I_WFU], args.in[I_WFD], 0, 0, FI, gwi, ngw); convert_ffn_weights(F, args.in[I_WEG], args.in[I_WEU], args.in[I_WED], 1, FI, 2 * FI, gwi, ngw); }
                              else convert_ffn_weights(F, args.in[I_WEG], args.in[I_WEU], args.in[I_WED], 1, 2 * FI, 4 * FI, gwi, ngw); }
                else { if (ch == 0) { convert_ffn_weights(F, args.in[I_WEG], args.in[I_WEU], args.in[I_WED], 1, 0, FI, gwi, ngw); convert_ffn_weights(F, args.in[I_WEG], args.in[I_WEU], args.in[I_WED], 1, 4 * FI, 4 * FI + FI * 3 / 2, gwi, ngw); }
                       else convert_ffn_weights(F, args.in[I_WEG], args.in[I_WEU], args.in[I_WED], 1, 4 * FI + FI * 3 / 2, 8 * FI, gwi, ngw); }
                __syncthreads();
            }
            if (STEP_ON) {
#ifndef SKIP_B
                FRESH_WS;
                pg8::Gemm g{(const bf16*)(ws + WS_H + (size_t)ch * TC * DM), (const bf16*)(ws + WS_WM + WM_WIN), TC, NCOL, DM / 2}; pg8::StaticOrder S; S.init(TC, NCOL, F.G, F.vb_());
                pg8::EpiI8 E{(bf16*)(ws + WS_PROJ), PCOL, (const float*)(ws + WS_RS) + (size_t)ch * TC, ((const float*)(ws + WS_WSC))[l], ws + WS_G8 + (size_t)ch * TC * GCOL, PCOL / 256};
                for (int rep = 0; rep < REP_B; ++rep) pg8::gemm_phase<pg8::EpiI8, pg8::StaticOrder, true, true, 2>(ring, F.wv, g, S, E);
#endif
            }
            STEP_END_L;
            if (STEP_ON) {
#ifndef SKIP_C1
                for (int rep = 0; rep < REP_C1; ++rep) c1_phase(F);
#endif

            }
            STEP_END_L;
#ifndef SKIP_C2
            if (STEP_ON) { for (int rep = 0; rep < REP_C2; ++rep) c2_phase(F); }
#endif

            if (ch == NCH - 1) STEP_END; else STEP_END_L;
        }
        fresh_ids(F);
        if (STEP_ON) {
#ifndef SKIP_E
            FRESH_WS;
            pg8::Gemm g{(const bf16*)(ws + WS_ATT), (const bf16*)(ws + WS_WM + WM_WA), T, DM, 256}; pg8::StaticOrder S; S.init(T, DM, F.G, F.vb_());
            pg8::EpiGate<0> E{ws + WS_G8, GCOL, (bf16*)(ws + WS_MRG), DM};
            for (int rep = 0; rep < REP_E; ++rep) pg8::gemm_phase<pg8::EpiGate<0>, pg8::StaticOrder, true, true>(ring, F.wv, g, S, E);
#endif
        }
        if (STEP_ON) {
#ifndef SKIP_F
            FRESH_WS;
            pg8::Gemm g{(const bf16*)(ws + WS_RET), (const bf16*)(ws + WS_WM + WM_WR), T, DM, DM}; pg8::StaticOrder S; S.init(T, DM, F.G, F.vb_());
            pg8::EpiGate<1> E{ws + WS_G8 + DM, GCOL, (bf16*)(ws + WS_MRG), DM};
            pg8::gemm_phase<pg8::EpiGate<1>, pg8::StaticOrder, true, true>(ring, F.wv, g, S, E);
#endif
        }
        STEP_END_L;
        fresh_ids(F);
        if (STEP_ON) {
#ifndef SKIP_G
            FRESH_WS;
            pg8::Gemm g{(const bf16*)(ws + WS_MRG), (const bf16*)(ws + WS_WM + WM_WMIX), T, DM, DM}; pg8::StaticOrder S; S.init(T, DM, F.G, F.vb_());
            pg8::EpiBf16 E{(bf16*)(ws + WS_Y), DM};
            for (int rep = 0; rep < REP_G; ++rep) pg8::gemm_phase<pg8::EpiBf16, pg8::StaticOrder, true, true>(ring, F.wv, g, S, E);
#endif
        }
        STEP_END_L;
#ifndef SKIP_H
        fresh_ids(F);
        if (STEP_ON) {
#pragma nounroll
            for (int j = 0; j < 2; ++j) { const int e = 2 * F.xi + j; phase_h(F, args, l, moe, e >> 3, (e & 7) * F.NR_() + F.rank, F.G, j == 0); __syncthreads(); }
        }
#endif
        if (moe) STEP_END; else STEP_END_L;
        if (moe) { if (STEP_ON) phase_h2(F, F.G, F.G); STEP_END; }
        const int fvb = moe ? (int)blockIdx.x : F.vb_();
        {
            LAS int* tendL = (LAS int*)(F.lds + MISC_OFF + 128);
            if (F.wv == 0 && lane_id() == 0) { int acc = 0;
                for (int e = 0; e < 8; ++e) { const int c = moe ? (int)__hip_atomic_load((unsigned*)(F.ctl + CW_ECNT + e), RLX_AGENT) : (e == 0 ? T : 0); acc += (c + 255) >> 8; tendL[e] = acc; } }
            if (F.wv == 1 && lane_id() < 8) ((LAS float*)(F.lds + MISC_OFF + 256))[lane_id()] = ((const float*)(F.ws + WS_WSCF))[lane_id()];
            __syncthreads();
            const int ttot = __builtin_amdgcn_readfirstlane(tendL[7]);
            for (int rffn = 0; rffn < (l == 0 ? REP_FFN0 : 1); ++rffn) {
            if (STEP_ON) {
#ifndef SKIP_I
                FRESH_WS;
                pg8::Gemm g{(const bf16*)(ws + WS_H), (const bf16*)(ws + WS_WF), ttot * 256, 2 * FF, DM / 2, (const int*)(ws + WS_SRC)};
                pg8::FfnOrder S; S.so.init(ttot * 256, 2 * FF, F.G, fvb); S.tend = tendL; S.estride = (unsigned)WF_E;
                pg8::EpiSwigluI8 E{ws + WS_U, FF, moe ? (const float*)(ws + WS_RSS) : (const float*)(ws + WS_RS), (const LAS float*)(F.lds + MISC_OFF + 256)};
                if (moe) pg8::gemm_phase<pg8::EpiSwigluI8, pg8::FfnOrder, true, true, 2, true>(ring, F.wv, g, S, E);
                else pg8::gemm_phase<pg8::EpiSwigluI8, pg8::FfnOrder, true, true, 2>(ring, F.wv, g, S, E);
#endif
            }
            if (moe) STEP_END; else STEP_END_L;
            if (STEP_ON) {
#ifndef SKIP_J
                FRESH_WS;
                pg8::Gemm g{(const bf16*)(ws + WS_U), (const bf16*)(ws + WS_WF + WF_GU), ttot * 256, DM, FF / 2};
                pg8::FfnOrder S; S.so.init(ttot * 256, DM, F.G, fvb); S.tend = tendL; S.estride = (unsigned)WF_E;
                pg8::EpiBf16 E{(bf16*)(ws + WS_YS), DM};
                for (int rep = 0; rep < REP_J; ++rep) pg8::gemm_phase<pg8::EpiBf16, pg8::FfnOrder, true, true, 1>(ring, F.wv, g, S, E);
#endif
            }
            if (moe) STEP_END; else STEP_END_L;
            }
        }
        if (STEP_ON) {
#ifndef SKIP_K
            phase_k(F, args, l, moe, moe ? (int)blockIdx.x : (2 * F.xi + (F.rank >> 4)) * (F.G >> 4) + (F.rank & 15));
            if (l + 1 < DEPTH) { convert_mixer_weights(F, args, l + 1); convert_win(F, args, l + 1);
                if (!side) convert_ffn_weights(F, args.in[I_WEG], args.in[I_WEU], args.in[I_WED], 1, 0, NEXP * FFN_ITEMS, (int)blockIdx.x * NWAVES + F.wv, F.G * NWAVES); }
#endif

        }
        STEP_END;
    }
#undef STEP_ON
#undef STEP_END
}

extern "C" void kernel_launch(void* const* d_in, const int* in_sizes, int n_in, void* d_out, int out_size, void* d_ws, size_t ws_size, hipStream_t stream) {
    static int grid = 0;
    if (grid == 0) {
        if (n_in != 20 || in_sizes[0] != T * DM || out_size != T * DM || ws_size < WS_END) { fprintf(stderr, "kernel_launch: unexpected shapes / workspace (%zu < %zu)\n", ws_size, (size_t)WS_END); grid = -1; return; }
        int dev = 0, cus = 0, per_cu = 0;
        if (hipGetDevice(&dev) != hipSuccess || hipDeviceGetAttribute(&cus, hipDeviceAttributeMultiprocessorCount, dev) != hipSuccess) { grid = -1; return; }
        if (hipFuncSetAttribute((const void*)fwd, hipFuncAttributeMaxDynamicSharedMemorySize, LDS_BYTES) != hipSuccess) { grid = -1; return; }
        if (hipOccupancyMaxActiveBlocksPerMultiprocessor(&per_cu, (const void*)fwd, NWAVES * 64, LDS_BYTES) != hipSuccess || per_cu < 1) { fprintf(stderr, "kernel_launch: occupancy query says %d\n", per_cu); }
        (void)hipGetLastError();
        grid = cus;
    }
    if (grid < 0) return;
    (void)hipMemsetAsync((char*)d_ws + WS_CTL, 0, CTL_ZERO_BYTES, stream);
    Args a{};
    for (int i = 0; i < 20; ++i) a.in[i] = (const float*)d_in[i];
    a.out = (float*)d_out; a.ws = (unsigned char*)d_ws;
#if MK_MULTI
    for (int s = 0; s < NSTEPS; ++s) { a.lo = s; a.hi = s + 1; hipLaunchKernelGGL(fwd, dim3(grid), dim3(NWAVES * 64), LDS_BYTES, stream, a); }
#else
    a.lo = 0; a.hi = 1 << 30;
    hipLaunchKernelGGL(fwd, dim3(grid), dim3(NWAVES * 64), LDS_BYTES, stream, a);
#endif
}
```

```cpp
#include <hip/hip_runtime.h>
#include <cstdio>
#include <cstdint>

#define REP_B 1
#define REP_C1 1
#define REP_BAR 1
#define REP_H0 1
#define REP_PRO 1
#define REP_MIX 1
#define REP_FFN0 1
#define REP_SH 1
#define REP_SC 1
#define REP_CVT 1
#define REP_A 1
#define REP_C1A 1
#define REP_C1K 1
#define REP_D 1
#define REP_C2 1
#define REP_E 1
#define REP_G 1
#define REP_I 1
#define REP_J 1
#ifndef MK_MULTI
#define MK_MULTI 0
#endif

__device__ __forceinline__ int lane_id() { int r; asm volatile("v_mbcnt_lo_u32_b32 %0, -1, 0\n\tv_mbcnt_hi_u32_b32 %0, -1, %0" : "=v"(r)); return r; }
namespace pg8 {
#define PG8_LAS __attribute__((address_space(3)))
#define PG8_GAS __attribute__((address_space(1)))
typedef unsigned short bf16_t;
typedef short bf16x8 __attribute__((ext_vector_type(8)));
typedef float f32x4 __attribute__((ext_vector_type(4)));
typedef unsigned u32x4 __attribute__((ext_vector_type(4)));
typedef int v8i32 __attribute__((ext_vector_type(8)));
typedef int v4i32 __attribute__((ext_vector_type(4)));
constexpr int BM = 256, BK = 64, HALF = 128, HTB = HALF * BK * 2, STAGE_BYTES = 8 * HTB, NXCD = 8, WGM = 8;

__host__ __device__ __forceinline__ int lds_byte(int r, int c) { const int st = (r >> 4) * 2 + (c >> 5), rr = r & 15, cc = c & 31, ob = rr * 64 + cc * 2; return st * 1024 + (ob ^ (((ob >> 9) & 1) << 5)); }
__host__ __device__ __forceinline__ void stage_rc(int b, int& R, int& C) { const int st = b / 1024, sb = b % 1024, swz = sb ^ (((sb >> 9) & 1) << 5); R = (st >> 1) * 16 + swz / 64; C = (st & 1) * 32 + (swz % 64) / 2; }
__host__ __device__ __forceinline__ int perm32(int rho) { const int n = rho >> 4, i = rho & 15; return 8 * (i >> 2) + 4 * n + (i & 3); }

struct Unit { int pm, pn; unsigned boff; int e; };
struct Gemm { const bf16_t* A; const bf16_t* Bt; int M, N, K; const int* gsrc; int ascale; };

struct StaticOrder {
    int nM, nN, nwg, G, c;
    __host__ __device__ void init(int M, int N, int G_, int c_) { nM = M / BM; nN = N / BM; nwg = nM * nN; G = G_; c = c_; }
    __host__ __device__ bool next(int i, Unit& u) const {
        const int L = i * G + c; if (L >= nwg) return false;
        int wgid = L; { const int q = nwg / NXCD, r = nwg % NXCD, xcd = wgid % NXCD, off = wgid / NXCD; wgid = (xcd < r ? xcd * (q + 1) : r * (q + 1) + (xcd - r) * q) + off; }
        const int nig = WGM * nN, gid = wgid / nig, fm = gid * WGM, gsz = (nM - fm) < WGM ? (nM - fm) : WGM;
        u.pm = fm + ((wgid % nig) % gsz); u.pn = (wgid % nig) / gsz; u.boff = 0; u.e = 0; return true;
    }
};
struct FfnOrder {
    StaticOrder so; const PG8_LAS int* tend; unsigned estride;
    __device__ bool next(int i, Unit& u) const {
        if (!so.next(i, u)) return false;
        const int ta = u.pm; int e = 0;
#pragma unroll
        for (int k = 0; k < 7; ++k) e += (ta >= tend[k]) ? 1 : 0;
        u.boff = (unsigned)e * estride; u.e = e; return true;
    }
};

__device__ __forceinline__ unsigned cvt_pk_bf16(float lo, float hi) { unsigned r; asm volatile("v_cvt_pk_bf16_f32 %0, %1, %2" : "=v"(r) : "v"(lo), "v"(hi)); return r; }
__device__ __forceinline__ float bflo(unsigned w) { return __builtin_bit_cast(float, w << 16); }
__device__ __forceinline__ float bfhi(unsigned w) { return __builtin_bit_cast(float, w & 0xffff0000u); }
__device__ __forceinline__ float sigm(float x) { return __builtin_amdgcn_rcpf(1.0f + __expf(-x)); }

struct EpiBf16 {
    static constexpr bool PERM = true; static constexpr int NVM = 16;
    bf16_t* O; int ldc;
    __device__ __forceinline__ void operator()(const f32x4 (&acc)[2][2][4][2], const Unit& u, int wr, int wc, int fr, int fq) const {
        const int row0 = u.pm * BM + wr * 64 + fr; const int col0 = u.pn * BM + wc * 32 + 8 * fq;
#pragma unroll
        for (int ai = 0; ai < 2; ++ai)
#pragma unroll
            for (int m = 0; m < 4; ++m) { bf16_t* rowp = O + (size_t)(row0 + ai * HALF + m * 16) * ldc + col0;
#pragma unroll
                for (int bj = 0; bj < 2; ++bj) { const f32x4 v0 = acc[ai][bj][m][0], v1 = acc[ai][bj][m][1];
                    u32x4 w; w.x = cvt_pk_bf16(v0[0], v0[1]); w.y = cvt_pk_bf16(v0[2], v0[3]); w.z = cvt_pk_bf16(v1[0], v1[1]); w.w = cvt_pk_bf16(v1[2], v1[3]);
                    *(PG8_GAS u32x4*)(rowp + bj * HALF) = w; } }
    }
};
constexpr int SC_OFF = 131072 + 320 + 1024;
__device__ __forceinline__ void stage_row_scales(PG8_LAS unsigned char* lds, const float* rs0, int wid) {
    int ln; asm volatile("v_mbcnt_lo_u32_b32 %0, -1, 0\n\tv_mbcnt_hi_u32_b32 %0, -1, %0" : "=v"(ln));
    const float* p = rs0 + (wid >> 2) * 64 + ln; PG8_LAS unsigned char* d = lds + SC_OFF + wid * 512;
    asm volatile("" ::: "memory");
    __builtin_amdgcn_global_load_lds((const unsigned*)p, (PG8_LAS unsigned*)d, 4, 0, 0);
    __builtin_amdgcn_global_load_lds((const unsigned*)(p + HALF), (PG8_LAS unsigned*)(d + 256), 4, 0, 0);
    asm volatile("" ::: "memory");
}
__device__ __forceinline__ void load_row_scales(PG8_LAS unsigned char* lds, int wid, int fr, float ws, float (&sc)[2][4]) {
    asm volatile("" ::: "memory");
    const PG8_LAS float* sl = (const PG8_LAS float*)(lds + SC_OFF + wid * 512) + fr;
#pragma unroll
    for (int ai = 0; ai < 2; ++ai)
#pragma unroll
        for (int m = 0; m < 4; ++m) sc[ai][m] = sl[ai * 64 + m * 16] * ws;
}
struct EpiI8 {
    static constexpr bool PERM = true, HAS_STAGE = true; static constexpr int NVM = 18;
    bf16_t* O; int ldc; const float* rs; float ws; unsigned char* G8; int ntb;
    static constexpr int GC8 = 2048;
    __device__ __forceinline__ void stage(PG8_LAS unsigned char* lds, const Unit& u, int wid) const { stage_row_scales(lds, rs + u.pm * BM, wid); }
    __device__ __forceinline__ void operator()(const f32x4 (&acc)[2][2][4][2], const Unit& u, int wr, int wc, int fr, int fq, PG8_LAS unsigned char* lds, int wid) const {
        const int row0 = u.pm * BM + wr * 64 + fr;
        float scv[2][4]; load_row_scales(lds, wid, fr, ws, scv);
        if (u.pn < ntb) {
            const int col0 = u.pn * BM + wc * 32 + 8 * fq;
#pragma unroll
            for (int ai = 0; ai < 2; ++ai)
#pragma unroll
                for (int m = 0; m < 4; ++m) { const int row = row0 + ai * HALF + m * 16; const float sc = scv[ai][m]; bf16_t* rowp = O + (size_t)row * ldc + col0;
#pragma unroll
                    for (int bj = 0; bj < 2; ++bj) { const v4i32 a0 = __builtin_bit_cast(v4i32, acc[ai][bj][m][0]), a1 = __builtin_bit_cast(v4i32, acc[ai][bj][m][1]);
                        u32x4 w; w.x = cvt_pk_bf16((float)a0[0] * sc, (float)a0[1] * sc); w.y = cvt_pk_bf16((float)a0[2] * sc, (float)a0[3] * sc); w.z = cvt_pk_bf16((float)a1[0] * sc, (float)a1[1] * sc); w.w = cvt_pk_bf16((float)a1[2] * sc, (float)a1[3] * sc);
                        *(PG8_GAS u32x4*)(rowp + bj * HALF) = w; } }
        } else {
            const int col0 = (u.pn - ntb) * BM + wc * 32 + 8 * fq;
            typedef int i32x2 __attribute__((ext_vector_type(2)));
#pragma unroll
            for (int ai = 0; ai < 2; ++ai)
#pragma unroll
                for (int m = 0; m < 4; ++m) { const int row = row0 + ai * HALF + m * 16; const float sc = scv[ai][m]; unsigned char* rowp = G8 + (size_t)row * GC8 + col0;
#pragma unroll
                    for (int bj = 0; bj < 2; ++bj) { const v4i32 a0 = __builtin_bit_cast(v4i32, acc[ai][bj][m][0]), a1 = __builtin_bit_cast(v4i32, acc[ai][bj][m][1]);
                        int w0 = 0, w1 = 0;
                        w0 = __builtin_amdgcn_cvt_pk_fp8_f32((float)a0[0] * sc, (float)a0[1] * sc, w0, false); w0 = __builtin_amdgcn_cvt_pk_fp8_f32((float)a0[2] * sc, (float)a0[3] * sc, w0, true);
                        w1 = __builtin_amdgcn_cvt_pk_fp8_f32((float)a1[0] * sc, (float)a1[1] * sc, w1, false); w1 = __builtin_amdgcn_cvt_pk_fp8_f32((float)a1[2] * sc, (float)a1[3] * sc, w1, true);
                        *(PG8_GAS i32x2*)(rowp + bj * HALF) = (i32x2){w0, w1}; } }
        }
    }
};
template <bool C, class A, class B> struct PickT { typedef A type; };
template <class A, class B> struct PickT<false, A, B> { typedef B type; };
template <int ADD, bool OUT8 = false, bool IN8 = false> struct EpiGate {
    static constexpr bool PERM = true; static constexpr int NVM = 16;
    const unsigned char* Gt; int ldg; bf16_t* O; int ldc; unsigned char* O8; const unsigned char* A8;
    typedef int i32x2 __attribute__((ext_vector_type(2))); typedef float f32x2v __attribute__((ext_vector_type(2)));
    typedef typename PickT<IN8, i32x2, u32x4>::type TT;
    __device__ __forceinline__ TT ldt(size_t off) const { if constexpr (IN8) return *(const PG8_GAS i32x2*)(A8 + off); else return *(const PG8_GAS u32x4*)(O + off); }
    __device__ __forceinline__ void one(const f32x4 v0, const f32x4 v1, const i32x2 g, const TT t, bf16_t* p, unsigned char* p8) const {
        const f32x2v g01 = __builtin_amdgcn_cvt_pk_f32_fp8(g.x, false), g23 = __builtin_amdgcn_cvt_pk_f32_fp8(g.x, true), g45 = __builtin_amdgcn_cvt_pk_f32_fp8(g.y, false), g67 = __builtin_amdgcn_cvt_pk_f32_fp8(g.y, true);
        float o[8];
        o[0] = sigm(g01.x) * v0[0]; o[1] = sigm(g01.y) * v0[1]; o[2] = sigm(g23.x) * v0[2]; o[3] = sigm(g23.y) * v0[3];
        o[4] = sigm(g45.x) * v1[0]; o[5] = sigm(g45.y) * v1[1]; o[6] = sigm(g67.x) * v1[2]; o[7] = sigm(g67.y) * v1[3];
        if constexpr (ADD != 0 && IN8) { const f32x2v a01 = __builtin_amdgcn_cvt_pk_f32_fp8(t.x, false), a23 = __builtin_amdgcn_cvt_pk_f32_fp8(t.x, true), a45 = __builtin_amdgcn_cvt_pk_f32_fp8(t.y, false), a67 = __builtin_amdgcn_cvt_pk_f32_fp8(t.y, true);
            o[0] = fmaf(a01.x, 0.0625f, o[0]); o[1] = fmaf(a01.y, 0.0625f, o[1]); o[2] = fmaf(a23.x, 0.0625f, o[2]); o[3] = fmaf(a23.y, 0.0625f, o[3]); o[4] = fmaf(a45.x, 0.0625f, o[4]); o[5] = fmaf(a45.y, 0.0625f, o[5]); o[6] = fmaf(a67.x, 0.0625f, o[6]); o[7] = fmaf(a67.y, 0.0625f, o[7]); }
        else if constexpr (ADD != 0) { o[0] += bflo(t.x); o[1] += bfhi(t.x); o[2] += bflo(t.y); o[3] += bfhi(t.y); o[4] += bflo(t.z); o[5] += bfhi(t.z); o[6] += bflo(t.w); o[7] += bfhi(t.w); }
        if constexpr (OUT8) {
            int w0 = 0, w1 = 0;
            w0 = __builtin_amdgcn_cvt_pk_fp8_f32(__builtin_amdgcn_fmed3f(o[0] * 16.0f, -448.0f, 448.0f), __builtin_amdgcn_fmed3f(o[1] * 16.0f, -448.0f, 448.0f), w0, false);
            w0 = __builtin_amdgcn_cvt_pk_fp8_f32(__builtin_amdgcn_fmed3f(o[2] * 16.0f, -448.0f, 448.0f), __builtin_amdgcn_fmed3f(o[3] * 16.0f, -448.0f, 448.0f), w0, true);
            w1 = __builtin_amdgcn_cvt_pk_fp8_f32(__builtin_amdgcn_fmed3f(o[4] * 16.0f, -448.0f, 448.0f), __builtin_amdgcn_fmed3f(o[5] * 16.0f, -448.0f, 448.0f), w1, false);
            w1 = __builtin_amdgcn_cvt_pk_fp8_f32(__builtin_amdgcn_fmed3f(o[6] * 16.0f, -448.0f, 448.0f), __builtin_amdgcn_fmed3f(o[7] * 16.0f, -448.0f, 448.0f), w1, true);
            *(PG8_GAS i32x2*)p8 = (i32x2){w0, w1};
        } else {
        u32x4 w; w.x = cvt_pk_bf16(o[0], o[1]); w.y = cvt_pk_bf16(o[2], o[3]); w.z = cvt_pk_bf16(o[4], o[5]); w.w = cvt_pk_bf16(o[6], o[7]);
        *(PG8_GAS u32x4*)p = w; }
    }
    __device__ __forceinline__ void operator()(const f32x4 (&acc)[2][2][4][2], const Unit& u, int wr, int wc, int fr, int fq) const {
        const int row0 = u.pm * BM + wr * 64 + fr; const int col0 = u.pn * BM + wc * 32 + 8 * fq;
        i32x2 gt[2][4][2]; TT t0[4][2], t1[4][2];
#pragma unroll
        for (int ai = 0; ai < (OUT8 ? 1 : 2); ++ai)
#pragma unroll
            for (int m = 0; m < 4; ++m)
#pragma unroll
                for (int bj = 0; bj < 2; ++bj) { const size_t row = (size_t)(row0 + ai * HALF + m * 16);
                    gt[ai][m][bj] = *(const PG8_GAS i32x2*)(Gt + row * ldg + col0 + bj * HALF);
                    if (ai == 0) { t0[m][bj] = TT{}; if (ADD) t0[m][bj] = ldt(row * ldc + col0 + bj * HALF); } }
#pragma unroll
        for (int m = 0; m < 4; ++m) {
#pragma unroll
            for (int bj = 0; bj < 2; ++bj) { const size_t row = (size_t)(row0 + m * 16); one(acc[0][bj][m][0], acc[0][bj][m][1], gt[0][m][bj], t0[m][bj], O + row * ldc + col0 + bj * HALF, O8 + row * ldc + col0 + bj * HALF); }
#pragma unroll
            for (int bj = 0; bj < 2; ++bj) { const size_t row = (size_t)(row0 + HALF + m * 16); t1[m][bj] = TT{}; if (ADD) t1[m][bj] = ldt(row * ldc + col0 + bj * HALF);
                if (OUT8) gt[1][m][bj] = *(const PG8_GAS i32x2*)(Gt + row * ldg + col0 + bj * HALF); }
            __builtin_amdgcn_sched_barrier(0);
        }
#pragma unroll
        for (int m = 0; m < 4; ++m)
#pragma unroll
            for (int bj = 0; bj < 2; ++bj) { const size_t row = (size_t)(row0 + HALF + m * 16); one(acc[1][bj][m][0], acc[1][bj][m][1], gt[1][m][bj], t1[m][bj], O + row * ldc + col0 + bj * HALF, O8 + row * ldc + col0 + bj * HALF); }
    }
};
struct EpiSwiglu {
    static constexpr bool PERM = true; static constexpr int NVM = 8;
    unsigned char* O; int ldc;
    __device__ __forceinline__ void operator()(const f32x4 (&acc)[2][2][4][2], const Unit& u, int wr, int wc, int fr, int fq) const {
        const int row0 = u.pm * BM + wr * 64 + fr; const int col0 = u.pn * HALF + wc * 32 + 8 * fq;
#pragma unroll
        for (int ai = 0; ai < 2; ++ai)
#pragma unroll
            for (int m = 0; m < 4; ++m) { unsigned char* rowp = O + (size_t)(row0 + ai * HALF + m * 16) * ldc + col0;
                float o[8];
#pragma unroll
                for (int n = 0; n < 2; ++n)
#pragma unroll
                    for (int k = 0; k < 4; ++k) { const float g = acc[ai][0][m][n][k], up = acc[ai][1][m][n][k]; o[n * 4 + k] = g * sigm(g) * up; }
                int w0 = 0, w1 = 0;
                w0 = __builtin_amdgcn_cvt_pk_fp8_f32(o[0], o[1], w0, false); w0 = __builtin_amdgcn_cvt_pk_fp8_f32(o[2], o[3], w0, true);
                w1 = __builtin_amdgcn_cvt_pk_fp8_f32(o[4], o[5], w1, false); w1 = __builtin_amdgcn_cvt_pk_fp8_f32(o[6], o[7], w1, true);
                typedef int i32x2 __attribute__((ext_vector_type(2)));
                *(PG8_GAS i32x2*)rowp = (i32x2){w0, w1}; }
    }
};

__device__ __forceinline__ v8i32 cat8(bf16x8 a, bf16x8 b) { return __builtin_shufflevector(__builtin_bit_cast(v4i32, a), __builtin_bit_cast(v4i32, b), 0, 1, 2, 3, 4, 5, 6, 7); }
constexpr int W8_SHIFT = 8;
constexpr int W8_SCALE = (127 - W8_SHIFT / 2) * 0x01010101, ONE_SCALE = W8_SCALE;
template <class E, class = void> struct EpiStage {
    static __device__ __forceinline__ void stage(const E&, PG8_LAS unsigned char*, const Unit&, int) {}
    template <class A> static __device__ __forceinline__ void run(const E& e, const A& acc, const Unit& u, int wr, int wc, int fr, int fq, PG8_LAS unsigned char*, int) { e(acc, u, wr, wc, fr, fq); } };
template <class E> struct EpiStage<E, decltype((void)E::HAS_STAGE)> {
    static __device__ __forceinline__ void stage(const E& e, PG8_LAS unsigned char* lds, const Unit& u, int wid) { e.stage(lds, u, wid); }
    template <class A> static __device__ __forceinline__ void run(const E& e, const A& acc, const Unit& u, int wr, int wc, int fr, int fq, PG8_LAS unsigned char* lds, int wid) { e(acc, u, wr, wc, fr, fq, lds, wid); } };
struct EpiSwigluI8 {
    static constexpr bool PERM = true, HAS_STAGE = true; static constexpr int NVM = 10;
    unsigned char* O; int ldc; const float* rs; const PG8_LAS float* wscL;
    __device__ __forceinline__ void stage(PG8_LAS unsigned char* lds, const Unit& u, int wid) const { stage_row_scales(lds, rs + u.pm * BM, wid); }
    __device__ __forceinline__ void operator()(const f32x4 (&acc)[2][2][4][2], const Unit& u, int wr, int wc, int fr, int fq, PG8_LAS unsigned char* lds, int wid) const {
        const int row0 = u.pm * BM + wr * 64 + fr; const int col0 = u.pn * HALF + wc * 32 + 8 * fq;
        float scv[2][4]; load_row_scales(lds, wid, fr, wscL[u.e], scv);
#pragma unroll
        for (int ai = 0; ai < 2; ++ai)
#pragma unroll
            for (int m = 0; m < 4; ++m) { const int row = row0 + ai * HALF + m * 16; const float sc = scv[ai][m]; unsigned char* rowp = O + (size_t)row * ldc + col0;
                typedef float f32x2v __attribute__((ext_vector_type(2))); typedef int i32x2 __attribute__((ext_vector_type(2)));
                const f32x2v sc2 = (f32x2v){sc, sc}, nl2 = (f32x2v){-1.44269504f, -1.44269504f}, one2 = (f32x2v){1.0f, 1.0f};
                f32x2v o[4];
#pragma unroll
                for (int n = 0; n < 2; ++n) { const v4i32 gi = __builtin_bit_cast(v4i32, acc[ai][0][m][n]), ui = __builtin_bit_cast(v4i32, acc[ai][1][m][n]);
#pragma unroll
                    for (int k = 0; k < 2; ++k) { const f32x2v g = (f32x2v){(float)gi[2 * k], (float)gi[2 * k + 1]} * sc2, up = (f32x2v){(float)ui[2 * k], (float)ui[2 * k + 1]} * sc2;
                        const f32x2v t = g * nl2; const f32x2v d = (f32x2v){__builtin_amdgcn_exp2f(t.x), __builtin_amdgcn_exp2f(t.y)} + one2;
                        o[n * 2 + k] = (g * (f32x2v){__builtin_amdgcn_rcpf(d.x), __builtin_amdgcn_rcpf(d.y)}) * up; } }
                int w0 = 0, w1 = 0;
                w0 = __builtin_amdgcn_cvt_pk_fp8_f32(o[0].x, o[0].y, w0, false); w0 = __builtin_amdgcn_cvt_pk_fp8_f32(o[1].x, o[1].y, w0, true);
                w1 = __builtin_amdgcn_cvt_pk_fp8_f32(o[2].x, o[2].y, w1, false); w1 = __builtin_amdgcn_cvt_pk_fp8_f32(o[3].x, o[3].y, w1, true);
                *(PG8_GAS i32x2*)rowp = (i32x2){w0, w1}; }
    }
};
constexpr int GI_OFF = SC_OFF + 4096;
template <class Epi, class Sched, bool ALIGN_EPI = false, bool SP2 = false, int MODE = 0, bool GATHER = false>
__device__ __forceinline__ void gemm_phase(PG8_LAS unsigned char* lds, const int wv, const Gemm g, const Sched& S, const Epi& E) {
    int tid_ = wv * 64 + lane_id(); asm volatile("" : "+v"(tid_));
    const int tid = tid_, wid = __builtin_amdgcn_readfirstlane(tid >> 6), lane = tid & 63, wr = wid >> 2, wc = wid & 3, fr = lane & 15, fq = lane >> 4;
    constexpr bool FP8 = (MODE == 1), I8 = (MODE == 2);
    int K_ = g.K; asm volatile("" : "+s"(K_)); const int K = K_, nt = K / BK;
    unsigned voffA, voffB;
    { int R, C; stage_rc(tid * 16, R, C); const int Rb = Epi::PERM ? ((R & ~31) + perm32(R & 31)) : R;
        voffA = (unsigned)(R * K + C) * 2u; voffB = (unsigned)(Rb * K + C) * 2u; }
    int gR_, gC_; stage_rc(tid * 16, gR_, gC_); const int gR = gR_; const unsigned gcol = (unsigned)gC_ * 2u, growb = (unsigned)K * 2u;
    unsigned gA0 = 0u, gA1 = 0u, gA2 = 0u, gA3 = 0u;
    const unsigned pstep = 64u * (unsigned)K * 2u;
    const unsigned kstep = (unsigned)(BK * 2);
    const unsigned hstep = (unsigned)HALF * (unsigned)K * 2u;
    const unsigned tstep = 2u * hstep;
    const unsigned ldsw = (unsigned)wid * 1024u;
    const char* const Ab = (const char*)g.A; const char* const Bb = (const char*)g.Bt;
    const int aoff = lds_byte(wr * 64 + fr, fq * 8), boff = lds_byte(wc * 32 + fr, fq * 8);
#define PG8_SA(b, h) (((b) * 2 + (h)) * HTB)
#define PG8_SB(b, h) ((4 + (b) * 2 + (h)) * HTB)
#define PG8_STAGE(bufoff, gbase, uoff, voff) do { _Pragma("unroll") for (int _i = 0; _i < 2; ++_i) \
        __builtin_amdgcn_global_load_lds((const unsigned*)((gbase) + (size_t)(unsigned)(((uoff) + _i * pstep) + (voff))), (PG8_LAS unsigned*)(lds + (bufoff) + ldsw + _i * 8192), 16, 0, 0); } while (0)
#define PG8_STA(bufoff, uoff, h) do { if constexpr (GATHER) { \
        __builtin_amdgcn_global_load_lds((const unsigned*)(Ab + (size_t)(unsigned)((uoff) + ((h) ? gA2 : gA0))), (PG8_LAS unsigned*)(lds + (bufoff) + ldsw), 16, 0, 0); \
        __builtin_amdgcn_global_load_lds((const unsigned*)(Ab + (size_t)(unsigned)((uoff) + ((h) ? gA3 : gA1))), (PG8_LAS unsigned*)(lds + (bufoff) + ldsw + 8192), 16, 0, 0); \
    } else PG8_STAGE(bufoff, Ab, (uoff) + ((h) ? hstep : 0u), voffA); } while (0)
#define PG8_LDA(dst, b, h) do { _Pragma("unroll") for (int m = 0; m < 4; ++m) { if constexpr (FP8) { dst##8[m] = __builtin_shufflevector(*(const PG8_LAS v4i32*)(lds + PG8_SA(b, h) + aoff + m * 2048), *(const PG8_LAS v4i32*)(lds + PG8_SA(b, h) + aoff + m * 2048 + 1024), 0, 1, 2, 3, 4, 5, 6, 7); } else { \
        _Pragma("unroll") for (int k = 0; k < 2; ++k) dst[m][k] = *(const PG8_LAS bf16x8*)(lds + PG8_SA(b, h) + aoff + m * 2048 + k * 1024); } } } while (0)
#define PG8_LDB(dst, b, h) do { _Pragma("unroll") for (int n = 0; n < 2; ++n) { if constexpr (FP8) { dst##8[n] = __builtin_shufflevector(*(const PG8_LAS v4i32*)(lds + PG8_SB(b, h) + boff + n * 2048), *(const PG8_LAS v4i32*)(lds + PG8_SB(b, h) + boff + n * 2048 + 1024), 0, 1, 2, 3, 4, 5, 6, 7); } else { \
        _Pragma("unroll") for (int k = 0; k < 2; ++k) dst[n][k] = *(const PG8_LAS bf16x8*)(lds + PG8_SB(b, h) + boff + n * 2048 + k * 1024); } } } while (0)
#define PG8_MMA(ai, bj, At, Bt) do { __builtin_amdgcn_s_setprio(1); if constexpr (FP8) { _Pragma("unroll") for (int m = 0; m < 4; ++m) _Pragma("unroll") for (int n = 0; n < 2; ++n) \
        asm volatile("v_mfma_scale_f32_16x16x128_f8f6f4 %0, %1, %2, %0, %3, %3 op_sel:[0,1,0] op_sel_hi:[0,0,0]" : "+v"(acc[ai][bj][m][n]) : "v"(Bt##8[n]), "v"(At##8[m]), "v"(scl8)); } else { \
        _Pragma("unroll") for (int m = 0; m < 4; ++m) _Pragma("unroll") for (int n = 0; n < 2; ++n) _Pragma("unroll") for (int k = 0; k < 2; ++k) { if constexpr (I8) \
        acc[ai][bj][m][n] = __builtin_bit_cast(f32x4, __builtin_amdgcn_mfma_i32_16x16x64_i8(__builtin_bit_cast(v4i32, Bt[n][k]), __builtin_bit_cast(v4i32, At[m][k]), __builtin_bit_cast(v4i32, acc[ai][bj][m][n]), 0, 0, 0)); else \
        acc[ai][bj][m][n] = __builtin_amdgcn_mfma_f32_16x16x32_bf16(Bt[n][k], At[m][k], acc[ai][bj][m][n], 0, 0, 0); } } __builtin_amdgcn_s_setprio(0); } while (0)
#define PG8_MMA_Z(ai, bj, At, Bt) do { __builtin_amdgcn_s_setprio(1); if constexpr (FP8) { _Pragma("unroll") for (int m = 0; m < 4; ++m) _Pragma("unroll") for (int n = 0; n < 2; ++n) \
        asm volatile("v_mfma_scale_f32_16x16x128_f8f6f4 %0, %1, %2, 0, %3, %3 op_sel:[0,1,0] op_sel_hi:[0,0,0]" : "=v"(acc[ai][bj][m][n]) : "v"(Bt##8[n]), "v"(At##8[m]), "v"(scl8)); } else { \
        _Pragma("unroll") for (int m = 0; m < 4; ++m) _Pragma("unroll") for (int n = 0; n < 2; ++n) { if constexpr (I8) { \
        acc[ai][bj][m][n] = __builtin_bit_cast(f32x4, __builtin_amdgcn_mfma_i32_16x16x64_i8(__builtin_bit_cast(v4i32, Bt[n][0]), __builtin_bit_cast(v4i32, At[m][0]), (v4i32){0, 0, 0, 0}, 0, 0, 0)); \
        acc[ai][bj][m][n] = __builtin_bit_cast(f32x4, __builtin_amdgcn_mfma_i32_16x16x64_i8(__builtin_bit_cast(v4i32, Bt[n][1]), __builtin_bit_cast(v4i32, At[m][1]), __builtin_bit_cast(v4i32, acc[ai][bj][m][n]), 0, 0, 0)); } else { \
        acc[ai][bj][m][n] = __builtin_amdgcn_mfma_f32_16x16x32_bf16(Bt[n][0], At[m][0], (f32x4){0.f, 0.f, 0.f, 0.f}, 0, 0, 0); \
        acc[ai][bj][m][n] = __builtin_amdgcn_mfma_f32_16x16x32_bf16(Bt[n][1], At[m][1], acc[ai][bj][m][n], 0, 0, 0); } } } __builtin_amdgcn_s_setprio(0); } while (0)
#define PG8_WAIT_V(n) asm volatile("s_waitcnt vmcnt(" #n ")" ::: "memory")
#define PG8_WAIT_L(n) asm volatile("s_waitcnt lgkmcnt(" #n ")" ::: "memory")
#define PG8_WAIT_VR(rlx) asm volatile("s_cmp_lg_u32 %0, 0\n\ts_cbranch_scc1 1f\n\ts_waitcnt vmcnt(8)\n1:\n\ts_waitcnt vmcnt(%1)" :: "s"(rlx), "n"(8 + Epi::NVM) : "scc", "memory")
#define PG8_BAR __builtin_amdgcn_s_barrier()
#define PG8_SCHED __builtin_amdgcn_sched_barrier(0)
    Unit cur, nxt; int ui = 0;
    if (!S.next(0, cur)) return;
    EpiStage<Epi>::stage(E, lds, cur, wid);
    f32x4 acc[2][2][4][2];
    constexpr bool ZC = SP2 && !GATHER;
    if constexpr (!ZC) {
#pragma unroll
    for (int a = 0; a < 2; ++a)
#pragma unroll
        for (int b = 0; b < 2; ++b)
#pragma unroll
            for (int m = 0; m < 4; ++m)
#pragma unroll
                for (int n = 0; n < 2; ++n) acc[a][b][m][n] = (f32x4){0.f, 0.f, 0.f, 0.f};
    }
    int scl8 = (W8_SCALE & 0xff) | ((g.ascale ? g.ascale : (W8_SCALE & 0xff)) * 0x01010100); asm volatile("" : "+v"(scl8));
    bf16x8 At[4][2], B0[2][2], B1[2][2]; v8i32 At8[4], B08[2], B18[2];
    unsigned cA = GATHER ? 0u : (unsigned)cur.pm * tstep, cB = (unsigned)cur.pn * tstep + cur.boff;
    if constexpr (GATHER) { const int* gp = g.gsrc + cur.pm * BM + gR;
        gA0 = (unsigned)gp[0] * growb + gcol; gA1 = (unsigned)gp[64] * growb + gcol; gA2 = (unsigned)gp[128] * growb + gcol; gA3 = (unsigned)gp[192] * growb + gcol; }
    if constexpr (SP2) {
        PG8_STAGE(PG8_SB(0, 0), Bb, cB, voffB); PG8_STAGE(PG8_SB(0, 1), Bb, cB + hstep, voffB); PG8_STA(PG8_SA(0, 0), cA, 0); PG8_STA(PG8_SA(0, 1), cA, 1);
        if (wr == 1) PG8_BAR;
        PG8_WAIT_V(2); PG8_BAR;
        PG8_STAGE(PG8_SB(1, 0), Bb, cB + kstep, voffB); PG8_STA(PG8_SA(1, 0), cA + kstep, 0); PG8_STAGE(PG8_SB(1, 1), Bb, cB + hstep + kstep, voffB);
        PG8_WAIT_V(6); PG8_BAR;
    } else {
        PG8_STAGE(PG8_SB(0, 0), Bb, cB, voffB); PG8_STA(PG8_SA(0, 0), cA, 0); PG8_STAGE(PG8_SB(0, 1), Bb, cB + hstep, voffB); PG8_STA(PG8_SA(0, 1), cA, 1);
        if (wr == 1) PG8_BAR;
        PG8_WAIT_V(4); PG8_BAR;
        PG8_STAGE(PG8_SB(1, 0), Bb, cB + kstep, voffB); PG8_STA(PG8_SA(1, 0), cA + kstep, 0); PG8_STAGE(PG8_SB(1, 1), Bb, cB + hstep + kstep, voffB);
        PG8_WAIT_V(6); PG8_BAR;
    }
    for (;;) {
        const bool has_next = S.next(ui + 1, nxt);
        const unsigned nA = GATHER ? 0u : (has_next ? (unsigned)nxt.pm * tstep : cA), nB = has_next ? (unsigned)nxt.pn * tstep + nxt.boff : cB;
        if constexpr (GATHER) { if (has_next) {
            const int* gp = g.gsrc + nxt.pm * BM + gR; PG8_LAS unsigned char* d = lds + GI_OFF + wid * 1024;
            asm volatile("" ::: "memory");
            __builtin_amdgcn_global_load_lds((const unsigned*)gp, (PG8_LAS unsigned*)d, 4, 0, 0); __builtin_amdgcn_global_load_lds((const unsigned*)(gp + 64), (PG8_LAS unsigned*)(d + 256), 4, 0, 0);
            __builtin_amdgcn_global_load_lds((const unsigned*)(gp + 128), (PG8_LAS unsigned*)(d + 512), 4, 0, 0); __builtin_amdgcn_global_load_lds((const unsigned*)(gp + 192), (PG8_LAS unsigned*)(d + 768), 4, 0, 0);
            asm volatile("" ::: "memory"); } }
        int t = 0;
        do {
            const bool last = (t == nt - 2);
            const unsigned a1 = cA + (unsigned)(t + 1) * kstep;
            const unsigned a2 = last ? nA : cA + (unsigned)(t + 2) * kstep, b2 = last ? nB : cB + (unsigned)(t + 2) * kstep;
            const unsigned a3 = a2 + kstep, b3 = b2 + kstep;
            if constexpr (SP2) {
            const int rlx = __builtin_amdgcn_readfirstlane(((t == 0) && (ui > 0)) ? 1 : 0);
            PG8_LDB(B0, 0, 0); PG8_LDB(B1, 0, 1); PG8_SCHED; PG8_LDA(At, 0, 0); PG8_STA(PG8_SA(1, 1), a1, 1);
            PG8_WAIT_VR(rlx); PG8_WAIT_L(0); PG8_BAR; if (ZC && t == 0) { PG8_MMA_Z(0, 0, At, B0); PG8_MMA_Z(0, 1, At, B1); } else { PG8_MMA(0, 0, At, B0); PG8_MMA(0, 1, At, B1); } PG8_BAR; PG8_SCHED;
            if constexpr (GATHER) { if (last && has_next) {
                const PG8_LAS unsigned* sl = (const PG8_LAS unsigned*)(lds + GI_OFF + wid * 1024) + lane;
                gA0 = sl[0] * growb + gcol; gA1 = sl[64] * growb + gcol; gA2 = sl[128] * growb + gcol; gA3 = sl[192] * growb + gcol; } }
            PG8_LDA(At, 0, 1); PG8_STAGE(PG8_SB(0, 0), Bb, b2, voffB); PG8_STAGE(PG8_SB(0, 1), Bb, b2 + hstep, voffB); PG8_STA(PG8_SA(0, 0), a2, 0);
            PG8_WAIT_VR(rlx); PG8_WAIT_L(0); PG8_BAR; if (ZC && t == 0) { PG8_MMA_Z(1, 0, At, B0); PG8_MMA_Z(1, 1, At, B1); } else { PG8_MMA(1, 0, At, B0); PG8_MMA(1, 1, At, B1); } PG8_BAR; PG8_SCHED;
            PG8_LDB(B0, 1, 0); PG8_LDB(B1, 1, 1); PG8_SCHED; PG8_LDA(At, 1, 0); PG8_STA(PG8_SA(0, 1), a2, 1);
            PG8_WAIT_V(8); PG8_WAIT_L(0); PG8_BAR; PG8_MMA(0, 0, At, B0); PG8_MMA(0, 1, At, B1); PG8_BAR; PG8_SCHED;
            PG8_LDA(At, 1, 1); PG8_STAGE(PG8_SB(1, 0), Bb, b3, voffB); PG8_STAGE(PG8_SB(1, 1), Bb, b3 + hstep, voffB); PG8_STA(PG8_SA(1, 0), a3, 0);
            PG8_WAIT_V(8); PG8_WAIT_L(0); PG8_BAR; PG8_MMA(1, 0, At, B0); PG8_MMA(1, 1, At, B1); PG8_BAR; PG8_SCHED;
            } else {
            PG8_LDB(B0, 0, 0); PG8_SCHED; PG8_LDA(At, 0, 0); PG8_STA(PG8_SA(1, 1), a1, 1);
            PG8_WAIT_L(8); PG8_BAR; PG8_WAIT_L(0); PG8_MMA(0, 0, At, B0); PG8_BAR; PG8_SCHED;
            PG8_LDB(B1, 0, 1); PG8_STAGE(PG8_SB(0, 0), Bb, b2, voffB);
            PG8_BAR; PG8_WAIT_L(0); PG8_MMA(0, 1, At, B1); PG8_BAR;
            PG8_LDA(At, 0, 1); PG8_STA(PG8_SA(0, 0), a2, 0);
            PG8_BAR; PG8_WAIT_L(0); PG8_MMA(1, 0, At, B0); PG8_BAR; PG8_SCHED;
            PG8_STAGE(PG8_SB(0, 1), Bb, b2 + hstep, voffB);
            PG8_WAIT_V(6); PG8_BAR; PG8_MMA(1, 1, At, B1); PG8_BAR;
            PG8_LDB(B0, 1, 0); PG8_SCHED; PG8_LDA(At, 1, 0); PG8_STA(PG8_SA(0, 1), a2, 1);
            PG8_WAIT_L(8); PG8_BAR; PG8_WAIT_L(0); PG8_MMA(0, 0, At, B0); PG8_BAR; PG8_SCHED;
            PG8_LDB(B1, 1, 1); PG8_STAGE(PG8_SB(1, 0), Bb, b3, voffB);
            PG8_BAR; PG8_WAIT_L(0); PG8_MMA(0, 1, At, B1); PG8_BAR;
            PG8_LDA(At, 1, 1); PG8_STA(PG8_SA(1, 0), a3, 0);
            PG8_BAR; PG8_WAIT_L(0); PG8_MMA(1, 0, At, B0); PG8_BAR; PG8_SCHED;
            PG8_STAGE(PG8_SB(1, 1), Bb, b3 + hstep, voffB);
            PG8_WAIT_V(6); PG8_BAR; PG8_MMA(1, 1, At, B1); PG8_BAR;
            }
            t += 2;
        } while (t < nt);
        if constexpr (FP8) asm volatile("s_nop 15\n\ts_nop 15" ::: "memory");
        if constexpr (ALIGN_EPI) { if (wr == 0) PG8_BAR; }
        { int l2 = lane; asm volatile("" : "+v"(l2)); EpiStage<Epi>::run(E, acc, cur, wr, wc, l2 & 15, l2 >> 4, lds, wid); }
        if (!has_next) break;
        if constexpr (!ZC) {
#pragma unroll
        for (int a = 0; a < 2; ++a)
#pragma unroll
            for (int b = 0; b < 2; ++b)
#pragma unroll
                for (int m = 0; m < 4; ++m)
#pragma unroll
                    for (int n = 0; n < 2; ++n) acc[a][b][m][n] = (f32x4){0.f, 0.f, 0.f, 0.f};
        }
        cur = nxt; cA = nA; cB = nB; ++ui; EpiStage<Epi>::stage(E, lds, cur, wid);
        if constexpr (ALIGN_EPI) { if (wr == 1) PG8_BAR; }
    }
    PG8_WAIT_V(0);
    if constexpr (!ALIGN_EPI) { if (wr == 0) PG8_BAR; }
    PG8_BAR;
#undef PG8_SA
#undef PG8_SB
#undef PG8_STAGE
#undef PG8_LDA
#undef PG8_LDB
#undef PG8_MMA
#undef PG8_WAIT_V
#undef PG8_WAIT_L
#undef PG8_WAIT_VR
#undef PG8_BAR
#undef PG8_SCHED
}
}

constexpr int BATCH = 16, SEQ = 2048, DM = 1024, T = BATCH * SEQ, DEPTH = 2;
constexpr int NCOL = 7424, FF = 2816, NEXP = 8;
constexpr int OFF_QA = 0, OFF_KA = 768, OFF_VA = 1536, OFF_QR = 2304, OFF_KR = 2816, OFF_VR = 3328, OFF_GR = 4352, OFF_GA = 5376, OFF_GT = 6400;
constexpr int PCOL = 5376, GCOL = 2048;
constexpr int CB = 8, TC = CB * SEQ, NCH = BATCH / CB;
constexpr float EPS = 1e-6f;
constexpr int NWAVES = 8;

constexpr size_t MiB = 1u << 20;
constexpr size_t WS_CTL = 0, CTL_ZERO_BYTES = 1 * MiB;
constexpr size_t WS_MOD = 1 * MiB;
constexpr size_t WS_ROPE = 2 * MiB;
constexpr size_t WS_ROUTEA = 3 * MiB;
constexpr size_t WS_SRC = 3 * MiB + 512 * 1024;
constexpr size_t WS_ROUTEB = 4 * MiB;
constexpr size_t WS_ROUTEP = 4 * MiB + 512 * 1024;
constexpr size_t WS_WSCF = 5 * MiB + 160 * 1024;
constexpr size_t WS_RSS = 5 * MiB + 512 * 1024;
constexpr size_t WS_WSC = 5 * MiB + 128 * 1024;
constexpr size_t WS_RS = 5 * MiB + 256 * 1024;
constexpr size_t WS_BBASE = 5 * MiB;
constexpr size_t WS_WM = 6 * MiB;
constexpr size_t WM_WIN = 0, WM_WA = (size_t)NCOL * DM, WM_WR = WM_WA + (size_t)DM * 256 * 2, WM_WMIX = WM_WR + (size_t)DM * DM * 2, WM_END = WM_WMIX + (size_t)DM * DM * 2;
static_assert(WM_END <= 12 * MiB, "mixer weights");
constexpr size_t WS_WF = 18 * MiB;
constexpr size_t WF_GU = (size_t)2 * FF * DM, WF_D = (size_t)DM * FF, WF_E = WF_GU + WF_D;
static_assert(NEXP * WF_E <= 66 * MiB, "ffn weights");
constexpr size_t WS_H = 84 * MiB;
constexpr size_t WS_BIG = 116 * MiB;
constexpr size_t WS_XB = WS_BIG;
constexpr size_t WS_Y = WS_BIG + 64 * MiB;
constexpr size_t WS_RET = WS_Y;
constexpr size_t WS_PROJ = WS_BIG + 128 * MiB;
constexpr size_t WS_MRG = WS_PROJ;
constexpr size_t WS_G8 = WS_BIG + 296 * MiB;
constexpr size_t WS_OG = WS_BIG + 360 * MiB;
constexpr size_t OGR_B = 5 * MiB / 2;
constexpr size_t RPT_OFF = 3 * MiB / 2;
constexpr size_t WS_MRG8 = WS_OG;
constexpr size_t WS_LSE = WS_BIG + 400 * MiB;
constexpr size_t WS_ATT = WS_BIG + 401 * MiB;
constexpr size_t WS_YS = WS_BIG + 64 * MiB;
constexpr size_t WS_SORT = WS_BIG + 64 * MiB;
constexpr size_t WS_U = WS_BIG + 196 * MiB;
constexpr size_t WS_END = WS_BIG + 417 * MiB;
static_assert((size_t)TC * PCOL * 2 <= 168 * MiB && (size_t)T * GCOL <= 64 * MiB && (size_t)264 * 256 * 1024 * 2 <= 132 * MiB && (size_t)264 * 256 * FF <= 182 * MiB && (size_t)3 * TC * 256 * 2 <= 24 * MiB && (size_t)CB * 8 * 16 * 8192 * 2 <= 16 * MiB && (size_t)T * DM * 2 <= 168 * MiB && (size_t)T * 256 * 2 <= 16 * MiB, "big map");

constexpr int CW_TMO = 0;
constexpr int CW_FMAX = 96;
constexpr int CW_WMAX = 80;
constexpr int CW_ECNT = 64;
constexpr int CW_RANK = 1024;
constexpr int CW_LBAR = 2048;
constexpr int CW_BAR = 4096;

constexpr int RING_BYTES = 131072;
constexpr int LDSCTL_OFF = RING_BYTES, MISC_OFF = LDSCTL_OFF + 320;
constexpr int LDS_BYTES = 147456;

#define GAS __attribute__((address_space(1)))
#define LAS __attribute__((address_space(3)))
typedef unsigned short bf16;
typedef unsigned v4u __attribute__((ext_vector_type(4)));
typedef unsigned v2u __attribute__((ext_vector_type(2)));
typedef int v4i __attribute__((ext_vector_type(4)));
typedef int v2i __attribute__((ext_vector_type(2)));
typedef float f32x4 __attribute__((ext_vector_type(4)));
typedef float f32x2 __attribute__((ext_vector_type(2)));
typedef short bf16x8 __attribute__((ext_vector_type(8)));
typedef short bf16x4 __attribute__((ext_vector_type(4)));
typedef GAS unsigned gu32;
#define RLX_AGENT __ATOMIC_RELAXED, __HIP_MEMORY_SCOPE_AGENT
#define LDS_WAIT() asm volatile("s_waitcnt lgkmcnt(0)" ::: "memory")
__device__ __forceinline__ unsigned f2bf(float f) { unsigned u = __builtin_bit_cast(unsigned, f); return (u + 0x7fffu + ((u >> 16) & 1u)) >> 16; }
__device__ __forceinline__ unsigned pk2(float lo, float hi) { return f2bf(lo) | (f2bf(hi) << 16); }
__device__ __forceinline__ float bflo(unsigned w) { return __builtin_bit_cast(float, w << 16); }
__device__ __forceinline__ float bfhi(unsigned w) { return __builtin_bit_cast(float, w & 0xffff0000u); }
__device__ __forceinline__ float bf2f(bf16 b) { return __builtin_bit_cast(float, (unsigned)b << 16); }

#define XB_TMO      128
#define XB_XCNT(j)  (256  + 64 * (j))
#define XB_XSUB(j)  (1280 + 64 * (j))
#define XB_XGEN(j)  (2304 + 64 * (j))
#define XB_TOP      3328
#define XB_TOPGEN   3392
#define XCD_BAR_WORDS 3456
#define XB_SPIN_CAP (1u << 22)

__device__ __forceinline__ unsigned xb_ld(unsigned* p)              { return __hip_atomic_load(p, __ATOMIC_RELAXED, __HIP_MEMORY_SCOPE_AGENT); }
__device__ __forceinline__ unsigned xb_add(unsigned* p, unsigned v) { return __hip_atomic_fetch_add(p, v, __ATOMIC_RELAXED, __HIP_MEMORY_SCOPE_AGENT); }
__device__ __forceinline__ unsigned xb_xcc_id() { return (unsigned)__builtin_amdgcn_s_getreg((3 << 11) | 20) & 0xFu; }
#define XB_SPIN(cond, bar) do { unsigned _sp = 0; while (cond) { __builtin_amdgcn_s_sleep(1); \
    if ((++_sp & 255u) == 0u) { if (xb_ld(&(bar)[XB_TMO])) break; if (_sp > XB_SPIN_CAP) { atomicAdd(&(bar)[XB_TMO], 1u); break; } } } } while (0)

struct XcdBarrier { unsigned* bar; unsigned x; volatile LAS unsigned* st; int wv; };

__device__ __forceinline__ XcdBarrier xcd_barrier_post(unsigned* bar, volatile LAS unsigned* st, int wv) {
    XcdBarrier b; b.bar = bar; b.x = xb_xcc_id(); b.st = st; b.wv = wv;
    if (wv == 0 && lane_id() == 0) (void)xb_add(&bar[XB_XCNT(b.x)], 1u);
    return b;
}
__device__ __forceinline__ void xcd_barrier_complete(unsigned* bar, unsigned x, unsigned& nloc, unsigned& nx) {
    const unsigned G = gridDim.x * gridDim.y * gridDim.z;
    unsigned sum, cnt, mine, sp = 0u;
    for (;;) {
        sum = 0u; cnt = 0u; mine = 0u;
#pragma unroll
        for (unsigned j = 0; j < 16; ++j) { const unsigned c = xb_ld(&bar[XB_XCNT(j)]); sum += c; cnt += (c > 0u) ? 1u : 0u; mine = (j == x) ? c : mine; }
        if (sum == G) break;
        __builtin_amdgcn_s_sleep(1);
        if ((++sp & 255u) == 0u) { if (xb_ld(&bar[XB_TMO])) break; if (sp > XB_SPIN_CAP) { atomicAdd(&bar[XB_TMO], 1u); break; } }
    }
    nloc = mine > 0u ? mine : 1u; nx = cnt > 0u ? cnt : 1u;
}
constexpr int PF_JUNK_OFF = 144704;
__device__ __forceinline__ void code_prefetch(LAS unsigned char* lds, int wv) {
    if (wv == 1) {
        unsigned long long pc; asm volatile("s_getpc_b64 %0" : "=s"(pc));
        const unsigned char* p = (const unsigned char*)(pc & ~63ull) + (size_t)lane_id() * 64;
        asm volatile("" ::: "memory");
#pragma unroll
        for (int k = 0; k < 12; ++k) __builtin_amdgcn_global_load_lds((const unsigned*)(p + k * 4096), (LAS unsigned*)(lds + PF_JUNK_OFF), 4, 0, 0);
        asm volatile("" ::: "memory");
    }
}
__device__ __forceinline__ void xcd_barrier(const XcdBarrier& b, LAS unsigned char* lds) {
    asm volatile("s_waitcnt vmcnt(0)" ::: "memory");
    __syncthreads();
    code_prefetch(lds, b.wv);
    if (b.wv == 0 && lane_id() == 0) {
        unsigned* bar = b.bar;
        __builtin_amdgcn_s_waitcnt(0);
        unsigned nloc = b.st[0], nx = b.st[1];
        if (nloc == 0u) { xcd_barrier_complete(bar, b.x, nloc, nx); b.st[0] = nloc; b.st[1] = nx; }
        const unsigned old = xb_add(&bar[XB_XSUB(b.x)], 1u);
        const unsigned gen = old / nloc;
        if (old + 1u == (gen + 1u) * nloc) {
            __builtin_amdgcn_fence(__ATOMIC_RELEASE, "agent");
            asm volatile("s_waitcnt vmcnt(0)" ::: "memory");
            const unsigned og = xb_add(&bar[XB_TOP], 1u);
            const unsigned tg = og / nx;
            if (og + 1u == (tg + 1u) * nx) xb_add(&bar[XB_TOPGEN], 1u);
            else XB_SPIN(xb_ld(&bar[XB_TOPGEN]) == tg, bar);
            __builtin_amdgcn_fence(__ATOMIC_ACQUIRE, "agent");
            xb_add(&bar[XB_XGEN(b.x)], 1u);
            asm volatile("s_waitcnt vmcnt(0)" ::: "memory");
        } else {
            XB_SPIN(xb_ld(&bar[XB_XGEN(b.x)]) == gen, bar);
            __builtin_amdgcn_fence(__ATOMIC_ACQUIRE, "agent");
            asm volatile("s_waitcnt vmcnt(0)" ::: "memory");
        }
    }
    __syncthreads();
}

__device__ __forceinline__ void xl_barrier(gu32* ctl, unsigned* bar, int xi, int NR, int& gen, int wv, LAS unsigned char* lds) {
    asm volatile("s_waitcnt vmcnt(0)" ::: "memory");
    __syncthreads();
    code_prefetch(lds, wv);
    if (wv == 0 && lane_id() == 0) {
        unsigned* c = (unsigned*)(ctl + CW_LBAR + 64 * xi);
        (void)xb_add(c, 1u);
        const unsigned target = (unsigned)NR * (unsigned)(gen + 1);
        XB_SPIN(xb_ld(c) < target, bar);
        __builtin_amdgcn_fence(__ATOMIC_ACQUIRE, "agent");
        asm volatile("s_waitcnt vmcnt(0)" ::: "memory");
    }
    __syncthreads();
    ++gen;
}

#define DPP_REDUCE(v, OP, IDENT) do { \
        v = OP(v, __builtin_bit_cast(float, __builtin_amdgcn_update_dpp(__builtin_bit_cast(int, v), __builtin_bit_cast(int, v), 0xB1, 0xF, 0xF, false)));    \
        v = OP(v, __builtin_bit_cast(float, __builtin_amdgcn_update_dpp(__builtin_bit_cast(int, v), __builtin_bit_cast(int, v), 0x4E, 0xF, 0xF, false)));    \
        v = OP(v, __builtin_bit_cast(float, __builtin_amdgcn_update_dpp(__builtin_bit_cast(int, v), __builtin_bit_cast(int, v), 0x141, 0xF, 0xF, false)));   \
        v = OP(v, __builtin_bit_cast(float, __builtin_amdgcn_update_dpp(__builtin_bit_cast(int, v), __builtin_bit_cast(int, v), 0x140, 0xF, 0xF, false)));   \
        v = OP(v, __builtin_bit_cast(float, __builtin_amdgcn_update_dpp(__builtin_bit_cast(int, (float)(IDENT)), __builtin_bit_cast(int, v), 0x142, 0xA, 0xF, false)));   \
        v = OP(v, __builtin_bit_cast(float, __builtin_amdgcn_update_dpp(__builtin_bit_cast(int, (float)(IDENT)), __builtin_bit_cast(int, v), 0x143, 0xC, 0xF, false)));   \
    } while (0)
__device__ __forceinline__ float dpp_add(float a, float b) { return a + b; }
__device__ __forceinline__ float wave_sum(float v) {
    DPP_REDUCE(v, dpp_add, 0.0f);
    return __builtin_bit_cast(float, __builtin_amdgcn_readlane(__builtin_bit_cast(int, v), 63));
}
__device__ __forceinline__ float wave_max_nonneg(float v) {
    DPP_REDUCE(v, fmaxf, 0.0f);
    return __builtin_bit_cast(float, __builtin_amdgcn_readlane(__builtin_bit_cast(int, v), 63));
}
__device__ __forceinline__ float sq4(f32x4 v) { return (v.x * v.x + v.y * v.y) + (v.z * v.z + v.w * v.w); }
__device__ __forceinline__ float log2_gamma(int h) { return log2f(1.0f - exp2f(-5.0f - (float)h)); }

__device__ __forceinline__ void cvt_item(const float* W, int N, int k0, int n0, bf16* WT, int K, int drow0, LAS float* scr, int lane) {
    float wv[32];
#pragma unroll
    for (int i = 0; i < 32; ++i) { const int kk = 2 * i + (lane >> 5); wv[i] = W[(size_t)(k0 + kk) * N + n0 + (lane & 31)]; }
#pragma unroll
    for (int i = 0; i < 32; ++i) { const int kk = 2 * i + (lane >> 5); scr[kk * 33 + (lane & 31)] = wv[i]; }
    LDS_WAIT(); asm volatile("" ::: "memory");
    const int c = lane & 7;
#pragma unroll
    for (int j = 0; j < 4; ++j) { const int n = (lane >> 3) + 8 * j; const LAS float* s = scr + (8 * c) * 33 + n;
        v4u o; o.x = pk2(s[0 * 33], s[1 * 33]); o.y = pk2(s[2 * 33], s[3 * 33]); o.z = pk2(s[4 * 33], s[5 * 33]); o.w = pk2(s[6 * 33], s[7 * 33]);
        *(GAS v4u*)(WT + (size_t)(drow0 + n) * K + k0 + 8 * c) = o; }
    LDS_WAIT(); asm volatile("" ::: "memory");
}

struct CvtSrc { const float* W; int N, k0, n0; };
__device__ __forceinline__ void cvt_load32(const CvtSrc& c, int lane, float (&wv)[32]) {
#pragma unroll
    for (int i = 0; i < 32; ++i) { const int kk = 2 * i + (lane >> 5); wv[i] = c.W[(size_t)(c.k0 + kk) * c.N + c.n0 + (lane & 31)]; }
}
__device__ __forceinline__ void cvt_item8(const float* W, int N, int k0, int n0, unsigned char* WT, int K, int drow0, LAS float* scr, int lane) {
    float wv[32];
#pragma unroll
    for (int i = 0; i < 32; ++i) { const int kk = 2 * i + (lane >> 5); wv[i] = W[(size_t)(k0 + kk) * N + n0 + (lane & 31)]; }
#pragma unroll
    for (int i = 0; i < 32; ++i) { const int kk = 2 * i + (lane >> 5); scr[kk * 33 + (lane & 31)] = wv[i]; }
    LDS_WAIT(); asm volatile("" ::: "memory");
    const int c = lane & 3; const float sc = (float)(1 << pg8::W8_SHIFT);
#pragma unroll
    for (int j = 0; j < 2; ++j) { const int n = (lane >> 2) + 16 * j; const LAS float* sp = scr + (16 * c) * 33 + n;
        int w[4];
#pragma unroll
        for (int q = 0; q < 4; ++q) { int t = 0; t = __builtin_amdgcn_cvt_pk_fp8_f32(sp[(4 * q + 0) * 33] * sc, sp[(4 * q + 1) * 33] * sc, t, false); t = __builtin_amdgcn_cvt_pk_fp8_f32(sp[(4 * q + 2) * 33] * sc, sp[(4 * q + 3) * 33] * sc, t, true); w[q] = t; }
        *(GAS v4i*)(WT + (size_t)(drow0 + n) * K + k0 + 16 * c) = (v4i){w[0], w[1], w[2], w[3]}; }
    LDS_WAIT(); asm volatile("" ::: "memory");
}
__device__ __forceinline__ void cvt_item8_p(const float (&wv)[32], int k0, unsigned char* WT, int K, int drow0, LAS float* scr, int lane) {
#pragma unroll
    for (int i = 0; i < 32; ++i) { const int kk = 2 * i + (lane >> 5); scr[kk * 33 + (lane & 31)] = wv[i]; }
    LDS_WAIT(); asm volatile("" ::: "memory");
    const int c = lane & 3; const float sc = (float)(1 << pg8::W8_SHIFT);
#pragma unroll
    for (int j = 0; j < 2; ++j) { const int n = (lane >> 2) + 16 * j; const LAS float* sp = scr + (16 * c) * 33 + n;
        int w[4];
#pragma unroll
        for (int q = 0; q < 4; ++q) { int t = 0; t = __builtin_amdgcn_cvt_pk_fp8_f32(sp[(4 * q + 0) * 33] * sc, sp[(4 * q + 1) * 33] * sc, t, false); t = __builtin_amdgcn_cvt_pk_fp8_f32(sp[(4 * q + 2) * 33] * sc, sp[(4 * q + 3) * 33] * sc, t, true); w[q] = t; }
        *(GAS v4i*)(WT + (size_t)(drow0 + n) * K + k0 + 16 * c) = (v4i){w[0], w[1], w[2], w[3]}; }
    LDS_WAIT(); asm volatile("" ::: "memory");
}

__device__ __forceinline__ void cvt_item_i8(const float* W, int N, int k0, int n0, signed char* WT, int K, int drow0, float q, LAS float* scr, int lane) {
    float wv[32];
#pragma unroll
    for (int i = 0; i < 32; ++i) { const int kk = 2 * i + (lane >> 5); wv[i] = W[(size_t)(k0 + kk) * N + n0 + (lane & 31)]; }
#pragma unroll
    for (int i = 0; i < 32; ++i) { const int kk = 2 * i + (lane >> 5); scr[kk * 33 + (lane & 31)] = wv[i]; }
    LDS_WAIT(); asm volatile("" ::: "memory");
    const int c = lane & 3;
#pragma unroll
    for (int j = 0; j < 2; ++j) { const int n = (lane >> 2) + 16 * j; const LAS float* sp = scr + (16 * c) * 33 + n;
        int w[4];
#pragma unroll
        for (int t = 0; t < 4; ++t) { const int a = __float2int_rn(__builtin_amdgcn_fmed3f(sp[(4 * t + 0) * 33] * q, -127.f, 127.f)), b = __float2int_rn(__builtin_amdgcn_fmed3f(sp[(4 * t + 1) * 33] * q, -127.f, 127.f)), cc = __float2int_rn(__builtin_amdgcn_fmed3f(sp[(4 * t + 2) * 33] * q, -127.f, 127.f)), d = __float2int_rn(__builtin_amdgcn_fmed3f(sp[(4 * t + 3) * 33] * q, -127.f, 127.f));
            w[t] = (int)((unsigned)(a & 255) | ((unsigned)(b & 255) << 8) | ((unsigned)(cc & 255) << 16) | ((unsigned)(d & 255) << 24)); }
        *(GAS v4i*)(WT + (size_t)(drow0 + n) * K + k0 + 16 * c) = (v4i){w[0], w[1], w[2], w[3]}; }
    LDS_WAIT(); asm volatile("" ::: "memory");
}
__device__ __forceinline__ void cvt_item_i8_p(const float (&wv)[32], int k0, signed char* WT, int K, int drow0, float q, LAS float* scr, int lane) {
#pragma unroll
    for (int i = 0; i < 32; ++i) { const int kk = 2 * i + (lane >> 5); scr[kk * 33 + (lane & 31)] = wv[i]; }
    LDS_WAIT(); asm volatile("" ::: "memory");
    const int c = lane & 3;
#pragma unroll
    for (int j = 0; j < 2; ++j) { const int n = (lane >> 2) + 16 * j; const LAS float* sp = scr + (16 * c) * 33 + n;
        int w[4];
#pragma unroll
        for (int t = 0; t < 4; ++t) { const int a = __float2int_rn(__builtin_amdgcn_fmed3f(sp[(4 * t + 0) * 33] * q, -127.f, 127.f)), b = __float2int_rn(__builtin_amdgcn_fmed3f(sp[(4 * t + 1) * 33] * q, -127.f, 127.f)), cc = __float2int_rn(__builtin_amdgcn_fmed3f(sp[(4 * t + 2) * 33] * q, -127.f, 127.f)), d = __float2int_rn(__builtin_amdgcn_fmed3f(sp[(4 * t + 3) * 33] * q, -127.f, 127.f));
            w[t] = (int)((unsigned)(a & 255) | ((unsigned)(b & 255) << 8) | ((unsigned)(cc & 255) << 16) | ((unsigned)(d & 255) << 24)); }
        *(GAS v4i*)(WT + (size_t)(drow0 + n) * K + k0 + 16 * c) = (v4i){w[0], w[1], w[2], w[3]}; }
    LDS_WAIT(); asm volatile("" ::: "memory");
}

struct Args { const float* in[20]; float* out; unsigned char* ws; int lo, hi; };
struct Frame {
    LAS unsigned char* lds;
    gu32* ctl;
    int G, wv;
    int xi, rank;
    int crow;
    __device__ __forceinline__ int NR_() const { return G >> 3; }
    __device__ __forceinline__ int vb_() const { return rank * 8 + xi; }
    __device__ __forceinline__ int vid_() const { return xi * (G >> 3) + rank; }
    float* out; unsigned char* ws;
};
__device__ __forceinline__ void fresh_ids(Frame& F) { int a = __builtin_amdgcn_readfirstlane(F.xi), b = __builtin_amdgcn_readfirstlane(F.rank); asm volatile("" : "+s"(a), "+s"(b)); F.xi = a; F.rank = b; }
enum { I_X = 0, I_C, I_WADA, I_BADA, I_NPM, I_WIN, I_WATT, I_WRET, I_WMIX, I_NPOM, I_NPF, I_WFG, I_WFU, I_WFD, I_WROUT, I_BROUT, I_WEG, I_WEU, I_WED, I_NPOF };

__device__ __forceinline__ void convert_mixer_weights(Frame& F, const Args& A_, int l) {
    int tid_ = F.wv * 64 + lane_id(); asm volatile("" : "+v"(tid_)); const int tid = tid_, lane = tid & 63, wave = __builtin_amdgcn_readfirstlane(tid >> 6), gw = blockIdx.x * NWAVES + wave, NGW = F.G * NWAVES;
    LAS float* scr = (LAS float*)(F.lds + wave * 16384);
    bf16* wm = (bf16*)(F.ws + WS_WM);
    constexpr int I_A = (256 / 64) * (DM / 32), I_R = (DM / 64) * (DM / 32), NIT = I_A + 2 * I_R;
    for (int it = gw; it < NIT; it += NGW) {
        int r = it;
        if (r < I_A) { const int nb = DM / 32, kb = r / nb, n0 = (r % nb) * 32; cvt_item(A_.in[I_WATT] + (size_t)l * 256 * DM, DM, kb * 64, n0, (bf16*)((char*)wm + WM_WA), 256, n0, scr, lane); continue; } r -= I_A;
        if (r < I_R) { const int nb = DM / 32, kb = r / nb, n0 = (r % nb) * 32; cvt_item(A_.in[I_WRET] + (size_t)l * DM * DM, DM, kb * 64, n0, (bf16*)((char*)wm + WM_WR), DM, n0, scr, lane); continue; } r -= I_R;
        { const int nb = DM / 32, kb = r / nb, n0 = (r % nb) * 32; cvt_item8(A_.in[I_WMIX] + (size_t)l * DM * DM, DM, kb * 64, n0, (unsigned char*)wm + WM_WMIX, DM, n0, scr, lane); }
    }
}
__device__ __forceinline__ float max4(f32x4 v) { return fmaxf(fmaxf(fabsf(v.x), fabsf(v.y)), fmaxf(fabsf(v.z), fabsf(v.w))); }
__device__ __forceinline__ void absmax_phase(Frame& F, const Args& A_) {
    int tid_ = F.wv * 64 + lane_id(); asm volatile("" : "+v"(tid_)); const int tid = tid_, lane = tid & 63; const int b = blockIdx.x;
    if (F.G >= 256) {
        { constexpr int N4 = DM * NCOL / 4, SL = (N4 + 127) / 128; const int l = b & 1, sl = (b >> 1) & 127;
          if (b < 256) { const f32x4* W = (const f32x4*)(A_.in[I_WIN] + (size_t)l * DM * NCOL); const int end = (sl + 1) * SL < N4 ? (sl + 1) * SL : N4; float mx = 0.f;
            for (int i = sl * SL + tid; i < end; i += 8 * 512) { f32x4 v[8];
#pragma unroll
                for (int u = 0; u < 8; ++u) { const int ii = i + u * 512; v[u] = W[ii < end ? ii : i]; }
#pragma unroll
                for (int u = 0; u < 8; ++u) mx = fmaxf(mx, max4(v[u])); }
            mx = wave_max_nonneg(mx);
            if (lane == 0) __hip_atomic_fetch_max((unsigned*)(F.ctl + CW_WMAX + l), __builtin_bit_cast(unsigned, mx), RLX_AGENT); } }
        { constexpr int NH = 128 * FF / 4, N4 = 2 * NH, NS = 28, SL = (N4 + NS - 1) / NS; const int t = b % 9, sl = b / 9;
          if (sl < NS) { const f32x4* Wg = (const f32x4*)(t == 0 ? A_.in[I_WFG] : A_.in[I_WEG] + (size_t)(t - 1) * DM * FF); const f32x4* Wu = (const f32x4*)(t == 0 ? A_.in[I_WFU] : A_.in[I_WEU] + (size_t)(t - 1) * DM * FF);
            const int end = (sl + 1) * SL < N4 ? (sl + 1) * SL : N4; float mx = 0.f;
            for (int i = sl * SL + tid; i < end; i += 4 * 512) { f32x4 v[4];
#pragma unroll
                for (int u = 0; u < 4; ++u) { int ii = i + u * 512; if (ii >= end) ii = i; v[u] = ii < NH ? Wg[ii] : Wu[ii - NH]; }
#pragma unroll
                for (int u = 0; u < 4; ++u) mx = fmaxf(mx, max4(v[u])); }
            mx = wave_max_nonneg(mx);
            if (lane == 0) __hip_atomic_fetch_max((unsigned*)(F.ctl + CW_FMAX + t), __builtin_bit_cast(unsigned, mx), RLX_AGENT); } }
    } else {
        for (int l = 0; l < DEPTH; ++l) { constexpr int N4 = DM * NCOL / 4; const f32x4* W = (const f32x4*)(A_.in[I_WIN] + (size_t)l * DM * NCOL); float mx = 0.f;
            for (int i = b * 512 + tid; i < N4; i += F.G * 512) mx = fmaxf(mx, max4(W[i]));
            mx = wave_max_nonneg(mx);
            if (lane == 0) __hip_atomic_fetch_max((unsigned*)(F.ctl + CW_WMAX + l), __builtin_bit_cast(unsigned, mx), RLX_AGENT); }
        for (int t = 0; t < 9; ++t) { constexpr int NH = 128 * FF / 4; const f32x4* Wg = (const f32x4*)(t == 0 ? A_.in[I_WFG] : A_.in[I_WEG] + (size_t)(t - 1) * DM * FF); const f32x4* Wu = (const f32x4*)(t == 0 ? A_.in[I_WFU] : A_.in[I_WEU] + (size_t)(t - 1) * DM * FF); float mx = 0.f;
            for (int i = b * 512 + tid; i < NH; i += F.G * 512) mx = fmaxf(mx, fmaxf(max4(Wg[i]), max4(Wu[i])));
            mx = wave_max_nonneg(mx);
            if (lane == 0) __hip_atomic_fetch_max((unsigned*)(F.ctl + CW_FMAX + t), __builtin_bit_cast(unsigned, mx), RLX_AGENT); }
    }
}
__device__ __forceinline__ void convert_win(Frame& F, const Args& A_, int l) {
    int tid_ = F.wv * 64 + lane_id(); asm volatile("" : "+v"(tid_)); const int tid = tid_, lane = tid & 63, wave = __builtin_amdgcn_readfirstlane(tid >> 6), gw = blockIdx.x * NWAVES + wave, NGW = F.G * NWAVES;
    LAS float* scr = (LAS float*)(F.lds + wave * 16384);
    const float mx = fmaxf(__builtin_bit_cast(float, __hip_atomic_load((unsigned*)(F.ctl + CW_WMAX + l), RLX_AGENT)), 1e-30f);
    const float q = 127.0f / mx;
    if (blockIdx.x == 0 && tid == 0) ((float*)(F.ws + WS_WSC))[l] = mx * (1.0f / 127.0f);
    constexpr int I_IN = (DM / 64) * (NCOL / 32);
    for (int it = gw; it < I_IN; it += NGW) { const int nb = NCOL / 32, kb = it / nb, n0 = (it % nb) * 32;
        cvt_item_i8(A_.in[I_WIN] + (size_t)l * DM * NCOL, NCOL, kb * 64, n0, (signed char*)(F.ws + WS_WM + WM_WIN), DM, n0, q, scr, lane); }
}
__device__ __forceinline__ void convert_ffn_weights(Frame& F, const float* wg, const float* wu, const float* wd, int tmax0, int it_lo, int it_hi, int gwi, int ngw) {
    int tid_ = F.wv * 64 + lane_id(); asm volatile("" : "+v"(tid_)); const int tid = tid_, lane = tid & 63, wave = __builtin_amdgcn_readfirstlane(tid >> 6);
    LAS float* scr = (LAS float*)(F.lds + wave * 16384);
    constexpr int I_G = (DM / 64) * (FF / 32), I_D = (FF / 64) * (DM / 32), PER = 2 * I_G + I_D;
    auto src_of = [&](int it) -> CvtSrc { const int e = it / PER; int r = it % PER;
        if (r < 2 * I_G) { const int up = r >= I_G; if (up) r -= I_G; const int nb = FF / 32, kb = r / nb, n0 = (r % nb) * 32; return CvtSrc{(up ? wu : wg) + (size_t)e * DM * FF, FF, kb * 64, n0}; }
        r -= 2 * I_G; const int nb = DM / 32, kb = r / nb, n0 = (r % nb) * 32; return CvtSrc{wd + (size_t)e * FF * DM, DM, kb * 64, n0}; };
    auto process = [&](int it, const float (&wv)[32]) { const int e = it / PER; int r = it % PER;
        unsigned char* wgu_t = F.ws + WS_WF + (size_t)e * WF_E; unsigned char* wd_t = wgu_t + WF_GU;
        if (r < 2 * I_G) { const int up = r >= I_G; if (up) r -= I_G; const int nb = FF / 32, kb = r / nb, n0 = (r % nb) * 32;
            const float mx = 1.25f * fmaxf(__builtin_bit_cast(float, __hip_atomic_load((unsigned*)(F.ctl + CW_FMAX + tmax0 + e), RLX_AGENT)), 1e-30f);
            if (r == 0 && !up && lane == 0) ((float*)(F.ws + WS_WSCF))[e] = mx * (1.0f / 127.0f);
            cvt_item_i8_p(wv, kb * 64, (signed char*)wgu_t, DM, (n0 >> 7) * 256 + (n0 & 127) + (up ? 128 : 0), 127.0f / mx, scr, lane); return; }
        r -= 2 * I_G;
        { const int nb = DM / 32, kb = r / nb, n0 = (r % nb) * 32; cvt_item8_p(wv, kb * 64, wd_t, FF, n0, scr, lane); } };
    float wa[32], wb[32];
    int it = it_lo + gwi;
    if (it < it_hi) cvt_load32(src_of(it), lane, wa);
#pragma nounroll
    for (; it < it_hi; it += 2 * ngw) {
        if (it + ngw < it_hi) cvt_load32(src_of(it + ngw), lane, wb);
        process(it, wa);
        if (it + ngw < it_hi) {
            if (it + 2 * ngw < it_hi) cvt_load32(src_of(it + 2 * ngw), lane, wa);
            process(it + ngw, wb); }
    }
}
constexpr int FFN_ITEMS = 2 * (DM / 64) * (FF / 32) + (FF / 64) * (DM / 32);

__device__ __forceinline__ void adaln_phase(Frame& F, const Args& A_) {
    int tid_ = F.wv * 64 + lane_id(); asm volatile("" : "+v"(tid_)); const int tid = tid_, lane = tid & 63, wave = __builtin_amdgcn_readfirstlane(tid >> 6), gw = blockIdx.x * NWAVES + wave, NGW = F.G * NWAVES; (void)lane; (void)gw; (void)NGW; (void)tid;
    LAS float* cact = (LAS float*)F.lds;
    LAS float* part = (LAS float*)(F.lds + 65536);
    const float* c = A_.in[I_C];
    for (int i = tid; i < BATCH * DM; i += 512) { const float v = c[i]; cact[i] = v / (1.0f + __expf(-v)); }
    __syncthreads();
    float* mod = (float*)(F.ws + WS_MOD);
    for (int item = blockIdx.x; item < DEPTH * 96; item += F.G) {
        const int l = item / 96, n0 = (item % 96) * 64, n = n0 + lane;
        const float* W = A_.in[I_WADA] + (size_t)l * DM * 6 * DM;
        float acc[16];
#pragma unroll
        for (int b = 0; b < 16; ++b) acc[b] = 0.f;
        const int kb = wave * 128;
        float wn[16];
#pragma unroll
        for (int i = 0; i < 16; ++i) wn[i] = W[(size_t)(kb + i) * 6144 + n];
#pragma nounroll
        for (int k = kb; k < kb + 128; k += 16) {
            float wv[16];
#pragma unroll
            for (int i = 0; i < 16; ++i) wv[i] = wn[i];
            if (k + 16 < kb + 128) {
#pragma unroll
                for (int i = 0; i < 16; ++i) wn[i] = W[(size_t)(k + 16 + i) * 6144 + n];
            }
#pragma unroll
            for (int q = 0; q < 4; ++q)
#pragma unroll
                for (int b = 0; b < 16; ++b) { const f32x4 cv = *(const LAS f32x4*)(cact + b * DM + k + 4 * q); acc[b] += (cv.x * wv[4 * q] + cv.y * wv[4 * q + 1]) + (cv.z * wv[4 * q + 2] + cv.w * wv[4 * q + 3]); }
        }
#pragma unroll
        for (int b = 0; b < 16; ++b) part[(wave * 16 + b) * 64 + lane] = acc[b];
        __syncthreads();
        for (int o = tid; o < 1024; o += 512) { const int b = o >> 6, nn = o & 63; float s = 0.f;
#pragma unroll
            for (int w = 0; w < 8; ++w) s += part[(w * 16 + b) * 64 + nn];
            mod[((size_t)l * 16 + b) * 6144 + n0 + nn] = s + A_.in[I_BADA][(size_t)l * 6144 + n0 + nn]; }
        __syncthreads();
    }
}
__device__ __forceinline__ void rope_phase(Frame& F) {
    int tid_ = F.wv * 64 + lane_id(); asm volatile("" : "+v"(tid_)); const int tid = tid_, lane = tid & 63, wave = __builtin_amdgcn_readfirstlane(tid >> 6), gw = blockIdx.x * NWAVES + wave, NGW = F.G * NWAVES; (void)lane; (void)gw; (void)NGW; (void)tid;
    float* rope = (float*)(F.ws + WS_ROPE);
    for (int i = blockIdx.x * 512 + tid; i < SEQ * 32; i += F.G * 512) {
        const int pos = i >> 5, k = i & 31;
        const float inv = 1.0f / powf(10000.0f, (float)k / 32.0f);
        const float ang = (float)pos * inv;
        float s, c; sincosf(ang, &s, &c);
        rope[pos * 64 + k] = c; rope[pos * 64 + 32 + k] = s;
    }
}

__device__ __forceinline__ void norm_mod_store(const f32x4 (&v)[4], const float* gain, const float* sc, const float* sh, signed char* orow, float* rsp, int lane) {
    float ss = 0.f;
#pragma unroll
    for (int j = 0; j < 4; ++j) ss += sq4(v[j]);
    const float r = rsqrtf(wave_sum(ss) * (1.0f / DM) + EPS);
    f32x4 o[4]; float mx = 0.f;
#pragma unroll
    for (int j = 0; j < 4; ++j) { const int k = 4 * lane + 256 * j;
        const f32x4 g = *(const f32x4*)(gain + k), s1 = *(const f32x4*)(sc + k), s0 = *(const f32x4*)(sh + k);
        o[j] = (v[j] * r) * g * (s1 + 1.0f) + s0;
        mx = fmaxf(mx, fmaxf(fmaxf(fabsf(o[j].x), fabsf(o[j].y)), fmaxf(fabsf(o[j].z), fabsf(o[j].w)))); }
    mx = wave_max_nonneg(mx);
    mx = fmaxf(mx, 1e-20f);
    const float q = 127.0f / mx;
#pragma unroll
    for (int j = 0; j < 4; ++j) { const int k = 4 * lane + 256 * j;
        const int a = __float2int_rn(o[j].x * q), b = __float2int_rn(o[j].y * q), c = __float2int_rn(o[j].z * q), d = __float2int_rn(o[j].w * q);
        *(unsigned*)(orow + k) = (unsigned)(a & 255) | ((unsigned)(b & 255) << 8) | ((unsigned)(c & 255) << 16) | ((unsigned)(d & 255) << 24); }
    if (lane == 0) *rsp = mx * (1.0f / 127.0f);
}
__device__ __forceinline__ void norm_mod_store_reg(const f32x4 (&v)[4], const f32x4 (&vn)[4], const f32x4 (&vs)[4], signed char* orow, float* rsp, int lane) {
    float ss = 0.f;
#pragma unroll
    for (int j = 0; j < 4; ++j) ss += sq4(v[j]);
    const float r = rsqrtf(wave_sum(ss) * (1.0f / DM) + EPS);
    f32x4 o[4]; float mx = 0.f;
#pragma unroll
    for (int j = 0; j < 4; ++j) { o[j] = (v[j] * r) * vn[j] + vs[j];
        mx = fmaxf(mx, fmaxf(fmaxf(fabsf(o[j].x), fabsf(o[j].y)), fmaxf(fabsf(o[j].z), fabsf(o[j].w)))); }
    mx = wave_max_nonneg(mx);
    mx = fmaxf(mx, 1e-20f);
    const float q = 127.0f / mx;
#pragma unroll
    for (int j = 0; j < 4; ++j) { const int k = 4 * lane + 256 * j;
        const int a = __float2int_rn(o[j].x * q), b = __float2int_rn(o[j].y * q), c = __float2int_rn(o[j].z * q), d = __float2int_rn(o[j].w * q);
        *(unsigned*)(orow + k) = (unsigned)(a & 255) | ((unsigned)(b & 255) << 8) | ((unsigned)(c & 255) << 16) | ((unsigned)(d & 255) << 24); }
    if (lane == 0) *rsp = mx * (1.0f / 127.0f);
}
__device__ __forceinline__ void load_row_bf16(const bf16* row, f32x4 (&v)[4], int lane) {
#pragma unroll
    for (int j = 0; j < 4; ++j) { const v2u w = *(const v2u*)(row + 4 * lane + 256 * j); v[j] = (f32x4){bflo(w.x), bfhi(w.x), bflo(w.y), bfhi(w.y)}; }
}

constexpr int RW = 2;
__device__ __forceinline__ void phase_a(Frame& F, const Args& A_) {
    int tid_ = F.wv * 64 + lane_id(); asm volatile("" : "+v"(tid_)); const int tid = tid_, lane = tid & 63, wave = __builtin_amdgcn_readfirstlane(tid >> 6), gw = blockIdx.x * NWAVES + wave, NGW = F.G * NWAVES;
    const float* mod = (const float*)(F.ws + WS_MOD); signed char* hb = (signed char*)(F.ws + WS_H);
    const int WPB = NGW / BATCH, blw = gw / WPB, wi = gw % WPB, mbase = blw * SEQ, mend = mbase + SEQ;
    if (blw >= BATCH) return;
    const float* mb = mod + (size_t)blw * 6144;
    f32x4 vn[4], vs[4];
#pragma unroll
    for (int j = 0; j < 4; ++j) { const int k = 4 * lane + 256 * j; vn[j] = *(const f32x4*)(A_.in[I_NPM] + k) * (*(const f32x4*)(mb + 1024 + k) + 1.0f); vs[j] = *(const f32x4*)(mb + k); }
    f32x4 nx[RW][4];
#define PA_ISSUE(mm0) do { _Pragma("unroll") for (int r = 0; r < RW; ++r) { const int m = (mm0) + r * WPB < mend ? (mm0) + r * WPB : (mm0); \
        _Pragma("unroll") for (int j = 0; j < 4; ++j) nx[r][j] = *(const f32x4*)(A_.in[I_X] + (size_t)m * DM + 4 * lane + 256 * j); } } while (0)
    if (mbase + wi < mend) PA_ISSUE(mbase + wi);
    for (int m0 = mbase + wi; m0 < mend; m0 += RW * WPB) {
        f32x4 v[RW][4];
#pragma unroll
        for (int r = 0; r < RW; ++r)
#pragma unroll
            for (int j = 0; j < 4; ++j) v[r][j] = nx[r][j];
        if (m0 + RW * WPB < mend) PA_ISSUE(m0 + RW * WPB);
#pragma unroll
        for (int r = 0; r < RW; ++r) { const int m = m0 + r * WPB; if (m < mend) norm_mod_store_reg(v[r], vn, vs, hb + (size_t)m * DM, (float*)(F.ws + WS_RS) + m, lane); }
    }
#undef PA_ISSUE
}

template <bool L0, bool MOE>
__device__ __forceinline__ void phase_h_t(Frame& F, const Args& A_, int l, int ch, int bi, int nb, bool first) {
    constexpr bool moe = MOE;
    int tid_ = F.wv * 64 + lane_id(); asm volatile("" : "+v"(tid_)); const int tid = tid_, lane = tid & 63, wave = __builtin_amdgcn_readfirstlane(tid >> 6), gw = bi * NWAVES + wave, NGW = nb * NWAVES;
    const float* mod = (const float*)(F.ws + WS_MOD) + (size_t)l * 16 * 6144; unsigned char* h8 = F.ws + WS_H;
    const bf16* Y = (const bf16*)(F.ws + WS_Y);
    const float* xin = A_.in[I_X]; bf16* xb = (bf16*)(F.ws + WS_XB);
    LAS float* wr = (LAS float*)F.lds;
    LAS int* cntL = (LAS int*)(F.lds + MISC_OFF + 64);
    if (moe) {
        if (first) for (int i = tid; i < DM * NEXP; i += 512) wr[i] = A_.in[I_WROUT][i];
        if (tid < 8) cntL[tid] = 0;
        __syncthreads();
    }
    const float* gpost = A_.in[I_NPOM] + (size_t)l * DM; const float* gffn = A_.in[I_NPF] + (size_t)l * DM;
    const int WPB = NGW / CB, blw = gw / WPB, wi = gw % WPB, mbase = ch * TC + blw * SEQ, mend = mbase + SEQ;
    const float* mb = mod + (size_t)(ch * CB + blw) * 6144;
    f32x4 vg1[4], vgf[4];
#pragma unroll
    for (int j = 0; j < 4; ++j) { const int k = 4 * lane + 256 * j; vg1[j] = *(const f32x4*)(mb + 2048 + k) * *(const f32x4*)(gpost + k); vgf[j] = *(const f32x4*)(gffn + k) * (*(const f32x4*)(mb + 4096 + k) + 1.0f); }
    v2u ry[RW][4], rx[RW][4]; f32x4 rxf[RW][4];
#define PH_ISSUE(mm0) do { _Pragma("unroll") for (int r = 0; r < RW; ++r) { const int m = (mm0) + r * WPB < mend ? (mm0) + r * WPB : (mm0); \
        _Pragma("unroll") for (int j = 0; j < 4; ++j) { ry[r][j] = *(const v2u*)(Y + (size_t)m * DM + 4 * lane + 256 * j); \
            if (L0) rxf[r][j] = *(const f32x4*)(xin + (size_t)m * DM + 4 * lane + 256 * j); else rx[r][j] = *(const v2u*)(xb + (size_t)m * DM + 4 * lane + 256 * j); } } } while (0)
    constexpr bool PF = !MOE;
    if (PF && mbase + wi < mend) PH_ISSUE(mbase + wi);
    for (int m0 = mbase + wi; m0 < mend; m0 += RW * WPB) {
        const int NGWr = WPB;
        f32x4 y[RW][4], x[RW][4], h[RW][4]; float ss[RW], ss2[RW];
        f32x4 vsh[4];
#pragma unroll
        for (int j = 0; j < 4; ++j) vsh[j] = *(const f32x4*)(mb + 3072 + 4 * lane + 256 * j);
        if (!PF) PH_ISSUE(m0);
#pragma unroll
        for (int r = 0; r < RW; ++r)
#pragma unroll
            for (int j = 0; j < 4; ++j) { const v2u w = ry[r][j]; y[r][j] = (f32x4){bflo(w.x), bfhi(w.x), bflo(w.y), bfhi(w.y)};
                if (L0) x[r][j] = rxf[r][j]; else { const v2u u = rx[r][j]; x[r][j] = (f32x4){bflo(u.x), bfhi(u.x), bflo(u.y), bfhi(u.y)}; } }
        if (PF && m0 + RW * WPB < mend) PH_ISSUE(m0 + RW * WPB);
#pragma unroll
        for (int r = 0; r < RW; ++r) { ss[r] = 0.f;
#pragma unroll
            for (int j = 0; j < 4; ++j) ss[r] += sq4(y[r][j]); }
#pragma unroll
        for (int r = 0; r < RW; ++r) ss[r] = wave_sum(ss[r]);
#pragma unroll
        for (int r = 0; r < RW; ++r) { const int m = m0 + r * NGWr < mend ? m0 + r * NGWr : m0;
            const float rr = rsqrtf(ss[r] * (1.0f / DM) + EPS); ss2[r] = 0.f;
#pragma unroll
            for (int j = 0; j < 4; ++j) { const int k = 4 * lane + 256 * j;
                x[r][j] = x[r][j] + vg1[j] * (y[r][j] * rr);
                if (m0 + r * NGWr < mend) *(v2u*)(xb + (size_t)m * DM + k) = (v2u){pk2(x[r][j].x, x[r][j].y), pk2(x[r][j].z, x[r][j].w)};
                ss2[r] += sq4(x[r][j]); } }
#pragma unroll
        for (int r = 0; r < RW; ++r) ss2[r] = wave_sum(ss2[r]);
#pragma unroll
        for (int r = 0; r < RW; ++r) { const int m = m0 + r * NGWr < mend ? m0 + r * NGWr : m0;
            const float r2 = rsqrtf(ss2[r] * (1.0f / DM) + EPS); float mx = 0.f;
#pragma unroll
            for (int j = 0; j < 4; ++j) {
                h[r][j] = (x[r][j] * r2) * vgf[j] + vsh[j];
                mx = fmaxf(mx, fmaxf(fmaxf(fabsf(h[r][j].x), fabsf(h[r][j].y)), fmaxf(fabsf(h[r][j].z), fabsf(h[r][j].w)))); }
            mx = wave_max_nonneg(mx);
            mx = fmaxf(mx, 1e-20f); const float q = 127.0f / mx;
            if (m0 + r * NGWr < mend) {
#pragma unroll
                for (int j = 0; j < 4; ++j) { const int k = 4 * lane + 256 * j;
                    const int a = __float2int_rn(h[r][j].x * q), b = __float2int_rn(h[r][j].y * q), c = __float2int_rn(h[r][j].z * q), d = __float2int_rn(h[r][j].w * q);
                    *(unsigned*)(h8 + (size_t)m * DM + k) = (unsigned)(a & 255) | ((unsigned)(b & 255) << 8) | ((unsigned)(c & 255) << 16) | ((unsigned)(d & 255) << 24); }
                if (lane == 0) ((float*)(F.ws + WS_RS))[m] = mx * (1.0f / 127.0f); } }
        if (moe) {
            float lg[RW][8];
#pragma unroll
            for (int r = 0; r < RW; ++r) {
#pragma unroll
                for (int e = 0; e < 8; ++e) lg[r][e] = 0.f;
#pragma unroll
                for (int j = 0; j < 4; ++j)
#pragma unroll
                    for (int i = 0; i < 4; ++i) { const int k = 4 * lane + 256 * j + i; const f32x4 wa = *(const LAS f32x4*)(wr + k * 8), wb = *(const LAS f32x4*)(wr + k * 8 + 4); const float hv = h[r][j][i];
                        lg[r][0] += hv * wa.x; lg[r][1] += hv * wa.y; lg[r][2] += hv * wa.z; lg[r][3] += hv * wa.w; lg[r][4] += hv * wb.x; lg[r][5] += hv * wb.y; lg[r][6] += hv * wb.z; lg[r][7] += hv * wb.w; } }
#pragma unroll
            for (int e = 0; e < 8; ++e)
#pragma unroll
                for (int r = 0; r < RW; ++r) lg[r][e] = wave_sum(lg[r][e]) + A_.in[I_BROUT][e];
#pragma unroll
            for (int r = 0; r < RW; ++r) { const int m = m0 + r * NGWr;
                int e1 = 0; float v1 = lg[r][0];
#pragma unroll
                for (int e = 1; e < 8; ++e) if (lg[r][e] > v1) { v1 = lg[r][e]; e1 = e; }
                int e2 = -1; float v2 = -3.0e38f;
#pragma unroll
                for (int e = 0; e < 8; ++e) if (e != e1 && lg[r][e] > v2) { v2 = lg[r][e]; e2 = e; }
                const float p1 = 1.0f / (1.0f + __expf(v2 - v1)), p2 = 1.0f - p1;
                if (lane == 0 && m < mend) {
                    const int lr1 = __hip_atomic_fetch_add(cntL + e1, 1, __ATOMIC_RELAXED, __HIP_MEMORY_SCOPE_WORKGROUP);
                    const int lr2 = __hip_atomic_fetch_add(cntL + e2, 1, __ATOMIC_RELAXED, __HIP_MEMORY_SCOPE_WORKGROUP);
                    *(v4i*)(F.ws + WS_ROUTEA + (size_t)m * 16) = (v4i){e1, lr1, e2, lr2};
                    *(f32x2*)(F.ws + WS_ROUTEP + (size_t)m * 8) = (f32x2){p1, p2};
                } }
        }
    }
#undef PH_ISSUE
    if (moe) {
        __syncthreads();
        if (tid < 8) { const int c = cntL[tid]; const unsigned base = __hip_atomic_fetch_add((unsigned*)(F.ctl + CW_ECNT + tid), (unsigned)c, RLX_AGENT);
            ((int*)(F.ws + WS_BBASE))[(ch * 256 + bi) * 8 + tid] = (int)base; }
    }
}
__device__ __forceinline__ void phase_h(Frame& F, const Args& A_, int l, bool moe, int ch, int bi, int nb, bool first) {
    static_assert(DEPTH == 2, "layer 0 is the dense one and reads the f32 input, layer 1 the MoE one: only those two variants are instantiated");
    (void)moe;
    if (l == 0) phase_h_t<true, false>(F, A_, l, ch, bi, nb, first); else phase_h_t<false, true>(F, A_, l, ch, bi, nb, first);
}
__device__ __forceinline__ void phase_h2(Frame& F, int nb_first, int nb_last) {
    int tid_ = F.wv * 64 + lane_id(); asm volatile("" : "+v"(tid_)); const int tid = tid_;
    LAS int* offL = (LAS int*)(F.lds + MISC_OFF + 96);
    LAS int* bbL = (LAS int*)F.lds;
    for (int i = tid; i < NCH * 256 * 8; i += 512) bbL[i] = ((const int*)(F.ws + WS_BBASE))[i];
    if (tid == 0) { int off = 0;
        for (int e = 0; e < 8; ++e) { const int c = (int)__hip_atomic_load((unsigned*)(F.ctl + CW_ECNT + e), RLX_AGENT); offL[e] = off; off += ((c + 255) >> 8) << 8; } }
    __syncthreads();
    int* src = (int*)(F.ws + WS_SRC); float* rss = (float*)(F.ws + WS_RSS);
    if (blockIdx.x == F.G - 1) {
        for (int e = 0; e < 8; ++e) { const int c = (int)__hip_atomic_load((unsigned*)(F.ctl + CW_ECNT + e), RLX_AGENT), pe = ((c + 255) >> 8) << 8;
            for (int p = c + tid; p < pe; p += 512) { src[offL[e] + p] = 0; rss[offL[e] + p] = 0.f; } } }
    for (int m = (int)blockIdx.x * 512 + tid; m < T; m += F.G * 512) {
        const v4i a = *(const v4i*)(F.ws + WS_ROUTEA + (size_t)m * 16); const float rs = ((const float*)(F.ws + WS_RS))[m];
        const int ch = m / TC, r = m % TC, nb = (ch == NCH - 1) ? nb_last : nb_first, WPB = nb * NWAVES / CB, bi = ((r / SEQ) * WPB + (r % SEQ) % WPB) / NWAVES;
        const int pos1 = offL[a.x] + bbL[(ch * 256 + bi) * 8 + a.x] + a.y, pos2 = offL[a.z] + bbL[(ch * 256 + bi) * 8 + a.z] + a.w;
        *(v2i*)(F.ws + WS_ROUTEB + (size_t)m * 8) = (v2i){pos1, pos2}; rss[pos1] = rs; rss[pos2] = rs; src[pos1] = m; src[pos2] = m;
    }
    __syncthreads();
}
__device__ __forceinline__ void phase_k(Frame& F, const Args& A_, int l, bool moe, int kb) {
    int tid_ = F.wv * 64 + lane_id(); asm volatile("" : "+v"(tid_)); const int tid = tid_, lane = tid & 63, wave = __builtin_amdgcn_readfirstlane(tid >> 6), gw = kb * NWAVES + wave, NGW = F.G * NWAVES;
    const float* mod = (const float*)(F.ws + WS_MOD) + (size_t)l * 16 * 6144; signed char* hb = (signed char*)(F.ws + WS_H);
    const bf16* ys = (const bf16*)(F.ws + WS_YS);
    const float* gpost = A_.in[I_NPOF] + (size_t)l * DM;
    const int WPB = NGW / BATCH, blw = gw / WPB, wi = gw % WPB, mbase = blw * SEQ, mend = mbase + SEQ;
    if (blw >= BATCH) return;
    const float* mb = mod + (size_t)blw * 6144; const float* mb2 = mb + 16 * 6144;
    f32x4 vg2[4], vn[4], vs[4];
#pragma unroll
    for (int j = 0; j < 4; ++j) { const int k = 4 * lane + 256 * j; vg2[j] = *(const f32x4*)(mb + 5120 + k) * *(const f32x4*)(gpost + k);
        if (l + 1 < DEPTH) { vn[j] = *(const f32x4*)(A_.in[I_NPM] + (size_t)(l + 1) * DM + k) * (*(const f32x4*)(mb2 + 1024 + k) + 1.0f); vs[j] = *(const f32x4*)(mb2 + k); } else { vn[j] = vg2[j]; vs[j] = vg2[j]; } }
    v2u rya[RW][4], ryb[RW][4], rxx[RW][4]; v2i npos[RW]; f32x2 np[RW], cp[RW];
#pragma unroll
    for (int r = 0; r < RW; ++r) { npos[r] = (v2i){0, 0}; np[r] = (f32x2){0.f, 0.f}; cp[r] = np[r]; }
#define PK_POS(mm0) do { _Pragma("unroll") for (int r = 0; r < RW; ++r) { const int m = (mm0) + r * WPB < mend ? (mm0) + r * WPB : mbase + wi; \
        npos[r] = *(const v2i*)(F.ws + WS_ROUTEB + (size_t)m * 8); np[r] = *(const f32x2*)(F.ws + WS_ROUTEP + (size_t)m * 8); } } while (0)
#define PK_ROWS(mm0) do { _Pragma("unroll") for (int r = 0; r < RW; ++r) { const int m = (mm0) + r * WPB < mend ? (mm0) + r * WPB : (mm0); \
        _Pragma("unroll") for (int j = 0; j < 4; ++j) { \
            if (moe) { rya[r][j] = *(const v2u*)(ys + (size_t)npos[r].x * DM + 4 * lane + 256 * j); ryb[r][j] = *(const v2u*)(ys + (size_t)npos[r].y * DM + 4 * lane + 256 * j); } \
            else rya[r][j] = *(const v2u*)(ys + (size_t)m * DM + 4 * lane + 256 * j); \
            rxx[r][j] = *(const v2u*)((const bf16*)(F.ws + WS_XB) + (size_t)m * DM + 4 * lane + 256 * j); } cp[r] = np[r]; } } while (0)
    if (mbase + wi < mend) { if (moe) PK_POS(mbase + wi); PK_ROWS(mbase + wi); if (moe) PK_POS(mbase + wi + RW * WPB); }
    for (int m0 = mbase + wi; m0 < mend; m0 += RW * WPB) {
        f32x4 y[RW][4], x[RW][4]; float ss[RW];
#pragma unroll
        for (int r = 0; r < RW; ++r) { const f32x2 p = cp[r];
#pragma unroll
            for (int j = 0; j < 4; ++j) { const v2u a = rya[r][j], u = rxx[r][j];
                if (moe) { const v2u b = ryb[r][j]; y[r][j] = (f32x4){bflo(a.x) * p.x + bflo(b.x) * p.y, bfhi(a.x) * p.x + bfhi(b.x) * p.y, bflo(a.y) * p.x + bflo(b.y) * p.y, bfhi(a.y) * p.x + bfhi(b.y) * p.y}; }
                else y[r][j] = (f32x4){bflo(a.x), bfhi(a.x), bflo(a.y), bfhi(a.y)};
                x[r][j] = (f32x4){bflo(u.x), bfhi(u.x), bflo(u.y), bfhi(u.y)}; } }
        if (m0 + RW * WPB < mend) { PK_ROWS(m0 + RW * WPB); if (moe) PK_POS(m0 + 2 * RW * WPB); }
#pragma unroll
        for (int r = 0; r < RW; ++r) { ss[r] = 0.f;
#pragma unroll
            for (int j = 0; j < 4; ++j) ss[r] += sq4(y[r][j]); }
#pragma unroll
        for (int r = 0; r < RW; ++r) ss[r] = wave_sum(ss[r]);
#pragma unroll
        for (int r = 0; r < RW; ++r) { const int m = m0 + r * WPB; if (m < mend) {
            const float rr = rsqrtf(ss[r] * (1.0f / DM) + EPS);
#pragma unroll
            for (int j = 0; j < 4; ++j) { const int k = 4 * lane + 256 * j;
                x[r][j] = x[r][j] + vg2[j] * (y[r][j] * rr);
                if (l + 1 < DEPTH) *(v2u*)((bf16*)(F.ws + WS_XB) + (size_t)m * DM + k) = (v2u){pk2(x[r][j].x, x[r][j].y), pk2(x[r][j].z, x[r][j].w)};
                else *(f32x4*)(F.out + (size_t)m * DM + k) = x[r][j]; }
            if (l + 1 < DEPTH) norm_mod_store_reg(x[r], vn, vs, hb + (size_t)m * DM, (float*)(F.ws + WS_RS) + m, lane); } }
    }
#undef PK_POS
#undef PK_ROWS
}

typedef short v4s16 __attribute__((ext_vector_type(4)));
__device__ __forceinline__ v2u tr4(const LAS bf16* tile, int stride, int r0, int c0, int fr) {
    const LAS bf16* p = tile + (r0 + (fr >> 2)) * stride + c0 + 4 * (fr & 3);
    return __builtin_bit_cast(v2u, __builtin_amdgcn_ds_read_tr16_b64_v4i16((LAS v4s16*)p));
}
#define LDS_BARRIER() asm volatile("s_waitcnt lgkmcnt(0)\n\ts_barrier" ::: "memory")
struct AttnPre { v4u q[2], k[4], v[4]; };
struct AttnId { int bl, g, h4, dsh, r, nbk, head; };
__device__ __forceinline__ AttnId attn_decode(int uid) {
    AttnId a; a.bl = uid / 192; int rem = uid % 192; a.g = rem >> 6; rem &= 63; a.h4 = rem >> 4; const int blk = rem & 15;
    a.dsh = 2 * a.g; const int d = 1 << a.dsh; a.r = blk & (d - 1); a.nbk = blk >> a.dsh; a.head = a.g * 4 + a.h4; return a;
}
__device__ __forceinline__ void attn_load(Frame& F, int uid, int tid, AttnPre& P) {
    const AttnId a = attn_decode(uid);
    const bf16* proj = (const bf16*)(F.ws + WS_PROJ);
#pragma unroll
    for (int k = 0; k < 2; ++k) { const int it = tid + 512 * k, i = it >> 3, c = it & 7; const size_t row = (size_t)a.bl * SEQ + (((size_t)a.nbk * 128 + i) << a.dsh) + a.r;
        P.q[k] = *(const v4u*)(proj + row * PCOL + OFF_QA + a.head * 64 + c * 8); }
#pragma unroll
    for (int k = 0; k < 4; ++k) { const int it = tid + 512 * k, kj = it >> 3, c = it & 7; const int si = (a.nbk - 1) * 128 + kj;
        P.k[k] = (v4u){0u, 0u, 0u, 0u}; P.v[k] = (v4u){0u, 0u, 0u, 0u};
        if (si >= 0) { const size_t row = (size_t)a.bl * SEQ + ((size_t)si << a.dsh) + a.r; P.k[k] = *(const v4u*)(proj + row * PCOL + OFF_KA + a.head * 64 + c * 8); P.v[k] = *(const v4u*)(proj + row * PCOL + OFF_VA + a.head * 64 + c * 8); } }
}
__device__ __forceinline__ void attn_stage(Frame& F, int tid, const AttnPre& P, bool np) {
    LAS bf16* Qs = (LAS bf16*)F.lds; LAS bf16* Ks = Qs + 128 * 72; LAS bf16* Vs = Ks + 256 * 72;
#pragma unroll
    for (int k = 0; k < 2; ++k) { const int it = tid + 512 * k, i = it >> 3, c = it & 7; *(LAS v4u*)(Qs + i * 72 + c * 8) = P.q[k]; }
#pragma unroll
    for (int k = 0; k < 4; ++k) { const int it = tid + 512 * k, kj = it >> 3, c = it & 7; if (!(np && k < 2)) *(LAS v4u*)(Ks + kj * 72 + c * 8) = P.k[k]; *(LAS v4u*)(Vs + kj * 72 + c * 8) = P.v[k]; }
}
__device__ __forceinline__ void attn_compute(Frame& F, int uid, int tid) {
    const int lane = tid & 63, w = __builtin_amdgcn_readfirstlane(tid >> 6), fr = lane & 15, qq = lane >> 4;
    const AttnId a = attn_decode(uid);
    const float slope_d = exp2f(-8.0f * (float)(a.head + 1) / 12.0f) * (float)(1 << a.dsh);
    const LAS bf16* Qs = (const LAS bf16*)F.lds; const LAS bf16* Ks = Qs + 128 * 72; const LAS bf16* Vs = Ks + 256 * 72;
    bf16x8 qf[2];
#pragma unroll
    for (int ks = 0; ks < 2; ++ks) qf[ks] = *(const LAS bf16x8*)(Qs + (16 * w + fr) * 72 + 32 * ks + 8 * qq);
    const int t0 = (a.nbk == 0) ? 8 - w : 0;
    f32x4 sc[9];
#pragma unroll
    for (int tt = 0; tt < 9; ++tt) { f32x4 acc = (f32x4){0.f, 0.f, 0.f, 0.f};
        if (tt >= t0) {
#pragma unroll
            for (int ks = 0; ks < 2; ++ks) { const bf16x8 av = *(const LAS bf16x8*)(Ks + (16 * (w + tt) + fr) * 72 + 32 * ks + 8 * qq); acc = __builtin_amdgcn_mfma_f32_16x16x32_bf16(av, qf[ks], acc, 0, 0, 0); } }
        sc[tt] = acc; }
    float qk_scale = 0.125f; asm volatile("" : "+s"(qk_scale));
    const int iq = 16 * w + fr; float mx = -3.0e38f;
#pragma unroll
    for (int tt = 0; tt < 9; ++tt) if (tt >= t0) {
#pragma unroll
        for (int i = 0; i < 4; ++i) { const int kj = 16 * (w + tt) + 4 * qq + i; const int dist = 128 + iq - kj; const bool valid = (dist >= 0) && (dist <= 128) && (a.nbk > 0 || kj >= 128);
            const float sv = valid ? __builtin_fmaf(sc[tt][i], qk_scale, -slope_d * (float)dist) : -1.0e30f; sc[tt][i] = sv; mx = fmaxf(mx, sv); } }
    mx = fmaxf(mx, __shfl_xor(mx, 16)); mx = fmaxf(mx, __shfl_xor(mx, 32));
    float sum = 0.f;
#pragma unroll
    for (int tt = 0; tt < 9; ++tt) {
        if (tt >= t0) {
#pragma unroll
            for (int i = 0; i < 4; ++i) { const float p = __expf(sc[tt][i] - mx); sc[tt][i] = p; sum += p; }
        } else sc[tt] = (f32x4){0.f, 0.f, 0.f, 0.f}; }
    sum += __shfl_xor(sum, 16); sum += __shfl_xor(sum, 32);
    const float inv = 1.0f / sum;
    f32x4 oacc[4];
#pragma unroll
    for (int dt = 0; dt < 4; ++dt) oacc[dt] = (f32x4){0.f, 0.f, 0.f, 0.f};
#pragma unroll
    for (int s = 0; s < 5; ++s) if (2 * s + 1 >= t0) {
        v4u pw; pw.x = pk2(sc[2 * s][0] * inv, sc[2 * s][1] * inv); pw.y = pk2(sc[2 * s][2] * inv, sc[2 * s][3] * inv);
        if (s < 4) { pw.z = pk2(sc[2 * s + 1][0] * inv, sc[2 * s + 1][1] * inv); pw.w = pk2(sc[2 * s + 1][2] * inv, sc[2 * s + 1][3] * inv); } else { pw.z = 0u; pw.w = 0u; }
        const bf16x8 pf = __builtin_bit_cast(bf16x8, pw);
        const int key0 = 16 * (w + 2 * s) + 4 * qq; int key1 = key0 + 16; if (key1 > 252) key1 = 252;
#pragma unroll
        for (int dt = 0; dt < 4; ++dt) { const v2u lo = tr4(Vs, 72, key0, 16 * dt, fr), hi = tr4(Vs, 72, key1, 16 * dt, fr);
            const bf16x8 av = __builtin_bit_cast(bf16x8, (v4u){lo.x, lo.y, hi.x, hi.y}); oacc[dt] = __builtin_amdgcn_mfma_f32_16x16x32_bf16(av, pf, oacc[dt], 0, 0, 0); }
    }
    const size_t lrow = (((size_t)a.nbk * 128 + iq) << a.dsh) + a.r, row = (size_t)a.bl * SEQ + lrow;
    bf16* og = (bf16*)(F.ws + WS_OG) + (size_t)a.bl * OGR_B + ((size_t)a.g * SEQ + lrow) * 256 + a.h4 * 64;
#pragma unroll
    for (int dt = 0; dt < 4; ++dt) { v2u o; o.x = pk2(oacc[dt][0], oacc[dt][1]); o.y = pk2(oacc[dt][2], oacc[dt][3]); *(v2u*)(og + 16 * dt + 4 * qq) = o; }
    if (qq == 0) ((float*)(F.ws + WS_LSE))[((size_t)a.g * TC + row) * 4 + a.h4] = mx + __logf(sum);
}

__device__ __forceinline__ void rot8(const bf16* p, const float* rope, int pos, int d0, float scl, float (&o1)[8], float (&o2)[8]) {
    const v4u a = *(const v4u*)(p + d0), b = *(const v4u*)(p + d0 + 32);
    const float t1[8] = {bflo(a.x), bfhi(a.x), bflo(a.y), bfhi(a.y), bflo(a.z), bfhi(a.z), bflo(a.w), bfhi(a.w)};
    const float t2[8] = {bflo(b.x), bfhi(b.x), bflo(b.y), bfhi(b.y), bflo(b.z), bfhi(b.z), bflo(b.w), bfhi(b.w)};
    const f32x4 c0 = *(const f32x4*)(rope + pos * 64 + d0), c1 = *(const f32x4*)(rope + pos * 64 + d0 + 4), s0 = *(const f32x4*)(rope + pos * 64 + 32 + d0), s1 = *(const f32x4*)(rope + pos * 64 + 32 + d0 + 4);
    const float cs[8] = {c0.x, c0.y, c0.z, c0.w, c1.x, c1.y, c1.z, c1.w}, sn[8] = {s0.x, s0.y, s0.z, s0.w, s1.x, s1.y, s1.z, s1.w};
#pragma unroll
    for (int j = 0; j < 8; ++j) { o1[j] = (t1[j] * cs[j] - t2[j] * sn[j]) * scl; o2[j] = (t1[j] * sn[j] + t2[j] * cs[j]) * scl; }
}

struct KvPre { v4u k1, k2, v[4]; f32x4 c0, c1, s0, s1; };
__device__ __forceinline__ void kvseq_load(Frame& F, int bl, int h, int c, int tid, KvPre& P) {
    const bf16* proj = (const bf16*)(F.ws + WS_PROJ); const float* rope = (const float*)(F.ws + WS_ROPE);
    { const int j = tid >> 2, d0 = (tid & 3) * 8; const size_t row = (size_t)bl * SEQ + c * 128 + j; const int pos = c * 128 + j;
      const bf16* kp = proj + row * PCOL + OFF_KR + h * 64;
      P.k1 = *(const v4u*)(kp + d0); P.k2 = *(const v4u*)(kp + d0 + 32);
      P.c0 = *(const f32x4*)(rope + pos * 64 + d0); P.c1 = *(const f32x4*)(rope + pos * 64 + d0 + 4); P.s0 = *(const f32x4*)(rope + pos * 64 + 32 + d0); P.s1 = *(const f32x4*)(rope + pos * 64 + 32 + d0 + 4); }
#pragma unroll
    for (int k = 0; k < 4; ++k) { const int it = tid + 512 * k, j = it >> 4, cc = it & 15; const size_t row = (size_t)bl * SEQ + c * 128 + j;
        P.v[k] = *(const v4u*)(proj + row * PCOL + OFF_VR + h * 128 + cc * 8); }
}
__device__ __forceinline__ void rot8r(const v4u a, const v4u b, const f32x4 c0, const f32x4 c1, const f32x4 s0, const f32x4 s1, float scl, v4u& o1, v4u& o2) {
    const float t1[8] = {bflo(a.x), bfhi(a.x), bflo(a.y), bfhi(a.y), bflo(a.z), bfhi(a.z), bflo(a.w), bfhi(a.w)};
    const float t2[8] = {bflo(b.x), bfhi(b.x), bflo(b.y), bfhi(b.y), bflo(b.z), bfhi(b.z), bflo(b.w), bfhi(b.w)};
    const float cs[8] = {c0.x, c0.y, c0.z, c0.w, c1.x, c1.y, c1.z, c1.w}, sn[8] = {s0.x, s0.y, s0.z, s0.w, s1.x, s1.y, s1.z, s1.w};
    float r1[8], r2[8];
#pragma unroll
    for (int j = 0; j < 8; ++j) { r1[j] = (t1[j] * cs[j] - t2[j] * sn[j]) * scl; r2[j] = (t1[j] * sn[j] + t2[j] * cs[j]) * scl; }
    o1 = (v4u){pk2(r1[0], r1[1]), pk2(r1[2], r1[3]), pk2(r1[4], r1[5]), pk2(r1[6], r1[7])};
    o2 = (v4u){pk2(r2[0], r2[1]), pk2(r2[2], r2[3]), pk2(r2[4], r2[5]), pk2(r2[6], r2[7])};
}
__device__ __forceinline__ void kvseq_unit(Frame& F, int bh) {
    int tid_ = F.wv * 64 + lane_id(); asm volatile("" : "+v"(tid_)); const int tid = tid_, lane = tid & 63, w = __builtin_amdgcn_readfirstlane(tid >> 6), fr = lane & 15, qq = lane >> 4;
    const int bl = bh >> 3, h = bh & 7;
    const float l2g = log2_gamma(h), gam = exp2f(l2g), g127 = exp2f(127.0f * l2g), g128 = exp2f(128.0f * l2g);
    constexpr int KVB = 128 * 72 + 128 * 136;
    f32x4 st[4];
#pragma unroll
    for (int mt = 0; mt < 4; ++mt) st[mt] = (f32x4){0.f, 0.f, 0.f, 0.f};
    KvPre P0, P1; kvseq_load(F, bl, h, 0, tid, P0); kvseq_load(F, bl, h, 1, tid, P1);
    const float kscl = 0.125f * exp2f(-(float)(tid >> 2) * l2g);
    bf16* rpt = (bf16*)(F.ws + WS_OG) + (size_t)bl * OGR_B + RPT_OFF + (size_t)(h * 16) * 8192 + (size_t)(16 * w + fr) * 64 + 4 * qq;
#define KVSEQ_STEP(P, c, bufi) do { LAS bf16* Ks = (LAS bf16*)F.lds + (bufi) * KVB; LAS bf16* Vs = Ks + 128 * 72; \
        { const int j = tid >> 2, d0 = (tid & 3) * 8; v4u o1, o2; rot8r(P.k1, P.k2, P.c0, P.c1, P.s0, P.s1, kscl, o1, o2); \
          *(LAS v4u*)(Ks + j * 72 + d0) = o1; *(LAS v4u*)(Ks + j * 72 + d0 + 32) = o2; } \
        _Pragma("unroll") for (int k = 0; k < 4; ++k) { const int it = tid + 512 * k, j = it >> 4, cc = it & 15; *(LAS v4u*)(Vs + j * 136 + cc * 8) = P.v[k]; } \
        _Pragma("unroll") for (int mt = 0; mt < 4; ++mt) *(v2u*)(rpt + (size_t)(c) * 8192 + 16 * mt) = (v2u){pk2(gam * st[mt][0], gam * st[mt][1]), pk2(gam * st[mt][2], gam * st[mt][3])}; \
        LDS_BARRIER(); \
        if ((c) + 2 < 16) kvseq_load(F, bl, h, (c) + 2, tid, P); \
        f32x4 acc[4]; \
        _Pragma("unroll") for (int mt = 0; mt < 4; ++mt) acc[mt] = (f32x4){0.f, 0.f, 0.f, 0.f}; \
        _Pragma("unroll") for (int ks = 0; ks < 4; ++ks) { \
            const v2u blo = tr4(Vs, 136, 32 * ks + 4 * qq, 16 * w, fr), bhi = tr4(Vs, 136, 32 * ks + 16 + 4 * qq, 16 * w, fr); \
            const bf16x8 bv = __builtin_bit_cast(bf16x8, (v4u){blo.x, blo.y, bhi.x, bhi.y}); \
            _Pragma("unroll") for (int mt = 0; mt < 4; ++mt) { \
                const v2u alo = tr4(Ks, 72, 32 * ks + 4 * qq, 16 * mt, fr), ahi = tr4(Ks, 72, 32 * ks + 16 + 4 * qq, 16 * mt, fr); \
                acc[mt] = __builtin_amdgcn_mfma_f32_16x16x32_bf16(__builtin_bit_cast(bf16x8, (v4u){alo.x, alo.y, ahi.x, ahi.y}), bv, acc[mt], 0, 0, 0); } } \
        _Pragma("unroll") for (int mt = 0; mt < 4; ++mt) st[mt] = st[mt] * g128 + acc[mt] * g127; } while (0)
    for (int c = 0; c < 16; c += 2) { KVSEQ_STEP(P0, c, 0); KVSEQ_STEP(P1, c + 1, 1); }
    LDS_BARRIER();
#undef KVSEQ_STEP
}
__device__ __forceinline__ void merge_items(Frame& F) {
    int tid_ = F.wv * 64 + lane_id(); asm volatile("" : "+v"(tid_)); const int tid = tid_;
    const bf16* og = (const bf16*)(F.ws + WS_OG) + (size_t)F.xi * OGR_B; const float* lse = (const float*)(F.ws + WS_LSE); bf16* att = (bf16*)(F.ws + WS_ATT) + (size_t)F.crow * 256;
    const int istr = F.NR_() * 512;
    for (int item0 = F.rank * 512 + tid; item0 < SEQ * 32; item0 += 4 * istr) {
        float l0[4], l1[4], l2[4]; v4u a[4], b[4], c[4];
#pragma unroll
        for (int q = 0; q < 4; ++q) { const int item = item0 + q * istr < SEQ * 32 ? item0 + q * istr : item0; const int row = F.xi * SEQ + (item >> 5), ch = item & 31, h4 = ch >> 3;
            l0[q] = lse[((size_t)0 * TC + row) * 4 + h4]; l1[q] = lse[((size_t)1 * TC + row) * 4 + h4]; l2[q] = lse[((size_t)2 * TC + row) * 4 + h4];
            const size_t lr = (size_t)(item >> 5) * 256 + ch * 8;
            a[q] = *(const v4u*)(og + lr); b[q] = *(const v4u*)(og + (size_t)SEQ * 256 + lr); c[q] = *(const v4u*)(og + (size_t)2 * SEQ * 256 + lr); }
#pragma unroll
        for (int q = 0; q < 4; ++q) { const int item = item0 + q * istr; if (item < SEQ * 32) { const int row = F.xi * SEQ + (item >> 5), ch = item & 31;
            const float mx = fmaxf(l0[q], fmaxf(l1[q], l2[q])); float w0 = __expf(l0[q] - mx), w1 = __expf(l1[q] - mx), w2 = __expf(l2[q] - mx); const float inv = 1.0f / (w0 + w1 + w2); w0 *= inv; w1 *= inv; w2 *= inv;
            v4u o;
            o.x = pk2(w0 * bflo(a[q].x) + w1 * bflo(b[q].x) + w2 * bflo(c[q].x), w0 * bfhi(a[q].x) + w1 * bfhi(b[q].x) + w2 * bfhi(c[q].x));
            o.y = pk2(w0 * bflo(a[q].y) + w1 * bflo(b[q].y) + w2 * bflo(c[q].y), w0 * bfhi(a[q].y) + w1 * bfhi(b[q].y) + w2 * bfhi(c[q].y));
            o.z = pk2(w0 * bflo(a[q].z) + w1 * bflo(b[q].z) + w2 * bflo(c[q].z), w0 * bfhi(a[q].z) + w1 * bfhi(b[q].z) + w2 * bfhi(c[q].z));
            o.w = pk2(w0 * bflo(a[q].w) + w1 * bflo(b[q].w) + w2 * bflo(c[q].w), w0 * bfhi(a[q].w) + w1 * bfhi(b[q].w) + w2 * bfhi(c[q].w));
            *(v4u*)(att + (size_t)row * 256 + ch * 8) = o; } }
    }
}
struct RetPre { v4u q1, q2, k1, k2, v[4], r[2]; f32x4 c0, c1, s0, s1; };
__device__ __forceinline__ void ret_load(Frame& F, int kid, int tid, RetPre& P) {
    const int bh = kid >> 4, c = kid & 15, bl = bh >> 3, h = bh & 7;
    const bf16* proj = (const bf16*)(F.ws + WS_PROJ); const float* rope = (const float*)(F.ws + WS_ROPE);
    { const int j = tid >> 2, d0 = (tid & 3) * 8; const size_t row = (size_t)bl * SEQ + c * 128 + j; const int pos = c * 128 + j;
      const bf16* qp = proj + row * PCOL + OFF_QR + h * 64; const bf16* kp = proj + row * PCOL + OFF_KR + h * 64;
      P.q1 = *(const v4u*)(qp + d0); P.q2 = *(const v4u*)(qp + d0 + 32); P.k1 = *(const v4u*)(kp + d0); P.k2 = *(const v4u*)(kp + d0 + 32);
      P.c0 = *(const f32x4*)(rope + pos * 64 + d0); P.c1 = *(const f32x4*)(rope + pos * 64 + d0 + 4); P.s0 = *(const f32x4*)(rope + pos * 64 + 32 + d0); P.s1 = *(const f32x4*)(rope + pos * 64 + 32 + d0 + 4); }
#pragma unroll
    for (int k = 0; k < 4; ++k) { const int it = tid + 512 * k, j = it >> 4, cc = it & 15; const size_t row = (size_t)bl * SEQ + c * 128 + j;
        P.v[k] = *(const v4u*)(proj + row * PCOL + OFF_VR + h * 128 + cc * 8); }
    { const bf16* rp = (const bf16*)(F.ws + WS_OG) + (size_t)bl * OGR_B + RPT_OFF + (size_t)(kid & 127) * 8192;
#pragma unroll
      for (int k = 0; k < 2; ++k) { const int it = tid + 512 * k, dv = it >> 3, cc = it & 7; P.r[k] = *(const v4u*)(rp + dv * 64 + cc * 8); } }
}
__device__ __forceinline__ void ret_stage(Frame& F, int kid, int tid, const RetPre& P) {
    const int h = (kid >> 4) & 7; const float l2g = log2_gamma(h);
    LAS bf16* Qs = (LAS bf16*)F.lds; LAS bf16* Ks = Qs + 128 * 72; LAS bf16* Rs = Ks + 128 * 72; LAS bf16* Vs = Rs + 128 * 72;
    { const int j = tid >> 2, d0 = (tid & 3) * 8; v4u o1, o2;
      rot8r(P.q1, P.q2, P.c0, P.c1, P.s0, P.s1, exp2f((float)j * l2g), o1, o2);
      *(LAS v4u*)(Qs + j * 72 + d0) = o1; *(LAS v4u*)(Qs + j * 72 + d0 + 32) = o2;
      rot8r(P.k1, P.k2, P.c0, P.c1, P.s0, P.s1, 0.125f * exp2f(-(float)j * l2g), o1, o2);
      *(LAS v4u*)(Ks + j * 72 + d0) = o1; *(LAS v4u*)(Ks + j * 72 + d0 + 32) = o2; }
#pragma unroll
    for (int k = 0; k < 4; ++k) { const int it = tid + 512 * k, j = it >> 4, cc = it & 15; *(LAS v4u*)(Vs + j * 136 + cc * 8) = P.v[k]; }
#pragma unroll
    for (int k = 0; k < 2; ++k) { const int it = tid + 512 * k, dv = it >> 3, cc = it & 7; *(LAS v4u*)(Rs + dv * 72 + cc * 8) = P.r[k]; }
}
constexpr int RET_GS_OFF = (128 * 72 * 3 + 128 * 136) * 2;
__device__ __forceinline__ void ret_gate_dma(Frame& F, int kid, int tid) {
    const int lane = tid & 63, w = __builtin_amdgcn_readfirstlane(tid >> 6);
    const int bh = kid >> 4, c = kid & 15, bl = bh >> 3, h = bh & 7;
    const bf16* gp = (const bf16*)(F.ws + WS_PROJ) + ((size_t)bl * SEQ + c * 128 + 16 * w) * PCOL + OFF_GR + h * 128;
    asm volatile("" ::: "memory");
#pragma unroll
    for (int k = 0; k < 4; ++k) { const int p = k * 64 + lane, r = p >> 4, cc = (p & 15) ^ r;
        __builtin_amdgcn_global_load_lds((const unsigned*)(gp + (size_t)r * PCOL + cc * 8), (LAS unsigned*)(F.lds + RET_GS_OFF + w * 4096 + k * 1024), 16, 0, 0); }
    asm volatile("" ::: "memory");
}
constexpr int RET_NLOADS = 14;
__device__ __forceinline__ void ret_compute(Frame& F, int kid, int tid, bool younger) {
    const int lane = tid & 63, w = __builtin_amdgcn_readfirstlane(tid >> 6), fr = lane & 15, qq = lane >> 4;
    const int bh = kid >> 4, c = kid & 15, bl = bh >> 3, h = bh & 7;
    const bf16* proj = (const bf16*)(F.ws + WS_PROJ);
    const LAS bf16* Qs = (const LAS bf16*)F.lds;
    const LAS bf16* Ks = Qs + 128 * 72;
    const LAS bf16* Rs = Ks + 128 * 72;
    const LAS bf16* Vs = Rs + 128 * 72;
    bf16x8 qf[2];
#pragma unroll
    for (int ks = 0; ks < 2; ++ks) qf[ks] = *(const LAS bf16x8*)(Qs + (16 * w + fr) * 72 + 32 * ks + 8 * qq);
    f32x4 oacc[8];
#pragma unroll
    for (int dt = 0; dt < 8; ++dt) oacc[dt] = (f32x4){0.f, 0.f, 0.f, 0.f};
    const int iq = 16 * w + fr;
#pragma unroll
    for (int s = 0; s < 4; ++s) {
        if (2 * s <= w) {
            f32x4 sa = (f32x4){0.f, 0.f, 0.f, 0.f}, sb = (f32x4){0.f, 0.f, 0.f, 0.f};
#pragma unroll
            for (int ks = 0; ks < 2; ++ks) { const bf16x8 av = *(const LAS bf16x8*)(Ks + (32 * s + fr) * 72 + 32 * ks + 8 * qq); sa = __builtin_amdgcn_mfma_f32_16x16x32_bf16(av, qf[ks], sa, 0, 0, 0); }
            if (2 * s + 1 <= w) {
#pragma unroll
                for (int ks = 0; ks < 2; ++ks) { const bf16x8 av = *(const LAS bf16x8*)(Ks + (32 * s + 16 + fr) * 72 + 32 * ks + 8 * qq); sb = __builtin_amdgcn_mfma_f32_16x16x32_bf16(av, qf[ks], sb, 0, 0, 0); }
            }
#pragma unroll
            for (int i = 0; i < 4; ++i) { const int ka = 32 * s + 4 * qq + i; if (ka > iq) sa[i] = 0.f; if (ka + 16 > iq) sb[i] = 0.f; }
            const bf16x8 pf = __builtin_bit_cast(bf16x8, (v4u){pk2(sa[0], sa[1]), pk2(sa[2], sa[3]), pk2(sb[0], sb[1]), pk2(sb[2], sb[3])});
#pragma unroll
            for (int dt = 0; dt < 8; ++dt) { const v2u lo = tr4(Vs, 136, 32 * s + 4 * qq, 16 * dt, fr), hi = tr4(Vs, 136, 32 * s + 16 + 4 * qq, 16 * dt, fr);
                const bf16x8 av = __builtin_bit_cast(bf16x8, (v4u){lo.x, lo.y, hi.x, hi.y}); oacc[dt] = __builtin_amdgcn_mfma_f32_16x16x32_bf16(av, pf, oacc[dt], 0, 0, 0); }
        }
    }
#pragma unroll
    for (int dt = 0; dt < 8; ++dt)
#pragma unroll
        for (int ks = 0; ks < 2; ++ks) { const bf16x8 av = *(const LAS bf16x8*)(Rs + (16 * dt + fr) * 72 + 32 * ks + 8 * qq); oacc[dt] = __builtin_amdgcn_mfma_f32_16x16x32_bf16(av, qf[ks], oacc[dt], 0, 0, 0); }
    float ss = 0.f;
#pragma unroll
    for (int dt = 0; dt < 8; ++dt) ss += sq4(oacc[dt]);
    ss += __shfl_xor(ss, 16); ss += __shfl_xor(ss, 32);
    const float rn = rsqrtf(ss * (1.0f / 128.0f) + EPS);
    const size_t row = (size_t)bl * SEQ + c * 128 + iq;
    bf16* rp = (bf16*)(F.ws + WS_RET) + (row + (size_t)F.crow) * DM + h * 128;
    if (younger) asm volatile("s_waitcnt vmcnt(%0)" :: "n"(RET_NLOADS) : "memory"); else asm volatile("s_waitcnt vmcnt(0)" ::: "memory");
    const LAS unsigned char* gs = F.lds + RET_GS_OFF + w * 4096 + fr * 256 + (qq & 1) * 8;
#pragma unroll
    for (int dt = 0; dt < 8; ++dt) { const v2u gw2 = *(const LAS v2u*)(gs + (((2 * dt + (qq >> 1)) ^ fr) << 4));
        const float g0 = bflo(gw2.x), g1 = bfhi(gw2.x), g2 = bflo(gw2.y), g3 = bfhi(gw2.y);
        v2u o; o.x = pk2(g0 * pg8::sigm(g0) * oacc[dt][0] * rn, g1 * pg8::sigm(g1) * oacc[dt][1] * rn); o.y = pk2(g2 * pg8::sigm(g2) * oacc[dt][2] * rn, g3 * pg8::sigm(g3) * oacc[dt][3] * rn);
        *(v2u*)(rp + 16 * dt + 4 * qq) = o; }
}

__device__ __forceinline__ void c2_phase(Frame& F) {
    fresh_ids(F);
    int tid_ = F.wv * 64 + lane_id(); asm volatile("" : "+v"(tid_)); const int tid = tid_;
    const int nu = (F.rank < 128) ? (128 - F.rank + F.NR_() - 1) / F.NR_() : 0, k0 = F.xi * 128 + F.rank;
    RetPre P;
    if (nu > 0) ret_load(F, k0, tid, P);
    merge_items(F);
    for (int k = 0; k < nu; ++k) {
        ret_stage(F, k0 + k * F.NR_(), tid, P);
        ret_gate_dma(F, k0 + k * F.NR_(), tid);
        LDS_BARRIER();
        if (k + 1 < nu) ret_load(F, k0 + (k + 1) * F.NR_(), tid, P);
        ret_compute(F, k0 + k * F.NR_(), tid, k + 1 < nu);
        LDS_BARRIER();
    }
}

__device__ __forceinline__ void c1_phase(Frame& F) {
    fresh_ids(F);
    int tid_ = F.wv * 64 + lane_id(); asm volatile("" : "+v"(tid_)); const int tid = tid_;
    const bool split = F.NR_() > 8;
    const int a0 = split ? F.rank - 8 : F.rank, astride = split ? F.NR_() - 8 : F.NR_();
    const int na = (split && F.rank < 8) ? 0 : (a0 < 192 ? (192 - a0 + astride - 1) / astride : 0), ab = F.xi * 192;
    for (int repa = 0; repa < REP_C1A; ++repa)
    if (na > 0) {
        AttnPre P; attn_load(F, ab + a0, tid, P);
        for (int k = 0; k < na; ++k) {
            attn_stage(F, tid, P, attn_decode(ab + a0 + k * astride).nbk == 0);
            LDS_BARRIER();
            if (k + 1 < na) attn_load(F, ab + a0 + (k + 1) * astride, tid, P);
            attn_compute(F, ab + a0 + k * astride, tid);
            LDS_BARRIER();
        }
    }
    for (int repk = 0; repk < REP_C1K; ++repk)
    if (split) { if (F.rank < 8) kvseq_unit(F, F.xi * 8 + F.rank); }
    else { for (int u = F.rank; u < 8; u += F.NR_()) kvseq_unit(F, F.xi * 8 + u); }
}

constexpr int STEPS_L0 = NCH * 5 + 1 + 2 + 1, STEPS_L1 = NCH * 5 + 1 + 1 + 2 + 1, NSTEPS = 2 + STEPS_L0 + STEPS_L1;

#ifndef NVG
#define NVG
#endif
#ifndef LBW
#define LBW 2
#endif
__global__ void __launch_bounds__(NWAVES * 64, LBW) NVG fwd(const Args args) {
    extern __shared__ __attribute__((aligned(16))) unsigned char lds_raw[];
    Frame F;
    F.lds = (LAS unsigned char*)lds_raw;
    F.G = gridDim.x; F.wv = __builtin_amdgcn_readfirstlane(threadIdx.x >> 6);
    F.ws = args.ws; F.out = args.out; F.ctl = (gu32*)(args.ws + WS_CTL);
    for (int u = threadIdx.x; u < (LDS_BYTES - LDSCTL_OFF) / 4; u += NWAVES * 64) ((LAS unsigned*)(F.lds + LDSCTL_OFF))[u] = 0u;
    __syncthreads();
    XcdBarrier bar; bar.bar = (unsigned*)(F.ctl + CW_BAR); bar.x = 0; bar.st = nullptr; bar.wv = F.wv;
    if (!MK_MULTI) bar = xcd_barrier_post((unsigned*)(F.ctl + CW_BAR), (volatile LAS unsigned*)(F.lds + MISC_OFF + 32), F.wv);
    const int lo = args.lo, hi = args.hi; int seq = 0;
    volatile LAS unsigned* misc = (volatile LAS unsigned*)(F.lds + MISC_OFF);
    const unsigned my_xcc = xb_xcc_id();
    if (!MK_MULTI && threadIdx.x == 0) misc[48] = xb_add((unsigned*)(F.ctl + CW_RANK + 64 * my_xcc), 1u);
    __syncthreads();
    const int hw_rank = __builtin_amdgcn_readfirstlane((int)misc[48]);
    F.xi = (int)(blockIdx.x & 7); F.rank = (int)(blockIdx.x >> 3);
    bool xl = false; int lgen = 0;
#define STEP_ON (seq >= lo && seq < hi)
#define FRESH_WS unsigned char* ws = args.ws; asm volatile("" : "+s"(ws))
#define STEP_END do { if (!MK_MULTI && STEP_ON && seq + 1 < hi) { for (int rb = 0; rb < REP_BAR; ++rb) xcd_barrier(bar, F.lds); } ++seq; } while (0)
#define STEP_END_L do { if (!MK_MULTI && STEP_ON && seq + 1 < hi) { if (xl) xl_barrier(F.ctl, bar.bar, F.xi, F.NR_(), lgen, F.wv, F.lds); else xcd_barrier(bar, F.lds); } ++seq; } while (0)
    LAS unsigned char* ring = F.lds;

    const bool side = (F.G == 256);
    if (STEP_ON) {
#ifndef SKIP_PRO
        for (int rp = 0; rp < REP_PRO; ++rp) {
        adaln_phase(F, args);
        rope_phase(F);
        absmax_phase(F, args);
        convert_mixer_weights(F, args, 0);
        if (!side) convert_ffn_weights(F, args.in[I_WFG], args.in[I_WFU], args.in[I_WFD], 0, 0, FFN_ITEMS, (int)blockIdx.x * NWAVES + F.wv, F.G * NWAVES);
        __syncthreads(); }
#endif
    }
    STEP_END;
    if (!MK_MULTI && lo == 0 && hi > 1) {
        if (threadIdx.x == 0) { unsigned ok = (F.G % 8 == 0) ? 1u : 0u, idx = 0u, npop = 0u;
            for (unsigned j = 0; j < 16; ++j) { const unsigned c = xb_ld(&bar.bar[XB_XCNT(j)]); if (c) { if (c != (unsigned)F.NR_()) ok = 0u; if (j < my_xcc) ++idx; ++npop; } }
            if (npop != 8u) ok = 0u;
            misc[49] = ok; misc[50] = idx; }
        __syncthreads();
        xl = misc[49] != 0u;
        if (xl) { F.xi = __builtin_amdgcn_readfirstlane((int)misc[50]); F.rank = hw_rank; }
    }
    if (STEP_ON) { convert_win(F, args, 0); __syncthreads(); for (int rep = 0; rep < REP_A; ++rep) phase_a(F, args); }
    STEP_END;

    for (int l = 0; l < DEPTH; ++l) {
        const bool moe = (l & 1) != 0;
        for (int rmix = 0; rmix < (l == 0 ? REP_MIX : 1); ++rmix)
        for (int ch = 0; ch < NCH; ++ch) {
            F.crow = ch * TC; fresh_ids(F);
#pragma nounroll
            for (int pass = 0; pass < 2; ++pass) {
            if (STEP_ON && side && F.rank >= 8 && pass == (F.rank >= 20 ? 1 : 0)) {
                __syncthreads();
                const int gwi = ((F.rank - 8) * 8 + F.xi) * NWAVES + F.wv, ngw = 192 * NWAVES;
                constexpr int FI = FFN_ITEMS;
                if (l == 0) { if (ch == 0) { convert_ffn_weights(F, args.in[I_WFG], args.in[I_WFU], args.in[I_WFD], 0, 0, FI, gwi, ngw); convert_ffn_weights(F, args.in[I_WEG], args.in[I_WEU], args.in[I_WED], 1, FI, 2 * FI, gwi, ngw); }
                              else convert_ffn_weights(F, args.in[I_WEG], args.in[I_WEU], args.in[I_WED], 1, 2 * FI, 4 * FI, gwi, ngw); }
                else { if (ch == 0) { convert_ffn_weights(F, args.in[I_WEG], args.in[I_WEU], args.in[I_WED], 1, 0, FI, gwi, ngw); convert_ffn_weights(F, args.in[I_WEG], args.in[I_WEU], args.in[I_WED], 1, 4 * FI, 4 * FI + FI * 3 / 2, gwi, ngw); }
                       else convert_ffn_weights(F, args.in[I_WEG], args.in[I_WEU], args.in[I_WED], 1, 4 * FI + FI * 3 / 2, 8 * FI, gwi, ngw); }
                __syncthreads();
            }
            if (STEP_ON && pass == 0) {
#ifndef SKIP_B
                FRESH_WS;
                pg8::Gemm g{(const bf16*)(ws + WS_H + (size_t)ch * TC * DM), (const bf16*)(ws + WS_WM + WM_WIN), TC, NCOL, DM / 2}; pg8::StaticOrder S; S.init(TC, NCOL, F.G, F.vb_());
                pg8::EpiI8 E{(bf16*)(ws + WS_PROJ), PCOL, (const float*)(ws + WS_RS) + (size_t)ch * TC, ((const float*)(ws + WS_WSC))[l], ws + WS_G8 + (size_t)ch * TC * GCOL, PCOL / 256};
                for (int rep = 0; rep < REP_B; ++rep) pg8::gemm_phase<pg8::EpiI8, pg8::StaticOrder, true, true, 2>(ring, F.wv, g, S, E);
#endif
            }
            }
            STEP_END_L;
            if (STEP_ON) {
#ifndef SKIP_C1
                for (int rep = 0; rep < REP_C1; ++rep) c1_phase(F);
#endif

            }
            STEP_END_L;
#ifndef SKIP_C2
            if (STEP_ON) { for (int rep = 0; rep < REP_C2; ++rep) c2_phase(F); }
#endif

            if (ch == NCH - 1) STEP_END; else STEP_END_L;
        }
        fresh_ids(F);
        if (STEP_ON) {
#ifndef SKIP_E
            FRESH_WS;
            pg8::Gemm g{(const bf16*)(ws + WS_ATT), (const bf16*)(ws + WS_WM + WM_WA), T, DM, 256}; pg8::StaticOrder S; S.init(T, DM, F.G, F.vb_());
            pg8::EpiGate<0, true> E{ws + WS_G8, GCOL, nullptr, DM, ws + WS_MRG, nullptr};
            for (int rep = 0; rep < REP_E; ++rep) pg8::gemm_phase<pg8::EpiGate<0, true>, pg8::StaticOrder, true, true>(ring, F.wv, g, S, E);
#endif
        }
        if (STEP_ON) {
#ifndef SKIP_F
            FRESH_WS;
            pg8::Gemm g{(const bf16*)(ws + WS_RET), (const bf16*)(ws + WS_WM + WM_WR), T, DM, DM}; pg8::StaticOrder S; S.init(T, DM, F.G, F.vb_());
            pg8::EpiGate<1, true, true> E{ws + WS_G8 + DM, GCOL, nullptr, DM, ws + WS_MRG8, ws + WS_MRG};
            pg8::gemm_phase<pg8::EpiGate<1, true, true>, pg8::StaticOrder, true, true>(ring, F.wv, g, S, E);
#endif
        }
        STEP_END_L;
        fresh_ids(F);
        if (STEP_ON) {
#ifndef SKIP_G
            FRESH_WS;
            pg8::Gemm g{(const bf16*)(ws + WS_MRG8), (const bf16*)(ws + WS_WM + WM_WMIX), T, DM, DM / 2, nullptr, 127 - 8}; pg8::StaticOrder S; S.init(T, DM, F.G, F.vb_());
            pg8::EpiBf16 E{(bf16*)(ws + WS_Y), DM};
            pg8::gemm_phase<pg8::EpiBf16, pg8::StaticOrder, true, true, 1>(ring, F.wv, g, S, E);
#endif
        }
        STEP_END_L;
#ifndef SKIP_H
        fresh_ids(F);
        if (STEP_ON) {
#pragma nounroll
            for (int j = 0; j < 2; ++j) { const int e = 2 * F.xi + j; phase_h(F, args, l, moe, e >> 3, (e & 7) * F.NR_() + F.rank, F.G, j == 0); __syncthreads(); }
        }
#endif
        if (moe) STEP_END; else STEP_END_L;
        if (moe) { if (STEP_ON) phase_h2(F, F.G, F.G); STEP_END; }
        const int fvb = moe ? (int)blockIdx.x : F.vb_();
        {
            LAS int* tendL = (LAS int*)(F.lds + MISC_OFF + 128);
            if (F.wv == 0 && lane_id() == 0) { int acc = 0;
                for (int e = 0; e < 8; ++e) { const int c = moe ? (int)__hip_atomic_load((unsigned*)(F.ctl + CW_ECNT + e), RLX_AGENT) : (e == 0 ? T : 0); acc += (c + 255) >> 8; tendL[e] = acc; } }
            if (F.wv == 1 && lane_id() < 8) ((LAS float*)(F.lds + MISC_OFF + 256))[lane_id()] = ((const float*)(F.ws + WS_WSCF))[lane_id()];
            __syncthreads();
            const int ttot = __builtin_amdgcn_readfirstlane(tendL[7]);
            for (int rffn = 0; rffn < (l == 0 ? REP_FFN0 : 1); ++rffn) {
            if (STEP_ON) {
#ifndef SKIP_I
                FRESH_WS;
                pg8::Gemm g{(const bf16*)(ws + WS_H), (const bf16*)(ws + WS_WF), ttot * 256, 2 * FF, DM / 2, (const int*)(ws + WS_SRC)};
                pg8::FfnOrder S; S.so.init(ttot * 256, 2 * FF, F.G, fvb); S.tend = tendL; S.estride = (unsigned)WF_E;
                pg8::EpiSwigluI8 E{ws + WS_U, FF, moe ? (const float*)(ws + WS_RSS) : (const float*)(ws + WS_RS), (const LAS float*)(F.lds + MISC_OFF + 256)};
                if (moe) pg8::gemm_phase<pg8::EpiSwigluI8, pg8::FfnOrder, true, true, 2, true>(ring, F.wv, g, S, E);
                else pg8::gemm_phase<pg8::EpiSwigluI8, pg8::FfnOrder, true, true, 2>(ring, F.wv, g, S, E);
#endif
            }
            if (moe) STEP_END; else STEP_END_L;
            if (STEP_ON) {
#ifndef SKIP_J
                FRESH_WS;
                pg8::Gemm g{(const bf16*)(ws + WS_U), (const bf16*)(ws + WS_WF + WF_GU), ttot * 256, DM, FF / 2};
                pg8::FfnOrder S; S.so.init(ttot * 256, DM, F.G, fvb); S.tend = tendL; S.estride = (unsigned)WF_E;
                pg8::EpiBf16 E{(bf16*)(ws + WS_YS), DM};
                for (int rep = 0; rep < REP_J; ++rep) pg8::gemm_phase<pg8::EpiBf16, pg8::FfnOrder, true, true, 1>(ring, F.wv, g, S, E);
#endif
            }
            if (moe) STEP_END; else STEP_END_L;
            }
        }
        if (STEP_ON) {
#ifndef SKIP_K
            phase_k(F, args, l, moe, moe ? (int)blockIdx.x : (2 * F.xi + (F.rank >> 4)) * (F.G >> 4) + (F.rank & 15));
            if (l + 1 < DEPTH) { convert_mixer_weights(F, args, l + 1); convert_win(F, args, l + 1);
                if (!side) convert_ffn_weights(F, args.in[I_WEG], args.in[I_WEU], args.in[I_WED], 1, 0, NEXP * FFN_ITEMS, (int)blockIdx.x * NWAVES + F.wv, F.G * NWAVES); }
#endif

        }
        STEP_END;
    }
#undef STEP_ON
#undef STEP_END
}

extern "C" void kernel_launch(void* const* d_in, const int* in_sizes, int n_in, void* d_out, int out_size, void* d_ws, size_t ws_size, hipStream_t stream) {
    static int grid = 0;
    if (grid == 0) {
        if (n_in != 20 || in_sizes[0] != T * DM || out_size != T * DM || ws_size < WS_END) { fprintf(stderr, "kernel_launch: unexpected shapes / workspace (%zu < %zu)\n", ws_size, (size_t)WS_END); grid = -1; return; }
        int dev = 0, cus = 0, per_cu = 0;
        if (hipGetDevice(&dev) != hipSuccess || hipDeviceGetAttribute(&cus, hipDeviceAttributeMultiprocessorCount, dev) != hipSuccess) { grid = -1; return; }
        if (hipFuncSetAttribute((const void*)fwd, hipFuncAttributeMaxDynamicSharedMemorySize, LDS_BYTES) != hipSuccess) { grid = -1; return; }
        if (hipOccupancyMaxActiveBlocksPerMultiprocessor(&per_cu, (const void*)fwd, NWAVES * 64, LDS_BYTES) != hipSuccess || per_cu < 1) { fprintf(stderr, "kernel_launch: occupancy query says %d\n", per_cu); }
        (void)hipGetLastError();
        grid = cus;
    }
    if (grid < 0) return;
    (void)hipMemsetAsync((char*)d_ws + WS_CTL, 0, CTL_ZERO_BYTES, stream);
    Args a{};
    for (int i = 0; i < 20; ++i) a.in[i] = (const float*)d_in[i];
    a.out = (float*)d_out; a.ws = (unsigned char*)d_ws;
#if MK_MULTI
    for (int s = 0; s < NSTEPS; ++s) { a.lo = s; a.hi = s + 1; hipLaunchKernelGGL(fwd, dim3(grid), dim3(NWAVES * 64), LDS_BYTES, stream, a); }
#else
    a.lo = 0; a.hi = 1 << 30;
    hipLaunchKernelGGL(fwd, dim3(grid), dim3(NWAVES * 64), LDS_BYTES, stream, a);
#endif
}
```
